# Optimizing an MI355X kernel written in HIP

```python
import jax
import jax.numpy as jnp
from jax import lax
import numpy as np

D_MODEL = 1024
BATCH = 1
SEQ = 16384
DEPTH = 2

GRID_W = 64
CTX_LEN = 256
HEAD_DIM = D_MODEL // 16
POOL_GROUPS = 4
POOL_WINDOWS = (2, 4, 8, 16)
POOL_GROUP_DIM = HEAD_DIM
POOL_DIM = POOL_GROUPS * POOL_GROUP_DIM
NA_HEADS = 8
NA_DIM = NA_HEADS * HEAD_DIM
NA_WIN_ROWS = 8
NA_WIN_COLS = 16
SG_HEADS = 4
SG_DIM = SG_HEADS * HEAD_DIM
SG_CHUNK = 128
MIX_DIM = POOL_DIM + NA_DIM + SG_DIM
Q_OFF = POOL_DIM
K_OFF = Q_OFF + NA_DIM
V_OFF = K_OFF + NA_DIM
U_OFF = V_OFF + NA_DIM
G_OFF = U_OFF + SG_DIM
IN_DIM = G_OFF + SG_DIM
N_EXPERTS = 16
N_GROUPS = 4
TOP_K = 2
D_EXPERT = D_MODEL // 2
EPS = 1e-6

kernel_name = 'hybrid_pool_natten_gmlp_moe_dit'


def rms_norm(x, g):
    xf = x.astype(jnp.float32)
    y = xf * lax.rsqrt(jnp.mean(xf * xf, axis=-1, keepdims=True) + EPS)
    return (y * g.astype(jnp.float32)).astype(x.dtype)


def modulate(x, shift, scale):
    return x * (1 + scale) + shift


def centred_pool_minus_self(x, window):
    L = x.shape[1]
    xf = x.astype(jnp.float32)
    cs = jnp.concatenate([jnp.zeros_like(xf[:, :1]), lax.cumsum(xf, axis=1)], axis=1)
    pos = jnp.arange(L)
    lo = jnp.clip(pos - window // 2, 0, L)
    hi = jnp.clip(pos + window // 2, 0, L)
    mean = (cs[:, hi] - cs[:, lo]) / (hi - lo).astype(jnp.float32)[None, :, None]
    return (mean - xf).astype(x.dtype)


def pool_mixer(p, w_pool, pool_scale):
    B, L, _ = p.shape
    pg = p.reshape(B, L, POOL_GROUPS, POOL_GROUP_DIM)
    y = jnp.stack([centred_pool_minus_self(pg[:, :, g], w) for g, w in enumerate(POOL_WINDOWS)], axis=2)
    y = jnp.einsum('blgc,gcd->blgd', y, w_pool)
    return y.reshape(B, L, POOL_DIM) * pool_scale


def spatial_gate(u, v, w_sg, b_sg, sg_norm):
    B, L, _ = u.shape
    nc = L // SG_CHUNK
    u = jax.nn.gelu(u)
    v = rms_norm(jax.nn.gelu(v).reshape(B, nc, SG_CHUNK, SG_HEADS, HEAD_DIM), sg_norm)
    mixed = jnp.einsum('hpq,bnqhd->bnphd', w_sg, v) + b_sg.T[:, :, None]
    return u * mixed.reshape(B, L, SG_DIM)


def neighbourhood_attention(q, k, v, k_ctx, v_ctx, rpb):
    B, N, H, dh = q.shape
    rows = N // GRID_W
    wr = min(NA_WIN_ROWS, rows)
    scale = HEAD_DIM ** -0.5
    qg = q.reshape(B, rows, GRID_W, H, dh)
    kg = k.reshape(B, rows, GRID_W, H, dh)
    vg = v.reshape(B, rows, GRID_W, H, dh)
    cols = jnp.arange(GRID_W)
    col_start = jnp.clip(cols - NA_WIN_COLS // 2, 0, GRID_W - NA_WIN_COLS)
    col_idx = col_start[:, None] + jnp.arange(NA_WIN_COLS)[None, :]
    dc = col_idx - cols[:, None] + NA_WIN_COLS - 1

    def one_row(r):
        rs = jnp.clip(r - wr // 2, 0, rows - wr)
        kb = lax.dynamic_slice_in_dim(kg, rs, wr, axis=1)[:, :, col_idx]
        vb = lax.dynamic_slice_in_dim(vg, rs, wr, axis=1)[:, :, col_idx]
        qr = lax.dynamic_index_in_dim(qg, r, axis=1, keepdims=False)
        dr = rs + jnp.arange(wr) - r + NA_WIN_ROWS - 1
        bias = rpb[:, dr[None, :, None], dc[:, None, :]]
        s_loc = jnp.einsum('bqhd,baqwhd->bhqaw', qr, kb).astype(jnp.float32) * scale + bias.astype(jnp.float32)[None]
        s_loc = s_loc.reshape(B, H, GRID_W, wr * NA_WIN_COLS)
        s_ctx = jnp.einsum('bqhd,bchd->bhqc', qr, k_ctx).astype(jnp.float32) * scale
        p = jax.nn.softmax(jnp.concatenate([s_loc, s_ctx], axis=-1), axis=-1)
        p_loc = p[..., :wr * NA_WIN_COLS].reshape(B, H, GRID_W, wr, NA_WIN_COLS).astype(v.dtype)
        p_ctx = p[..., wr * NA_WIN_COLS:].astype(v.dtype)
        return (jnp.einsum('bhqaw,baqwhd->bqhd', p_loc, vb)
                + jnp.einsum('bhqc,bchd->bqhd', p_ctx, v_ctx))

    out = lax.map(one_row, jnp.arange(rows))
    return jnp.moveaxis(out, 0, 1).reshape(B, N, H * dh)


def context_attention(q, k, v):
    B, Lc, H, dh = q.shape
    s = jnp.einsum('bqhd,bkhd->bhqk', q, k).astype(jnp.float32) * (HEAD_DIM ** -0.5)
    p = jax.nn.softmax(s, axis=-1).astype(v.dtype)
    return jnp.einsum('bhqk,bkhd->bqhd', p, v).reshape(B, Lc, H * dh)


def moe(h, w_router, b_router, w_gate, w_up, w_down):
    B, L, _ = h.shape
    logits = (h @ w_router).astype(jnp.float32) + b_router.astype(jnp.float32)
    scores = jax.nn.softmax(logits, axis=-1)
    sg = scores.reshape(B, L, N_GROUPS, N_EXPERTS // N_GROUPS)
    grp_score = lax.top_k(sg, TOP_K)[0].sum(-1)
    grp_mask = jax.nn.one_hot(jnp.argmax(grp_score, axis=-1), N_GROUPS, dtype=jnp.bool_)
    masked = jnp.where(grp_mask[..., None], sg, -1.0).reshape(B, L, N_EXPERTS)
    top_w, top_i = lax.top_k(masked, TOP_K)
    top_w = top_w / jnp.sum(top_w, axis=-1, keepdims=True)
    gates = jnp.sum(jax.nn.one_hot(top_i, N_EXPERTS, dtype=jnp.float32) * top_w[..., None], axis=-2)
    gates = gates.astype(h.dtype)
    y = jnp.zeros_like(h)
    for e in range(N_EXPERTS):
        he = jax.nn.silu(h @ w_gate[e]) * (h @ w_up[e])
        y = y + gates[..., e:e + 1] * (he @ w_down[e])
    return y


def setup_inputs(seed: int = 0) -> dict:
    key = jax.random.key(seed)
    ks = jax.random.split(key, 24)
    f32 = jnp.float32
    D = D_MODEL

    def nrm(k, shape, s):
        return jax.random.normal(k, shape, f32) * s

    return {
        'x': nrm(ks[0], (BATCH, SEQ, D), 1.0),
        'c': nrm(ks[1], (BATCH, D), 1.0),
        'ctx': nrm(ks[2], (BATCH, CTX_LEN, D), 1.0),
        'c_ctx': nrm(ks[3], (D,), 1.0),
        'w_ada': nrm(ks[4], (DEPTH, D, 6 * D), 0.5 * D ** -0.5),
        'b_ada': nrm(ks[5], (DEPTH, 6 * D), 0.02),
        'norm1': 1.0 + nrm(ks[6], (DEPTH, D), 0.01),
        'w_in': nrm(ks[7], (DEPTH, D, IN_DIM), D ** -0.5),
        'pool_w': nrm(ks[8], (DEPTH, POOL_GROUPS, POOL_GROUP_DIM, POOL_GROUP_DIM), POOL_GROUP_DIM ** -0.5),
        'pool_scale': 1.0 + nrm(ks[9], (DEPTH, POOL_DIM), 0.02),
        'q_norm': 1.0 + nrm(ks[10], (DEPTH, NA_HEADS, HEAD_DIM), 0.01),
        'k_norm': 1.0 + nrm(ks[11], (DEPTH, NA_HEADS, HEAD_DIM), 0.01),
        'rpb': nrm(ks[12], (DEPTH, NA_HEADS, 2 * NA_WIN_ROWS - 1, 2 * NA_WIN_COLS - 1), 0.1),
        'sg_w': nrm(ks[13], (DEPTH, SG_HEADS, SG_CHUNK, SG_CHUNK), SG_CHUNK ** -0.5),
        'sg_b': 1.0 + nrm(ks[14], (DEPTH, SG_HEADS, SG_CHUNK), 0.01),
        'sg_norm': 1.0 + nrm(ks[15], (DEPTH, SG_HEADS, HEAD_DIM), 0.01),
        'w_out': nrm(ks[16], (DEPTH, MIX_DIM, D), MIX_DIM ** -0.5),
        'norm2': 1.0 + nrm(ks[17], (DEPTH, D), 0.01),
        'w_router': nrm(ks[18], (D, N_EXPERTS), D ** -0.5),
        'b_router': nrm(ks[19], (N_EXPERTS,), 0.01),
        'w_gate': nrm(ks[20], (DEPTH, N_EXPERTS, D, D_EXPERT), D ** -0.5),
        'w_up': nrm(ks[21], (DEPTH, N_EXPERTS, D, D_EXPERT), D ** -0.5),
        'w_down': nrm(ks[22], (DEPTH, N_EXPERTS, D_EXPERT, D), D_EXPERT ** -0.5),
    }


def reference(x, c, ctx, c_ctx, w_ada, b_ada, norm1, w_in, pool_w, pool_scale, q_norm, k_norm, rpb,
              sg_w, sg_b, sg_norm, w_out, norm2, w_router, b_router, w_gate, w_up, w_down):
    cond_lat = jax.nn.silu(c)[:, None]
    cond_ctx = jax.nn.silu(c_ctx)[None, None]
    h_lat, h_ctx = x, ctx
    for l in range(DEPTH):
        last = l == DEPTH - 1
        sh1, sc1, g1, sh2, sc2, g2 = jnp.split(cond_lat @ w_ada[l] + b_ada[l], 6, axis=-1)
        csh1, csc1, cg1, csh2, csc2, cg2 = jnp.split(cond_ctx @ w_ada[l] + b_ada[l], 6, axis=-1)

        hn_ctx = modulate(rms_norm(h_ctx, norm1[l]), csh1, csc1)
        Bc, Lc, _ = hn_ctx.shape
        if last:
            a_c = hn_ctx @ w_in[l][:, K_OFF:U_OFF]
            kc_raw, vc_raw = a_c[..., :NA_DIM], a_c[..., NA_DIM:]
        else:
            a_c = hn_ctx @ w_in[l]
            kc_raw, vc_raw = a_c[..., K_OFF:V_OFF], a_c[..., V_OFF:U_OFF]
        k_ctx = rms_norm(kc_raw.reshape(Bc, Lc, NA_HEADS, HEAD_DIM), k_norm[l])
        v_ctx = vc_raw.reshape(Bc, Lc, NA_HEADS, HEAD_DIM)

        hn_lat = modulate(rms_norm(h_lat, norm1[l]), sh1, sc1)
        a = hn_lat @ w_in[l]
        B, N, _ = a.shape
        q = rms_norm(a[..., Q_OFF:K_OFF].reshape(B, N, NA_HEADS, HEAD_DIM), q_norm[l])
        k = rms_norm(a[..., K_OFF:V_OFF].reshape(B, N, NA_HEADS, HEAD_DIM), k_norm[l])
        v = a[..., V_OFF:U_OFF].reshape(B, N, NA_HEADS, HEAD_DIM)
        mix_lat = jnp.concatenate([
            pool_mixer(a[..., :Q_OFF], pool_w[l], pool_scale[l]),
            neighbourhood_attention(q, k, v, k_ctx, v_ctx, rpb[l]),
            spatial_gate(a[..., U_OFF:G_OFF], a[..., G_OFF:], sg_w[l], sg_b[l], sg_norm[l]),
        ], axis=-1)
        h_lat = h_lat + g1 * (mix_lat @ w_out[l])
        h_lat = h_lat + g2 * moe(modulate(rms_norm(h_lat, norm2[l]), sh2, sc2),
                                 w_router, b_router, w_gate[l], w_up[l], w_down[l])

        if not last:
            qc = rms_norm(a_c[..., Q_OFF:K_OFF].reshape(Bc, Lc, NA_HEADS, HEAD_DIM), q_norm[l])
            mix_ctx = jnp.concatenate([
                pool_mixer(a_c[..., :Q_OFF], pool_w[l], pool_scale[l]),
                context_attention(qc, k_ctx, v_ctx),
                spatial_gate(a_c[..., U_OFF:G_OFF], a_c[..., G_OFF:], sg_w[l], sg_b[l], sg_norm[l]),
            ], axis=-1)
            h_ctx = h_ctx + cg1 * (mix_ctx @ w_out[l])
            h_ctx = h_ctx + cg2 * moe(modulate(rms_norm(h_ctx, norm2[l]), csh2, csc2),
                                     w_router, b_router, w_gate[l], w_up[l], w_down[l])
    return h_lat
```

```cpp
#include <hip/hip_runtime.h>
#include <cstdio>
#include <cstdint>

constexpr int NTOK = 16384, NCTX = 256, MROWS = NTOK + NCTX, DM = 1024, IN_DIM = 2304;
constexpr int NEXP = 16, DEXP = 512;
constexpr int PQKU_LD = 1536;
constexpr int VT_LD = MROWS;
constexpr float EPS = 1e-6f;
constexpr float LOG2E = 1.4426950408889634f;

#define LAS __attribute__((address_space(3)))
#define GAS __attribute__((address_space(1)))
typedef unsigned short bf16_t;
typedef short bf16x8 __attribute__((ext_vector_type(8)));
typedef short bf16x4 __attribute__((ext_vector_type(4)));
typedef float f32x4 __attribute__((ext_vector_type(4)));
typedef float f32x2 __attribute__((ext_vector_type(2)));
typedef unsigned u32x4 __attribute__((ext_vector_type(4)));
typedef unsigned u32x2 __attribute__((ext_vector_type(2)));

__device__ __forceinline__ unsigned cvt_pk_bf16(float lo, float hi) { unsigned r; asm volatile("v_cvt_pk_bf16_f32 %0, %1, %2" : "=v"(r) : "v"(lo), "v"(hi)); return r; }
__device__ __forceinline__ float bf2f(unsigned short b) { return __builtin_bit_cast(float, (unsigned)b << 16); }
__device__ __forceinline__ float gelu_tanh(float x) {
    const float y = x * (1.0f + 0.044715f * x * x);
    return x * __builtin_amdgcn_rcpf(1.0f + __builtin_amdgcn_exp2f(-2.3022082f * y));
}
__device__ __forceinline__ float silu_f(float x) { return x * __builtin_amdgcn_rcpf(1.0f + __builtin_amdgcn_exp2f(-LOG2E * x)); }
__device__ __forceinline__ float wave_sum(float v) {
#pragma unroll
    for (int o = 1; o < 64; o <<= 1) v += __shfl_xor(v, o);
    return v;
}

namespace pg8 {
constexpr int BM = 256, BK = 64, HALF = 128, HTB = HALF * BK * 2, STAGE_BYTES = 8 * HTB, NXCD = 8, WGM = 8;
__host__ __device__ __forceinline__ int lds_byte(int r, int c) { const int st = (r >> 4) * 2 + (c >> 5), rr = r & 15, cc = c & 31, ob = rr * 64 + cc * 2; return st * 1024 + (ob ^ (((ob >> 9) & 1) << 5)); }
__host__ __device__ __forceinline__ void stage_rc(int b, int& R, int& C) { const int st = b / 1024, sb = b % 1024, swz = sb ^ (((sb >> 9) & 1) << 5); R = (st >> 1) * 16 + swz / 64; C = (st & 1) * 32 + (swz % 64) / 2; }
__host__ __device__ __forceinline__ int perm32(int rho) { const int n = rho >> 4, i = rho & 15; return 8 * (i >> 2) + 4 * n + (i & 3); }

struct Unit { int pm, pn, e; };

__device__ __forceinline__ bool static_unit(int i, int G, int c, int nM, int nN, int& pm, int& pn) {
    const int nwg = nM * nN; const long L = (long)i * G + c; if (L >= nwg) return false;
    int wgid = (int)L; { const int q = nwg / NXCD, r = nwg % NXCD, xcd = wgid % NXCD, off = wgid / NXCD; wgid = (xcd < r ? xcd * (q + 1) : r * (q + 1) + (xcd - r) * q) + off; }
    const int nig = WGM * nN, gid = wgid / nig, fm = gid * WGM, gsz = (nM - fm) < WGM ? (nM - fm) : WGM;
    pm = fm + ((wgid % nig) % gsz); pn = (wgid % nig) / gsz; return true;
}

template <class Epi, class Sched, int BPERM, bool GATHER, int GSH>
__device__ __forceinline__ void gemm_phase(LAS unsigned char* lds, const LAS int* idxl, const int K, const Sched& S, const Epi& E) {
    int tid_ = threadIdx.x; asm volatile("" : "+v"(tid_));
    const int tid = tid_, wid = __builtin_amdgcn_readfirstlane(tid >> 6), lane = tid & 63, wr = wid >> 2, wc = wid & 3, fr = lane & 15, fq = lane >> 4;
    const int nt = K / BK;
    int R_[2], C_[2];
    unsigned voffA[2][2], voffB[2][2];
    const size_t hstep = (size_t)HALF * (size_t)K * 2u;
#pragma unroll
    for (int i = 0; i < 2; ++i) {
        stage_rc(tid * 16 + i * 8192, R_[i], C_[i]);
        const int R = R_[i], C = C_[i];
        voffA[0][i] = (unsigned)(R * K + C) * 2u; voffA[1][i] = 0u;
        if (BPERM == 2) {
#pragma unroll
            for (int bj = 0; bj < 2; ++bj) voffB[bj][i] = (unsigned)((64 * (R >> 5) + 32 * bj + perm32(R & 31)) * K + C) * 2u;
        } else {
            const int Rb = (BPERM == 1) ? ((R & ~31) + perm32(R & 31)) : R;
            voffB[0][i] = (unsigned)(Rb * K + C) * 2u; voffB[1][i] = 0u;
        }
    }
    const size_t kstep = (size_t)(BK * 2);
    const unsigned ldsw = (unsigned)wid * 1024u;
    const int aoff = lds_byte(wr * 64 + fr, fq * 8), boff = lds_byte(wc * 32 + fr, fq * 8);
#define PG8_SA(b, h) (((b) * 2 + (h)) * HTB)
#define PG8_SB(b, h) ((4 + (b) * 2 + (h)) * HTB)
#define PG8_STAGE(bufoff, gbase, voff) do { _Pragma("unroll") for (int _i = 0; _i < 2; ++_i) \
        __builtin_amdgcn_global_load_lds((const unsigned*)((const char*)(gbase) + (voff)[_i]), (LAS unsigned*)(lds + (bufoff) + ldsw + _i * 8192), 16, 0, 0); } while (0)
#define PG8_STA(bufoff, gbase, h) do { if (GATHER) PG8_STAGE(bufoff, gbase, voffA[h]); else PG8_STAGE(bufoff, (gbase) + (h) * hstep, voffA[0]); } while (0)
#define PG8_STB(bufoff, gbase, h) do { if (BPERM == 2) PG8_STAGE(bufoff, gbase, voffB[h]); else PG8_STAGE(bufoff, (gbase) + (h) * hstep, voffB[0]); } while (0)
#define PG8_GLOAD(u_) do { if (GATHER) { _Pragma("unroll") for (int _h = 0; _h < 2; ++_h) _Pragma("unroll") for (int _i = 0; _i < 2; ++_i) \
        voffA[_h][_i] = (unsigned)((((unsigned)idxl[(u_) * 256 + _h * 128 + R_[_i]] & 0x7fffffffu) >> GSH) * (unsigned)K + (unsigned)C_[_i]) * 2u; } } while (0)
#define PG8_LDA(dst, b, h) do { _Pragma("unroll") for (int m = 0; m < 4; ++m) _Pragma("unroll") for (int k = 0; k < 2; ++k) dst[m][k] = *(const LAS bf16x8*)(lds + PG8_SA(b, h) + aoff + m * 2048 + k * 1024); } while (0)
#define PG8_LDB(dst, b, h) do { _Pragma("unroll") for (int n = 0; n < 2; ++n) _Pragma("unroll") for (int k = 0; k < 2; ++k) dst[n][k] = *(const LAS bf16x8*)(lds + PG8_SB(b, h) + boff + n * 2048 + k * 1024); } while (0)
#define PG8_MMA(ai, bj, At, Bt) do { __builtin_amdgcn_s_setprio(1); _Pragma("unroll") for (int m = 0; m < 4; ++m) _Pragma("unroll") for (int n = 0; n < 2; ++n) _Pragma("unroll") for (int k = 0; k < 2; ++k) \
        acc[ai][bj][m][n] = __builtin_amdgcn_mfma_f32_16x16x32_bf16(Bt[n][k], At[m][k], acc[ai][bj][m][n], 0, 0, 0); __builtin_amdgcn_s_setprio(0); } while (0)
#define PG8_WAIT_V(n) asm volatile("s_waitcnt vmcnt(" #n ")" ::: "memory")
#define PG8_WAIT_L(n) asm volatile("s_waitcnt lgkmcnt(" #n ")" ::: "memory")
#define PG8_BAR __builtin_amdgcn_s_barrier()
#define PG8_SCHED __builtin_amdgcn_sched_barrier(0)
    Unit cur, nxt; int ui = 0;
    if (!S.next(0, cur)) return;
    f32x4 acc[2][2][4][2];
#pragma unroll
    for (int a = 0; a < 2; ++a)
#pragma unroll
        for (int b = 0; b < 2; ++b)
#pragma unroll
            for (int m = 0; m < 4; ++m)
#pragma unroll
                for (int n = 0; n < 2; ++n) acc[a][b][m][n] = (f32x4){0.f, 0.f, 0.f, 0.f};
    bf16x8 At[4][2], B0[2][2], B1[2][2];
    const char* cA = S.a_base(cur); const char* cB = S.b_base(cur);
    PG8_GLOAD(0);
    PG8_STB(PG8_SB(0, 0), cB, 0); PG8_STB(PG8_SB(0, 1), cB, 1); PG8_STA(PG8_SA(0, 0), cA, 0); PG8_STA(PG8_SA(0, 1), cA, 1);
    if (wr == 1) PG8_BAR;
    PG8_WAIT_V(2); PG8_BAR;
    PG8_STB(PG8_SB(1, 0), cB + kstep, 0); PG8_STA(PG8_SA(1, 0), cA + kstep, 0); PG8_STB(PG8_SB(1, 1), cB + kstep, 1);
    PG8_WAIT_V(6); PG8_BAR;
    for (;;) {
        const bool has_next = S.next(ui + 1, nxt);
        const char* nA = has_next ? S.a_base(nxt) : cA; const char* nB = has_next ? S.b_base(nxt) : cB;
        for (int t = 0; t < nt; t += 2) {
            const bool last = (t == nt - 2);
            const char* a1 = cA + (size_t)(t + 1) * kstep;
            const char* a2 = last ? nA : cA + (size_t)(t + 2) * kstep; const char* b2 = last ? nB : cB + (size_t)(t + 2) * kstep;
            const char* a3 = a2 + kstep; const char* b3 = b2 + kstep;
            PG8_LDB(B0, 0, 0); PG8_LDB(B1, 0, 1); PG8_SCHED; PG8_LDA(At, 0, 0); PG8_STA(PG8_SA(1, 1), a1, 1);
            if (GATHER) { if (last && has_next) PG8_GLOAD(ui + 1); }
            PG8_WAIT_V(8); PG8_WAIT_L(0); PG8_BAR; PG8_MMA(0, 0, At, B0); PG8_MMA(0, 1, At, B1); PG8_BAR; PG8_SCHED;
            PG8_LDA(At, 0, 1); PG8_STB(PG8_SB(0, 0), b2, 0); PG8_STB(PG8_SB(0, 1), b2, 1); PG8_STA(PG8_SA(0, 0), a2, 0);
            PG8_WAIT_V(8); PG8_WAIT_L(0); PG8_BAR; PG8_MMA(1, 0, At, B0); PG8_MMA(1, 1, At, B1); PG8_BAR; PG8_SCHED;
            PG8_LDB(B0, 1, 0); PG8_LDB(B1, 1, 1); PG8_SCHED; PG8_LDA(At, 1, 0); PG8_STA(PG8_SA(0, 1), a2, 1);
            PG8_WAIT_V(8); PG8_WAIT_L(0); PG8_BAR; PG8_MMA(0, 0, At, B0); PG8_MMA(0, 1, At, B1); PG8_BAR; PG8_SCHED;
            PG8_LDA(At, 1, 1); PG8_STB(PG8_SB(1, 0), b3, 0); PG8_STB(PG8_SB(1, 1), b3, 1); PG8_STA(PG8_SA(1, 0), a3, 0);
            PG8_WAIT_V(8); PG8_WAIT_L(0); PG8_BAR; PG8_MMA(1, 0, At, B0); PG8_MMA(1, 1, At, B1); PG8_BAR; PG8_SCHED;
        }
        if (wr == 0) PG8_BAR;
        E(acc, cur, ui, wr, wc, fr, fq);
        if (!has_next) break;
#pragma unroll
        for (int a = 0; a < 2; ++a)
#pragma unroll
            for (int b = 0; b < 2; ++b)
#pragma unroll
                for (int m = 0; m < 4; ++m)
#pragma unroll
                    for (int n = 0; n < 2; ++n) acc[a][b][m][n] = (f32x4){0.f, 0.f, 0.f, 0.f};
        cur = nxt; cA = nA; cB = nB; ++ui;
        if (wr == 1) PG8_BAR;
    }
    PG8_WAIT_V(0);
    PG8_BAR;
#undef PG8_SA
#undef PG8_SB
#undef PG8_STAGE
#undef PG8_GLOAD
#undef PG8_STA
#undef PG8_STB
#undef PG8_LDA
#undef PG8_LDB
#undef PG8_MMA
#undef PG8_WAIT_V
#undef PG8_WAIT_L
#undef PG8_BAR
#undef PG8_SCHED
}
}

constexpr size_t MiB = 1u << 20;
constexpr size_t WS_CTL = 0, CTL_ZERO_BYTES = 1 * MiB;
constexpr size_t WS_SMALL = 1 * MiB;
constexpr size_t WS_LIST = 4 * MiB;
constexpr size_t WS_GW = 7 * MiB;
constexpr size_t WS_HCTX = 8 * MiB;
constexpr size_t WS_WIN = 10 * MiB;
constexpr size_t WS_WOUT = 19 * MiB;
constexpr size_t WS_WGU = 24 * MiB;
constexpr size_t WS_WDN = 88 * MiB;
constexpr size_t WS_XN = 120 * MiB;
constexpr size_t WS_PQKU = 153 * MiB;
constexpr size_t WS_VT = 202 * MiB;
constexpr size_t WS_Y = WS_PQKU;
constexpr size_t WS_MIX = 227 * MiB;
constexpr size_t WS_H = WS_MIX;
constexpr size_t WS_END = 260 * MiB;
static_assert(WS_PQKU + (size_t)MROWS * PQKU_LD * 2 <= WS_VT && WS_VT + (size_t)768 * VT_LD * 2 <= WS_MIX && WS_Y + (size_t)2 * MROWS * DM * 2 <= WS_MIX && WS_MIX + (size_t)MROWS * DM * 2 <= WS_END, "ws map");
static_assert(WS_XN + (size_t)MROWS * DM * 2 <= WS_PQKU && WS_WDN + (size_t)2 * 16 * 1024 * 512 * 2 <= WS_XN && WS_WGU + (size_t)2 * 16 * 1024 * 1024 * 2 <= WS_WDN, "ws map 2");
constexpr int CW_BAR = 4096;
constexpr int CW_CNT = 8192;
constexpr int CW_MOD = 16384;
static_assert((CW_MOD + 4 * 6144) * 4 <= (int)CTL_ZERO_BYTES, "ctl");
constexpr size_t SM_SGW = 0;
constexpr size_t SM_POOLT = 256 * 1024;
constexpr size_t SM_B2 = 320 * 1024;
constexpr int LIST_CAP = 2 * MROWS;

constexpr int RING_BYTES = 131072;
constexpr int IDX_OFF = RING_BYTES;
constexpr int MISC_OFF = IDX_OFF + 8192;
constexpr int LDS_BYTES = 147456;
constexpr int NWAVES = 8;

#define XB_TMO      128
#define XB_XCNT(j)  (256  + 64 * (j))
#define XB_XSUB(j)  (1280 + 64 * (j))
#define XB_XGEN(j)  (2304 + 64 * (j))
#define XB_TOP      3328
#define XB_TOPGEN   3392
#define XCD_BAR_WORDS 3456
#define XB_SPIN_CAP (1u << 18)
__device__ __forceinline__ unsigned xb_ld(unsigned* p)              { return __hip_atomic_load(p, __ATOMIC_RELAXED, __HIP_MEMORY_SCOPE_AGENT); }
__device__ __forceinline__ unsigned xb_add(unsigned* p, unsigned v) { return __hip_atomic_fetch_add(p, v, __ATOMIC_RELAXED, __HIP_MEMORY_SCOPE_AGENT); }
__device__ __forceinline__ unsigned xb_xcc_id() { return (unsigned)__builtin_amdgcn_s_getreg((3 << 11) | 20) & 0xFu; }
#define XB_SPIN(cond, bar) do { unsigned _sp = 0; while (cond) { __builtin_amdgcn_s_sleep(1); \
    if ((++_sp & 255u) == 0u) { if (xb_ld(&(bar)[XB_TMO])) break; if (_sp > XB_SPIN_CAP) { atomicAdd(&(bar)[XB_TMO], 1u); break; } } } } while (0)
struct XcdBarrier { unsigned* bar; unsigned x; volatile LAS unsigned* st; };
__device__ __forceinline__ XcdBarrier xcd_barrier_post(unsigned* bar, volatile LAS unsigned* st) {
    XcdBarrier b; b.bar = bar; b.x = xb_xcc_id(); b.st = st;
    if (threadIdx.x == 0) (void)xb_add(&bar[XB_XCNT(b.x)], 1u);
    return b;
}
__device__ __forceinline__ void xcd_barrier_complete(unsigned* bar, unsigned x, unsigned& nloc, unsigned& nx) {
    const unsigned G = gridDim.x * gridDim.y * gridDim.z;
    unsigned sum, cnt, mine, sp = 0u;
    for (;;) {
        sum = 0u; cnt = 0u; mine = 0u;
#pragma unroll
        for (unsigned j = 0; j < 16; ++j) { const unsigned c = xb_ld(&bar[XB_XCNT(j)]); sum += c; cnt += (c > 0u) ? 1u : 0u; mine = (j == x) ? c : mine; }
        if (sum == G) break;
        __builtin_amdgcn_s_sleep(1);
        if ((++sp & 255u) == 0u) { if (xb_ld(&bar[XB_TMO])) break; if (sp > XB_SPIN_CAP) { atomicAdd(&bar[XB_TMO], 1u); break; } }
    }
    nloc = mine > 0u ? mine : 1u; nx = cnt > 0u ? cnt : 1u;
}
__device__ __forceinline__ void xcd_barrier(const XcdBarrier& b) {
    asm volatile("s_waitcnt vmcnt(0)" ::: "memory");
    __syncthreads();
    if (threadIdx.x == 0) {
        unsigned* bar = b.bar;
        __builtin_amdgcn_s_waitcnt(0);
        unsigned nloc = b.st[0], nx = b.st[1];
        if (nloc == 0u) { xcd_barrier_complete(bar, b.x, nloc, nx); b.st[0] = nloc; b.st[1] = nx; }
        const unsigned old = xb_add(&bar[XB_XSUB(b.x)], 1u);
        const unsigned gen = old / nloc;
        if (old + 1u == (gen + 1u) * nloc) {
            __builtin_amdgcn_fence(__ATOMIC_RELEASE, "agent");
            asm volatile("s_waitcnt vmcnt(0)" ::: "memory");
            const unsigned og = xb_add(&bar[XB_TOP], 1u);
            const unsigned tg = og / nx;
            if (og + 1u == (tg + 1u) * nx) xb_add(&bar[XB_TOPGEN], 1u);
            else XB_SPIN(xb_ld(&bar[XB_TOPGEN]) == tg, bar);
            __builtin_amdgcn_fence(__ATOMIC_ACQUIRE, "agent");
            xb_add(&bar[XB_XGEN(b.x)], 1u);
            asm volatile("s_waitcnt vmcnt(0)" ::: "memory");
        } else {
            XB_SPIN(xb_ld(&bar[XB_XGEN(b.x)]) == gen, bar);
            __builtin_amdgcn_fence(__ATOMIC_ACQUIRE, "agent");
            asm volatile("s_waitcnt vmcnt(0)" ::: "memory");
        }
    }
    __syncthreads();
}

struct Args {
    const float *x, *c, *ctx, *c_ctx, *w_ada, *b_ada, *norm1, *w_in, *pool_w, *pool_scale, *q_norm, *k_norm, *rpb, *sg_w, *sg_b, *sg_norm, *w_out, *norm2, *w_router, *b_router, *w_gate, *w_up, *w_down;
    float* out; unsigned char* ws;
};
struct Frame {
    LAS unsigned char* lds;
    int tid, lane, wave, vcu, G;
};
__device__ __forceinline__ Frame fresh(const Frame& F0) { Frame F = F0; asm volatile("" : "+v"(F.tid), "+v"(F.lane), "+s"(F.wave), "+s"(F.vcu), "+s"(F.G)); return F; }
typedef const __attribute__((address_space(4))) Args* KArgs;
__device__ __forceinline__ KArgs get_args() { KArgs p = (KArgs)__builtin_amdgcn_kernarg_segment_ptr(); asm volatile("" : "+s"(p)); return p; }

__device__ __forceinline__ unsigned f2bf(float f) { unsigned u = __builtin_bit_cast(unsigned, f); return (u + 0x7fffu + ((u >> 16) & 1u)) >> 16; }
__device__ __forceinline__ unsigned pk2(float lo, float hi) { return f2bf(lo) | (f2bf(hi) << 16); }
__device__ __forceinline__ void p0_transpose_item(const float* W, int K, int N, bf16_t* WT, int k0, int n0, int drow0, LAS float* scr, int lane) {
#pragma unroll 8
    for (int i = 0; i < 32; ++i) { const int kk = 2 * i + (lane >> 5); scr[kk * 33 + (lane & 31)] = W[(size_t)(k0 + kk) * N + n0 + (lane & 31)]; }
    asm volatile("s_waitcnt lgkmcnt(0)" ::: "memory");
    const int c = lane & 7;
#pragma unroll
    for (int j = 0; j < 4; ++j) { const int n = (lane >> 3) + 8 * j; const LAS float* s = scr + (8 * c) * 33 + n;
        u32x4 o; o.x = pk2(s[0 * 33], s[1 * 33]); o.y = pk2(s[2 * 33], s[3 * 33]); o.z = pk2(s[4 * 33], s[5 * 33]); o.w = pk2(s[6 * 33], s[7 * 33]);
        *(u32x4*)(WT + (size_t)(drow0 + n) * K + k0 + 8 * c) = o; }
    asm volatile("s_waitcnt lgkmcnt(0)" ::: "memory");
}
__device__ __forceinline__ int win_dst_row(int n) { return n < 1280 ? n : (n < 1792 ? 1536 + (n - 1280) : (n < 2048 ? 1280 + (n - 1792) : n)); }

__device__ __forceinline__ void p0_prologue(KArgs Ap, const Frame& F0) {
    const Frame F = fresh(F0);
    unsigned char* ws = Ap->ws;
    LAS float* scr = (LAS float*)(F.lds + F.wave * 16384);
    const int gw = F.vcu * NWAVES + F.wave, NGW = F.G * NWAVES;
    const int lane = F.lane;
    float* mod = (float*)(ws + WS_CTL) + CW_MOD;
    for (int it = gw; it < 2 * 24 * 8; it += NGW) {
        const int l = it / (24 * 8), r = it % (24 * 8), nb = r / 8, sb = r % 8;
        const int kq = lane >> 3, c4 = (lane & 7) * 4;
        const float* W = Ap->w_ada + (size_t)l * DM * 6144 + nb * 256 + sb * 32 + c4;
        f32x4 a0 = (f32x4){0.f, 0.f, 0.f, 0.f}, a1 = a0;
#pragma unroll 4
        for (int k = kq; k < DM; k += 8) {
            const float c0 = silu_f(Ap->c[k]), c1 = silu_f(Ap->c_ctx[k]);
            const f32x4 w = *(const f32x4*)(W + (size_t)k * 6144);
            a0 += w * c0; a1 += w * c1;
        }
#pragma unroll
        for (int j = 0; j < 4; ++j) { float x0 = a0[j], x1 = a1[j];
            x0 += __shfl_xor(x0, 8); x0 += __shfl_xor(x0, 16); x0 += __shfl_xor(x0, 32); x1 += __shfl_xor(x1, 8); x1 += __shfl_xor(x1, 16); x1 += __shfl_xor(x1, 32); a0[j] = x0; a1[j] = x1; }
        if (kq == 0) { const f32x4 b = *(const f32x4*)(Ap->b_ada + l * 6144 + nb * 256 + sb * 32 + c4);
            *(f32x4*)(mod + (l * 2 + 0) * 6144 + nb * 256 + sb * 32 + c4) = a0 + b; *(f32x4*)(mod + (l * 2 + 1) * 6144 + nb * 256 + sb * 32 + c4) = a1 + b; }
    }
    constexpr int I_IN = 16 * 72, I_OUT = 16 * 32, I_G = 16 * 16, I_D = 8 * 32;
    constexpr int PER_L = I_IN + I_OUT + 16 * (2 * I_G + I_D);
    for (int it = gw; it < 2 * PER_L; it += NGW) {
        const int l = it / PER_L; int r = it % PER_L;
        if (r < I_IN) { const int kb = r / 72, nb = r % 72;
            p0_transpose_item(Ap->w_in + (size_t)l * DM * IN_DIM, DM, IN_DIM, (bf16_t*)(ws + WS_WIN) + (size_t)l * IN_DIM * DM, kb * 64, nb * 32, win_dst_row(nb * 32), scr, lane); continue; }
        r -= I_IN;
        if (r < I_OUT) { const int kb = r / 32, nb = r % 32;
            p0_transpose_item(Ap->w_out + (size_t)l * DM * DM, DM, DM, (bf16_t*)(ws + WS_WOUT) + (size_t)l * DM * DM, kb * 64, nb * 32, nb * 32, scr, lane); continue; }
        r -= I_OUT;
        const int e = r / (2 * I_G + I_D); r = r % (2 * I_G + I_D);
        if (r < 2 * I_G) { const int up = r / I_G; r = r % I_G; const int kb = r / 16, nb = r % 16; const int j0 = nb * 32;
            const float* src = (up ? Ap->w_up : Ap->w_gate) + ((size_t)l * NEXP + e) * DM * DEXP;
            p0_transpose_item(src, DM, DEXP, (bf16_t*)(ws + WS_WGU) + ((size_t)l * NEXP + e) * 1024 * 1024, kb * 64, j0, (j0 >> 7) * 256 + (j0 & 127) + (up ? 128 : 0), scr, lane); continue; }
        r -= 2 * I_G;
        { const int kb = r / 32, nb = r % 32;
            p0_transpose_item(Ap->w_down + ((size_t)l * NEXP + e) * DEXP * DM, DEXP, DM, (bf16_t*)(ws + WS_WDN) + ((size_t)l * NEXP + e) * 1024 * 512, kb * 64, nb * 32, nb * 32, scr, lane); }
    }
    const int gt = F.vcu * NWAVES * 64 + F.tid, NGT = F.G * NWAVES * 64;
    bf16_t* sgw = (bf16_t*)(ws + WS_SMALL + SM_SGW);
    for (int i = gt; i < 2 * 4 * 128 * 128; i += NGT) sgw[i] = (bf16_t)f2bf(Ap->sg_w[i]);
    bf16_t* poolt = (bf16_t*)(ws + WS_SMALL + SM_POOLT);
    for (int i = gt; i < 2 * 4 * 64 * 64; i += NGT) { const int lg = i >> 12, d = (i >> 6) & 63, c = i & 63; poolt[i] = (bf16_t)f2bf(Ap->pool_w[(lg << 12) + c * 64 + d]); }
    if (gw < 16) {
        const int l = gw >> 3, h = gw & 7;
        float mq = fabsf(Ap->q_norm[(l * 8 + h) * 64 + lane]), mk = fabsf(Ap->k_norm[(l * 8 + h) * 64 + lane]), mb = 0.f;
        for (int i = lane; i < 15 * 31; i += 64) mb = fmaxf(mb, fabsf(Ap->rpb[(l * 8 + h) * 465 + i]));
#pragma unroll
        for (int o = 1; o < 64; o <<= 1) { mq = fmaxf(mq, __shfl_xor(mq, o)); mk = fmaxf(mk, __shfl_xor(mk, o)); mb = fmaxf(mb, __shfl_xor(mb, o)); }
        if (lane == 0) ((float*)(ws + WS_SMALL + SM_B2))[gw] = LOG2E * (8.0f * mq * mk + mb);
    }
}

__device__ __forceinline__ const float* modp(KArgs Ap, int l, int cls) { return (const float*)(Ap->ws + WS_CTL) + CW_MOD + (l * 2 + cls) * 6144; }

__device__ __forceinline__ void phase_n1(KArgs Ap, const Frame& F0, int l) {
    const Frame F = fresh(F0);
    const int gw = F.vcu * NWAVES + F.wave, NGW = F.G * NWAVES, lane = F.lane;
    bf16_t* XN = (bf16_t*)(Ap->ws + WS_XN); const bf16_t* Y = (const bf16_t*)(Ap->ws + WS_Y); float* hctx = (float*)(Ap->ws + WS_HCTX);
    for (int row = gw; row < MROWS; row += NGW) {
        const int cls = row >= NTOK;
        const float* src = (l == 0) ? (cls ? Ap->ctx + (size_t)(row - NTOK) * DM : Ap->x + (size_t)row * DM) : (cls ? hctx + (size_t)(row - NTOK) * DM : Ap->out + (size_t)row * DM);
        float* dst = cls ? hctx + (size_t)(row - NTOK) * DM : Ap->out + (size_t)row * DM;
        f32x4 v[4]; float ss = 0.f;
#pragma unroll
        for (int j = 0; j < 4; ++j) v[j] = *(const f32x4*)(src + lane * 4 + 256 * j);
        if (l > 0) {
#pragma unroll
            for (int j = 0; j < 4; ++j) {
                const bf16x4 y0 = *(const bf16x4*)(Y + (size_t)(2 * row) * DM + lane * 4 + 256 * j), y1 = *(const bf16x4*)(Y + (size_t)(2 * row + 1) * DM + lane * 4 + 256 * j);
#pragma unroll
                for (int q = 0; q < 4; ++q) v[j][q] += bf2f((unsigned short)y0[q]) + bf2f((unsigned short)y1[q]);
                *(f32x4*)(dst + lane * 4 + 256 * j) = v[j];
            }
        }
#pragma unroll
        for (int j = 0; j < 4; ++j) ss += (v[j].x * v[j].x + v[j].y * v[j].y) + (v[j].z * v[j].z + v[j].w * v[j].w);
        const float r = 1.0f / sqrtf(wave_sum(ss) * (1.0f / DM) + EPS);
        const float* md = modp(Ap, l, cls);
#pragma unroll
        for (int j = 0; j < 4; ++j) {
            const int k = lane * 4 + 256 * j;
            const f32x4 nw = *(const f32x4*)(Ap->norm1 + l * DM + k), sh = *(const f32x4*)(md + k), sc = *(const f32x4*)(md + 1024 + k);
            const f32x4 hn = v[j] * r * nw * (sc + 1.0f) + sh;
            u32x2 w; w.x = cvt_pk_bf16(hn.x, hn.y); w.y = cvt_pk_bf16(hn.z, hn.w);
            *(u32x2*)(XN + (size_t)row * DM + k) = w;
        }
    }
}
__device__ __forceinline__ void phase_final(KArgs Ap, const Frame& F0) {
    const Frame F = fresh(F0);
    const int gw = F.vcu * NWAVES + F.wave, NGW = F.G * NWAVES, lane = F.lane;
    const bf16_t* Y = (const bf16_t*)(Ap->ws + WS_Y);
    for (int row = gw; row < NTOK; row += NGW) {
        float* dst = Ap->out + (size_t)row * DM;
#pragma unroll
        for (int j = 0; j < 4; ++j) {
            f32x4 v = *(const f32x4*)(dst + lane * 4 + 256 * j);
            const bf16x4 y0 = *(const bf16x4*)(Y + (size_t)(2 * row) * DM + lane * 4 + 256 * j), y1 = *(const bf16x4*)(Y + (size_t)(2 * row + 1) * DM + lane * 4 + 256 * j);
#pragma unroll
            for (int q = 0; q < 4; ++q) v[q] += bf2f((unsigned short)y0[q]) + bf2f((unsigned short)y1[q]);
            *(f32x4*)(dst + lane * 4 + 256 * j) = v;
        }
    }
}

__device__ __forceinline__ void phase_n2(KArgs Ap, const Frame& F0, int l) {
    const Frame F = fresh(F0);
    const int lane = F.lane;
    bf16_t* XN = (bf16_t*)(Ap->ws + WS_XN); float* hctx = (float*)(Ap->ws + WS_HCTX);
    LAS int* cntL = (LAS int*)(F.lds);
    LAS int* baseL = cntL + 16;
    LAS int* listL = cntL + 32;
    int* glist = (int*)(Ap->ws + WS_LIST); float* gwt = (float*)(Ap->ws + WS_GW);
    unsigned* gcnt = (unsigned*)(Ap->ws + WS_CTL) + CW_CNT + l * 16;
    if (F.tid < 16) cntL[F.tid] = 0;
    __syncthreads();
    const int nrows = (l == 0) ? MROWS : NTOK, rpb = nrows / F.G;
    const int r0 = F.vcu * rpb, r1 = (F.vcu == F.G - 1) ? nrows : r0 + rpb;
    for (int row = r0 + F.wave; row < r1; row += NWAVES) {
        const int cls = row >= NTOK;
        const float* src = cls ? hctx + (size_t)(row - NTOK) * DM : Ap->out + (size_t)row * DM;
        f32x4 v[4]; float ss = 0.f;
#pragma unroll
        for (int j = 0; j < 4; ++j) { v[j] = *(const f32x4*)(src + lane * 4 + 256 * j); ss += (v[j].x * v[j].x + v[j].y * v[j].y) + (v[j].z * v[j].z + v[j].w * v[j].w); }
        const float r = 1.0f / sqrtf(wave_sum(ss) * (1.0f / DM) + EPS);
        const float* md = modp(Ap, l, cls);
        float lg[16];
#pragma unroll
        for (int e = 0; e < 16; ++e) lg[e] = 0.f;
#pragma unroll
        for (int j = 0; j < 4; ++j) {
            const int k = lane * 4 + 256 * j;
            const f32x4 nw = *(const f32x4*)(Ap->norm2 + l * DM + k), sh = *(const f32x4*)(md + 3072 + k), sc = *(const f32x4*)(md + 4096 + k);
            const f32x4 hn = v[j] * r * nw * (sc + 1.0f) + sh;
            u32x2 w; w.x = cvt_pk_bf16(hn.x, hn.y); w.y = cvt_pk_bf16(hn.z, hn.w);
            *(u32x2*)(XN + (size_t)row * DM + k) = w;
#pragma unroll
            for (int q = 0; q < 4; ++q) {
                const float* wr_ = Ap->w_router + (size_t)(k + q) * 16;
#pragma unroll
                for (int e4 = 0; e4 < 4; ++e4) { const f32x4 ww = *(const f32x4*)(wr_ + e4 * 4);
                    lg[e4 * 4 + 0] += hn[q] * ww.x; lg[e4 * 4 + 1] += hn[q] * ww.y; lg[e4 * 4 + 2] += hn[q] * ww.z; lg[e4 * 4 + 3] += hn[q] * ww.w; }
            }
        }
        float mx = -3.0e38f;
#pragma unroll
        for (int e = 0; e < 16; ++e) { lg[e] = wave_sum(lg[e]) + Ap->b_router[e]; mx = fmaxf(mx, lg[e]); }
        float p[16];
#pragma unroll
        for (int e = 0; e < 16; ++e) p[e] = __expf(lg[e] - mx);
        float gs[4];
#pragma unroll
        for (int g = 0; g < 4; ++g) { const float a = p[4 * g], b = p[4 * g + 1], c = p[4 * g + 2], d = p[4 * g + 3];
            const float h1 = fmaxf(a, b), l1 = fminf(a, b), h2 = fmaxf(c, d), l2 = fminf(c, d);
            gs[g] = fmaxf(h1, h2) + fmaxf(fminf(h1, h2), fmaxf(l1, l2)); }
        int bg = 0; float bv = gs[0];
#pragma unroll
        for (int g = 1; g < 4; ++g) if (gs[g] > bv) { bv = gs[g]; bg = g; }
        float xg[4];
#pragma unroll
        for (int i = 0; i < 4; ++i) xg[i] = (bg == 0) ? p[i] : (bg == 1) ? p[4 + i] : (bg == 2) ? p[8 + i] : p[12 + i];
        int i1 = 0; float v1 = xg[0];
#pragma unroll
        for (int i = 1; i < 4; ++i) if (xg[i] > v1) { v1 = xg[i]; i1 = i; }
        int i2 = -1; float v2 = -1.f;
#pragma unroll
        for (int i = 0; i < 4; ++i) if (i != i1 && xg[i] > v2) { v2 = xg[i]; i2 = i; }
        const float inv = 1.0f / (v1 + v2);
        if (lane == 0) {
            const int e1 = bg * 4 + i1, e2 = bg * 4 + i2;
            const int p1 = __hip_atomic_fetch_add(cntL + e1, 1, __ATOMIC_RELAXED, __HIP_MEMORY_SCOPE_WORKGROUP); listL[e1 * 136 + p1] = 2 * row;
            const int p2 = __hip_atomic_fetch_add(cntL + e2, 1, __ATOMIC_RELAXED, __HIP_MEMORY_SCOPE_WORKGROUP); listL[e2 * 136 + p2] = 2 * row + 1;
            gwt[2 * row] = v1 * inv; gwt[2 * row + 1] = v2 * inv;
        }
    }
    __syncthreads();
    if (F.tid < 16) baseL[F.tid] = (int)__hip_atomic_fetch_add(gcnt + F.tid, (unsigned)cntL[F.tid], __ATOMIC_RELAXED, __HIP_MEMORY_SCOPE_AGENT);
    __syncthreads();
    for (int e = 0; e < 16; ++e) { const int n = cntL[e], b = baseL[e];
        for (int i = F.tid; i < n; i += NWAVES * 64) glist[(size_t)e * LIST_CAP + b + i] = listL[e * 136 + i]; }
    __syncthreads();
}

__device__ __forceinline__ bf16x8 ld8(const bf16_t* p) { return *(const bf16x8*)p; }
__device__ __forceinline__ bf16x8 ld4x2(const bf16_t* p0, const bf16_t* p1) { const bf16x4 a = *(const bf16x4*)p0, b = *(const bf16x4*)p1; return (bf16x8){a[0], a[1], a[2], a[3], b[0], b[1], b[2], b[3]}; }
#define MFMA16(a, b, c) __builtin_amdgcn_mfma_f32_16x16x32_bf16((a), (b), (c), 0, 0, 0)

__device__ __forceinline__ void attn_item(KArgs Ap, int l, bool lat, int r, int j, int qt0, int h, int lane) {
    const bf16_t* PQKU = (const bf16_t*)(Ap->ws + WS_PQKU); const bf16_t* VT = (const bf16_t*)(Ap->ws + WS_VT); bf16_t* mix = (bf16_t*)(Ap->ws + WS_MIX);
    const int fr = lane & 15, g = lane >> 4;
    const float B2 = ((const float*)(Ap->ws + WS_SMALL + SM_B2))[l * 8 + h];
    const bf16_t* qp = PQKU + (size_t)(qt0 + fr) * PQKU_LD + 256 + h * 64 + 8 * g;
    const bf16x8 q0 = ld8(qp), q1 = ld8(qp + 32);
    const int rs = min(max(r - 4, 0), 248);
    const int c = 16 * j + fr, cs = min(max(c - 8, 0), 48);
    const int kb_lo = (j <= 1) ? 0 : j - 1, nkb = (j == 0 || j == 3) ? 2 : 3;
    const int nloc = lat ? 8 * nkb : 0, nblk = nloc + 16;
    const float* rpbh = Ap->rpb + (size_t)(l * 8 + h) * 465;
    f32x4 O[4]; float lsum = 0.f;
#pragma unroll
    for (int d = 0; d < 4; ++d) O[d] = (f32x4){0.f, 0.f, 0.f, 0.f};
    const bf16_t* vrow = VT + (size_t)(h * 64 + fr) * VT_LD + 4 * g;
    for (int b = 0; b < nblk; b += 2) {
        float pp[8]; int tok0[2];
#pragma unroll
        for (int s = 0; s < 2; ++s) {
            const int bb = b + s; const bool loc = bb < nloc;
            const int a = bb / nkb, kb = kb_lo + bb % nkb;
            tok0[s] = loc ? (rs + a) * 64 + 16 * kb : NTOK + 16 * (bb - nloc);
            const bf16_t* kp = PQKU + (size_t)(tok0[s] + fr) * PQKU_LD + 768 + h * 64 + 8 * g;
            f32x4 S = MFMA16(ld8(kp), q0, ((f32x4){0.f, 0.f, 0.f, 0.f}));
            S = MFMA16(ld8(kp + 32), q1, S);
#pragma unroll
            for (int i = 0; i < 4; ++i) {
                float pv;
                if (loc) {
                    const int kc = 16 * kb + 4 * g + i; const bool valid = (kc >= cs) && (kc < cs + 16);
                    const int dc = min(max(kc - c + 15, 0), 30), dr = rs + a - r + 7;
                    const float bias = rpbh[dr * 31 + dc] * LOG2E;
                    pv = valid ? __builtin_amdgcn_exp2f(S[i] + bias - B2) : 0.f;
                } else pv = __builtin_amdgcn_exp2f(S[i] - B2);
                pp[s * 4 + i] = pv; lsum += pv;
            }
        }
        u32x4 pw; pw.x = cvt_pk_bf16(pp[0], pp[1]); pw.y = cvt_pk_bf16(pp[2], pp[3]); pw.z = cvt_pk_bf16(pp[4], pp[5]); pw.w = cvt_pk_bf16(pp[6], pp[7]);
        const bf16x8 P = __builtin_bit_cast(bf16x8, pw);
#pragma unroll
        for (int d = 0; d < 4; ++d) {
            const bf16_t* vp = vrow + (size_t)(16 * d) * VT_LD;
            O[d] = MFMA16(ld4x2(vp + tok0[0], vp + tok0[1]), P, O[d]);
        }
    }
    lsum += __shfl_xor(lsum, 16); lsum += __shfl_xor(lsum, 32);
    const float inv = 1.0f / lsum;
    bf16_t* op = mix + (size_t)(qt0 + fr) * DM + 256 + h * 64 + 4 * g;
#pragma unroll
    for (int d = 0; d < 4; ++d) { u32x2 w; w.x = cvt_pk_bf16(O[d][0] * inv, O[d][1] * inv); w.y = cvt_pk_bf16(O[d][2] * inv, O[d][3] * inv); *(u32x2*)(op + 16 * d) = w; }
}
__device__ __forceinline__ void pool_item(KArgs Ap, int l, int t0, int g4, int lane) {
    const bf16_t* PQKU = (const bf16_t*)(Ap->ws + WS_PQKU); bf16_t* mix = (bf16_t*)(Ap->ws + WS_MIX);
    const bf16_t* WT = (const bf16_t*)(Ap->ws + WS_SMALL + SM_POOLT) + (size_t)(l * 4 + g4) * 4096;
    const int fr = lane & 15, gq = lane >> 4;
    const int t = t0 + fr, base = (t >= NTOK) ? NTOK : 0, L = (t >= NTOK) ? NCTX : NTOK, tt = t - base;
    const int hw = 1 << g4;
    const int lo = max(tt - hw, 0), hi = min(tt + hw, L);
    const float invn = 1.0f / (float)(hi - lo);
    bf16x8 Bf[2];
#pragma unroll
    for (int s = 0; s < 2; ++s) {
        const int c0 = g4 * 64 + 32 * s + 8 * gq;
        float acc8[8];
#pragma unroll
        for (int q = 0; q < 8; ++q) acc8[q] = 0.f;
        for (int u = lo; u < hi; ++u) { const bf16x8 vv = ld8(PQKU + (size_t)(base + u) * PQKU_LD + c0);
#pragma unroll
            for (int q = 0; q < 8; ++q) acc8[q] += bf2f((unsigned short)vv[q]); }
        const bf16x8 self = ld8(PQKU + (size_t)t * PQKU_LD + c0);
        u32x4 w;
        float dq[8];
#pragma unroll
        for (int q = 0; q < 8; ++q) dq[q] = acc8[q] * invn - bf2f((unsigned short)self[q]);
        w.x = cvt_pk_bf16(dq[0], dq[1]); w.y = cvt_pk_bf16(dq[2], dq[3]); w.z = cvt_pk_bf16(dq[4], dq[5]); w.w = cvt_pk_bf16(dq[6], dq[7]);
        Bf[s] = __builtin_bit_cast(bf16x8, w);
    }
#pragma unroll
    for (int mb = 0; mb < 4; ++mb) {
        const bf16_t* wp = WT + (size_t)(16 * mb + fr) * 64 + 8 * gq;
        f32x4 o = MFMA16(ld8(wp), Bf[0], ((f32x4){0.f, 0.f, 0.f, 0.f}));
        o = MFMA16(ld8(wp + 32), Bf[1], o);
        const f32x4 ps = *(const f32x4*)(Ap->pool_scale + l * 256 + g4 * 64 + 16 * mb + 4 * gq);
        u32x2 w; w.x = cvt_pk_bf16(o[0] * ps[0], o[1] * ps[1]); w.y = cvt_pk_bf16(o[2] * ps[2], o[3] * ps[3]);
        *(u32x2*)(mix + (size_t)t * DM + g4 * 64 + 16 * mb + 4 * gq) = w;
    }
}
__device__ __forceinline__ void sg_item(KArgs Ap, int l, int ch, int h, int pb, int lane) {
    const bf16_t* PQKU = (const bf16_t*)(Ap->ws + WS_PQKU); const bf16_t* VT = (const bf16_t*)(Ap->ws + WS_VT); bf16_t* mix = (bf16_t*)(Ap->ws + WS_MIX);
    const bf16_t* W = (const bf16_t*)(Ap->ws + WS_SMALL + SM_SGW) + (size_t)(l * 4 + h) * 16384;
    const int fr = lane & 15, gq = lane >> 4;
    const int p = 16 * pb + fr, tok = ch * 128 + p;
    f32x4 acc[4];
#pragma unroll
    for (int mb = 0; mb < 4; ++mb) acc[mb] = (f32x4){0.f, 0.f, 0.f, 0.f};
#pragma unroll
    for (int s = 0; s < 4; ++s) {
        const bf16x8 Bf = ld8(W + (size_t)p * 128 + 32 * s + 8 * gq);
#pragma unroll
        for (int mb = 0; mb < 4; ++mb) acc[mb] = MFMA16(ld8(VT + (size_t)(512 + h * 64 + 16 * mb + fr) * VT_LD + ch * 128 + 32 * s + 8 * gq), Bf, acc[mb]);
    }
    const float bias = Ap->sg_b[(l * 4 + h) * 128 + p];
#pragma unroll
    for (int mb = 0; mb < 4; ++mb) {
        const bf16x4 u4 = *(const bf16x4*)(PQKU + (size_t)tok * PQKU_LD + 1280 + h * 64 + 16 * mb + 4 * gq);
        u32x2 w; w.x = cvt_pk_bf16(bf2f((unsigned short)u4[0]) * (acc[mb][0] + bias), bf2f((unsigned short)u4[1]) * (acc[mb][1] + bias));
        w.y = cvt_pk_bf16(bf2f((unsigned short)u4[2]) * (acc[mb][2] + bias), bf2f((unsigned short)u4[3]) * (acc[mb][3] + bias));
        *(u32x2*)(mix + (size_t)tok * DM + 768 + h * 64 + 16 * mb + 4 * gq) = w;
    }
}
__device__ __forceinline__ void phase_mix(KArgs Ap, const Frame& F0, int l) {
    const Frame F = fresh(F0);
    const int gw = F.vcu * NWAVES + F.wave, NGW = F.G * NWAVES, lane = F.lane;
    const int nrow_t = (l == 0) ? MROWS : NTOK;
    const int n_att = 256 * 8 * 4, n_actx = (l == 0) ? 16 * 8 : 0, n_pool = (nrow_t / 16) * 4, n_sg = (nrow_t / 128) * 4 * 8;
    const int total = n_att + n_actx + n_pool + n_sg;
    for (int it = gw; it < total; it += NGW) {
        int r = it;
        if (r < n_att) { const int j = r & 3, h = (r >> 2) & 7, row = r >> 5; attn_item(Ap, l, true, row, j, row * 64 + 16 * j, h, lane); continue; }
        r -= n_att;
        if (r < n_actx) { const int h = r & 7, qb = r >> 3; attn_item(Ap, l, false, 0, 0, NTOK + 16 * qb, h, lane); continue; }
        r -= n_actx;
        if (r < n_pool) { pool_item(Ap, l, (r >> 2) * 16, r & 3, lane); continue; }
        r -= n_pool;
        sg_item(Ap, l, r >> 5, (r >> 3) & 3, r & 7, lane);
    }
}

using pg8::Unit;
struct SchedInN { const char* A; const char* B; int G, c;
    __device__ __forceinline__ bool next(int i, Unit& u) const { u.e = 0; return pg8::static_unit(i, G, c, 65, 6, u.pm, u.pn); }
    __device__ __forceinline__ const char* a_base(const Unit& u) const { return A + (size_t)u.pm * 256 * DM * 2; }
    __device__ __forceinline__ const char* b_base(const Unit& u) const { return B + (size_t)u.pn * 256 * DM * 2; } };
struct SchedInT { const char* A; const char* B; int G, c;
    __device__ __forceinline__ bool next(int i, Unit& u) const { u.e = 0; return pg8::static_unit(i, G, c, 3, 65, u.pm, u.pn); }
    __device__ __forceinline__ const char* a_base(const Unit& u) const { return A + (size_t)(1536 + u.pm * 256) * DM * 2; }
    __device__ __forceinline__ const char* b_base(const Unit& u) const { return B + (size_t)u.pn * 256 * DM * 2; } };
struct SchedOut { const char* A; const char* B; int G, c, nM;
    __device__ __forceinline__ bool next(int i, Unit& u) const { u.e = 0; return pg8::static_unit(i, G, c, nM, 4, u.pm, u.pn); }
    __device__ __forceinline__ const char* a_base(const Unit& u) const { return A + (size_t)u.pm * 256 * DM * 2; }
    __device__ __forceinline__ const char* b_base(const Unit& u) const { return B + (size_t)u.pn * 256 * DM * 2; } };
struct SchedMoe { const char* A; const char* B; const LAS int* cnt; int G, c; size_t bstride_e, bstride_pn;
    __device__ __forceinline__ bool next(int i, Unit& u) const {
        int L = i * G + c;
#pragma unroll 1
        for (int e = 0; e < NEXP; ++e) { const int nu = ((cnt[e] + 255) >> 8) * 4; if (L < nu) { u.e = e; u.pm = L >> 2; u.pn = L & 3; return true; } L -= nu; }
        return false; }
    __device__ __forceinline__ const char* a_base(const Unit&) const { return A; }
    __device__ __forceinline__ const char* b_base(const Unit& u) const { return B + (size_t)u.e * bstride_e + (size_t)u.pn * bstride_pn; } };

struct EpiInN {
    bf16_t* O; const float* qw; const float* kw;
    __device__ __forceinline__ void operator()(f32x4 (&acc)[2][2][4][2], const Unit& u, int, int wr, int wc, int fr, int fq) const {
        const int type = (u.pn == 0) ? 0 : (u.pn <= 2) ? 1 : (u.pn <= 4) ? 2 : 3;
        const int head = (type == 1) ? (u.pn - 1) * 4 + wc : (type == 2) ? (u.pn - 3) * 4 + wc : 0;
        f32x4 wv[2][2];
#pragma unroll
        for (int bj = 0; bj < 2; ++bj)
#pragma unroll
            for (int n = 0; n < 2; ++n) {
                const int d = 32 * bj + 8 * fq + 4 * n;
                wv[bj][n] = (type == 1) ? *(const f32x4*)(qw + head * 64 + d) * (0.125f * LOG2E) : (type == 2) ? *(const f32x4*)(kw + head * 64 + d) : (f32x4){1.f, 1.f, 1.f, 1.f};
            }
        const int row0 = u.pm * 256 + wr * 64 + fr, col0 = u.pn * 256 + wc * 64 + 8 * fq;
#pragma unroll
        for (int ai = 0; ai < 2; ++ai)
#pragma unroll
            for (int m = 0; m < 4; ++m) {
                f32x4 v[2][2];
#pragma unroll
                for (int bj = 0; bj < 2; ++bj)
#pragma unroll
                    for (int n = 0; n < 2; ++n) v[bj][n] = acc[ai][bj][m][n];
                if (type == 1 || type == 2) {
                    float ss = 0.f;
#pragma unroll
                    for (int bj = 0; bj < 2; ++bj)
#pragma unroll
                        for (int n = 0; n < 2; ++n) ss += (v[bj][n][0] * v[bj][n][0] + v[bj][n][1] * v[bj][n][1]) + (v[bj][n][2] * v[bj][n][2] + v[bj][n][3] * v[bj][n][3]);
                    ss += __shfl_xor(ss, 16); ss += __shfl_xor(ss, 32);
                    const float r = 1.0f / sqrtf(ss * (1.0f / 64.0f) + EPS);
#pragma unroll
                    for (int bj = 0; bj < 2; ++bj)
#pragma unroll
                        for (int n = 0; n < 2; ++n) v[bj][n] = v[bj][n] * r * wv[bj][n];
                } else if (type == 3) {
#pragma unroll
                    for (int bj = 0; bj < 2; ++bj)
#pragma unroll
                        for (int n = 0; n < 2; ++n)
#pragma unroll
                            for (int q = 0; q < 4; ++q) v[bj][n][q] = gelu_tanh(v[bj][n][q]);
                }
                bf16_t* rowp = O + (size_t)(row0 + ai * 128 + m * 16) * PQKU_LD + col0;
#pragma unroll
                for (int bj = 0; bj < 2; ++bj) { u32x4 w; w.x = cvt_pk_bf16(v[bj][0][0], v[bj][0][1]); w.y = cvt_pk_bf16(v[bj][0][2], v[bj][0][3]); w.z = cvt_pk_bf16(v[bj][1][0], v[bj][1][1]); w.w = cvt_pk_bf16(v[bj][1][2], v[bj][1][3]);
                    *(u32x4*)(rowp + 32 * bj) = w; }
            }
    }
};
struct EpiInT {
    bf16_t* O; const float* sgn;
    __device__ __forceinline__ void operator()(f32x4 (&acc)[2][2][4][2], const Unit& u, int, int wr, int wc, int fr, int fq) const {
        const int col0 = u.pn * 256 + wc * 32 + 8 * fq;
#pragma unroll
        for (int ai = 0; ai < 2; ++ai) {
            if (u.pm == 2) {
                const int head = 2 * ai + wr;
                float sw[4];
#pragma unroll
                for (int m = 0; m < 4; ++m) sw[m] = sgn[head * 64 + 16 * m + fr];
#pragma unroll
                for (int bj = 0; bj < 2; ++bj)
#pragma unroll
                    for (int n = 0; n < 2; ++n) {
                        f32x4 ss = (f32x4){0.f, 0.f, 0.f, 0.f};
#pragma unroll
                        for (int m = 0; m < 4; ++m) {
#pragma unroll
                            for (int q = 0; q < 4; ++q) acc[ai][bj][m][n][q] = gelu_tanh(acc[ai][bj][m][n][q]);
                            ss += acc[ai][bj][m][n] * acc[ai][bj][m][n]; }
#pragma unroll
                        for (int q = 0; q < 4; ++q) { float t = ss[q]; t += __shfl_xor(t, 1); t += __shfl_xor(t, 2); t += __shfl_xor(t, 4); t += __shfl_xor(t, 8); ss[q] = 1.0f / sqrtf(t * (1.0f / 64.0f) + EPS); }
#pragma unroll
                        for (int m = 0; m < 4; ++m) acc[ai][bj][m][n] = acc[ai][bj][m][n] * ss * sw[m];
                    }
            }
#pragma unroll
            for (int m = 0; m < 4; ++m) {
                bf16_t* rowp = O + (size_t)(u.pm * 256 + ai * 128 + wr * 64 + m * 16 + fr) * VT_LD + col0;
#pragma unroll
                for (int bj = 0; bj < 2; ++bj) { const f32x4 v0 = acc[ai][bj][m][0], v1 = acc[ai][bj][m][1];
                    u32x4 w; w.x = cvt_pk_bf16(v0[0], v0[1]); w.y = cvt_pk_bf16(v0[2], v0[3]); w.z = cvt_pk_bf16(v1[0], v1[1]); w.w = cvt_pk_bf16(v1[2], v1[3]);
                    *(u32x4*)(rowp + 128 * bj) = w; }
            }
        }
    }
};
struct EpiOut {
    const float* base_lat; const float* base_ctx; float* out_lat; float* out_ctx; const float* g_lat; const float* g_ctx;
    __device__ __forceinline__ void operator()(f32x4 (&acc)[2][2][4][2], const Unit& u, int, int wr, int wc, int fr, int fq) const {
        const bool cx = u.pm >= 64;
        const float* base = cx ? base_ctx : base_lat; float* out = cx ? out_ctx : out_lat; const float* gt = cx ? g_ctx : g_lat;
        const int row0 = (cx ? 0 : u.pm * 256) + wr * 64 + fr, col0 = u.pn * 256 + wc * 32 + 4 * fq;
        f32x4 gv[2][2];
#pragma unroll
        for (int bj = 0; bj < 2; ++bj)
#pragma unroll
            for (int n = 0; n < 2; ++n) gv[bj][n] = *(const f32x4*)(gt + col0 + bj * 128 + n * 16);
#pragma unroll
        for (int ai = 0; ai < 2; ++ai)
#pragma unroll
            for (int m = 0; m < 4; ++m) { const size_t off = (size_t)(row0 + ai * 128 + m * 16) * DM + col0;
#pragma unroll
                for (int bj = 0; bj < 2; ++bj)
#pragma unroll
                    for (int n = 0; n < 2; ++n) { const f32x4 b = *(const f32x4*)(base + off + bj * 128 + n * 16); *(f32x4*)(out + off + bj * 128 + n * 16) = b + gv[bj][n] * acc[ai][bj][m][n]; } }
    }
};
struct EpiG1 {
    bf16_t* H; const LAS int* idxl;
    __device__ __forceinline__ void operator()(f32x4 (&acc)[2][2][4][2], const Unit& u, int ui, int wr, int wc, int fr, int fq) const {
        const int col0 = u.pn * 128 + wc * 32 + 8 * fq;
#pragma unroll
        for (int ai = 0; ai < 2; ++ai)
#pragma unroll
            for (int m = 0; m < 4; ++m) {
                const int ent = idxl[ui * 256 + ai * 128 + wr * 64 + m * 16 + fr];
                float hv[8];
#pragma unroll
                for (int n = 0; n < 2; ++n)
#pragma unroll
                    for (int q = 0; q < 4; ++q) hv[n * 4 + q] = silu_f(acc[ai][0][m][n][q]) * acc[ai][1][m][n][q];
                if (ent >= 0) { u32x4 w; w.x = cvt_pk_bf16(hv[0], hv[1]); w.y = cvt_pk_bf16(hv[2], hv[3]); w.z = cvt_pk_bf16(hv[4], hv[5]); w.w = cvt_pk_bf16(hv[6], hv[7]);
                    *(u32x4*)(H + (size_t)ent * DEXP + col0) = w; }
            }
    }
};
struct EpiG2 {
    bf16_t* Y; const LAS int* idxl; const float* gwt; const float* g_lat; const float* g_ctx;
    __device__ __forceinline__ void operator()(f32x4 (&acc)[2][2][4][2], const Unit& u, int ui, int wr, int wc, int fr, int fq) const {
        const int col0 = u.pn * 256 + wc * 32 + 8 * fq;
#pragma unroll
        for (int ai = 0; ai < 2; ++ai)
#pragma unroll
            for (int m = 0; m < 4; ++m) {
                const int ent = idxl[ui * 256 + ai * 128 + wr * 64 + m * 16 + fr];
                if (ent >= 0) {
                    const float gwv = gwt[ent]; const float* gt = (ent >= 2 * NTOK) ? g_ctx : g_lat;
#pragma unroll
                    for (int bj = 0; bj < 2; ++bj) {
                        const f32x4 g0 = *(const f32x4*)(gt + col0 + bj * 128), g1 = *(const f32x4*)(gt + col0 + bj * 128 + 4);
                        const f32x4 v0 = acc[ai][bj][m][0] * g0 * gwv, v1 = acc[ai][bj][m][1] * g1 * gwv;
                        u32x4 w; w.x = cvt_pk_bf16(v0[0], v0[1]); w.y = cvt_pk_bf16(v0[2], v0[3]); w.z = cvt_pk_bf16(v1[0], v1[1]); w.w = cvt_pk_bf16(v1[2], v1[3]);
                        *(u32x4*)(Y + (size_t)ent * DM + col0 + bj * 128) = w; }
                }
            }
    }
};

__device__ __forceinline__ void moe_setup(KArgs Ap, const Frame& F0, int l, LAS int* cntL, LAS int* idxl) {
    const Frame F = fresh(F0);
    const unsigned* gcnt = (const unsigned*)(Ap->ws + WS_CTL) + CW_CNT + l * 16;
    const int* glist = (const int*)(Ap->ws + WS_LIST);
    if (F.tid < 16) cntL[F.tid] = (int)gcnt[F.tid];
    __syncthreads();
    SchedMoe S{nullptr, nullptr, cntL, F.G, (int)blockIdx.x, 0, 0};
    Unit u;
    for (int i = 0; i < 8 && S.next(i, u); ++i) {
        const int n = cntL[u.e];
        if (F.tid < 256) { const int pos = u.pm * 256 + F.tid; const int* le = glist + (size_t)u.e * LIST_CAP;
            idxl[i * 256 + F.tid] = (pos < n) ? le[pos] : (int)((unsigned)le[0] | 0x80000000u); }
    }
    __syncthreads();
}

__global__ void __launch_bounds__(NWAVES * 64, 2) fwd_megakernel(Args A_unused) {
    extern __shared__ __attribute__((aligned(16))) unsigned char lds_raw[];
    Frame F;
    F.lds = (LAS unsigned char*)lds_raw;
    F.tid = threadIdx.x; F.lane = F.tid & 63; F.wave = __builtin_amdgcn_readfirstlane(F.tid >> 6);
    F.G = gridDim.x; { const int bx = blockIdx.x; F.vcu = (F.G % 8 == 0) ? (bx % 8) * (F.G / 8) + bx / 8 : bx; }
    volatile LAS unsigned* MISC = (volatile LAS unsigned*)(F.lds + MISC_OFF);
    for (int u = F.tid; u < 64; u += NWAVES * 64) MISC[u] = 0u;
    __syncthreads();
    XcdBarrier bar;
    { KArgs Ap = get_args(); bar = xcd_barrier_post((unsigned*)(Ap->ws + WS_CTL) + CW_BAR, MISC + 16); }
    LAS int* cntL = (LAS int*)(F.lds + MISC_OFF);
    LAS int* idxl = (LAS int*)(F.lds + IDX_OFF);

    { KArgs Ap = get_args(); p0_prologue(Ap, F); }
    xcd_barrier(bar);
#pragma unroll 1
    for (int l = 0; l < 2; ++l) {
        { KArgs Ap = get_args(); phase_n1(Ap, F, l); }
        xcd_barrier(bar);
        {
            KArgs Ap = get_args(); unsigned char* ws = Ap->ws; const Frame Fp = fresh(F); int bx = (int)blockIdx.x; asm volatile("" : "+s"(bx));
            SchedInN S1{(const char*)(ws + WS_XN), (const char*)(ws + WS_WIN) + (size_t)l * IN_DIM * DM * 2, Fp.G, bx};
            EpiInN E1{(bf16_t*)(ws + WS_PQKU), Ap->q_norm + l * 512, Ap->k_norm + l * 512};
            pg8::gemm_phase<EpiInN, SchedInN, 2, false, 0>(Fp.lds, idxl, DM, S1, E1);
        }
        {
            KArgs Ap = get_args(); unsigned char* ws = Ap->ws; const Frame Fp = fresh(F); int bx = (int)blockIdx.x; asm volatile("" : "+s"(bx));
            SchedInT S2{(const char*)(ws + WS_WIN) + (size_t)l * IN_DIM * DM * 2, (const char*)(ws + WS_XN), Fp.G, Fp.G - 1 - bx};
            EpiInT E2{(bf16_t*)(ws + WS_VT), Ap->sg_norm + l * 256};
            pg8::gemm_phase<EpiInT, SchedInT, 1, false, 0>(Fp.lds, idxl, DM, S2, E2);
        }
        xcd_barrier(bar);
        { KArgs Ap = get_args(); phase_mix(Ap, F, l); }
        xcd_barrier(bar);
        {
            KArgs Ap = get_args(); unsigned char* ws = Ap->ws; const Frame Fp = fresh(F); int bx = (int)blockIdx.x; asm volatile("" : "+s"(bx));
            SchedOut S{(const char*)(ws + WS_MIX), (const char*)(ws + WS_WOUT) + (size_t)l * DM * DM * 2, Fp.G, bx, (l == 0) ? 65 : 64};
            EpiOut E{(l == 0) ? Ap->x : Ap->out, (l == 0) ? Ap->ctx : (const float*)(ws + WS_HCTX), Ap->out, (float*)(ws + WS_HCTX), modp(Ap, l, 0) + 2048, modp(Ap, l, 1) + 2048};
            pg8::gemm_phase<EpiOut, SchedOut, 0, false, 0>(Fp.lds, idxl, DM, S, E);
        }
        xcd_barrier(bar);
        { KArgs Ap = get_args(); phase_n2(Ap, F, l); }
        xcd_barrier(bar);
        { KArgs Ap = get_args(); moe_setup(Ap, F, l, cntL, idxl); }
        {
            KArgs Ap = get_args(); unsigned char* ws = Ap->ws; const Frame Fp = fresh(F); int bx = (int)blockIdx.x; asm volatile("" : "+s"(bx));
            SchedMoe S{(const char*)(ws + WS_XN), (const char*)(ws + WS_WGU) + (size_t)l * NEXP * 1024 * 1024 * 2, cntL, Fp.G, bx, (size_t)1024 * 1024 * 2, (size_t)256 * DM * 2};
            EpiG1 E{(bf16_t*)(ws + WS_H), idxl};
            pg8::gemm_phase<EpiG1, SchedMoe, 1, true, 1>(Fp.lds, idxl, DM, S, E);
        }
        xcd_barrier(bar);
        {
            KArgs Ap = get_args(); unsigned char* ws = Ap->ws; const Frame Fp = fresh(F); int bx = (int)blockIdx.x; asm volatile("" : "+s"(bx));
            SchedMoe S{(const char*)(ws + WS_H), (const char*)(ws + WS_WDN) + (size_t)l * NEXP * 1024 * 512 * 2, cntL, Fp.G, bx, (size_t)1024 * 512 * 2, (size_t)256 * DEXP * 2};
            EpiG2 E{(bf16_t*)(ws + WS_Y), idxl, (const float*)(ws + WS_GW), modp(Ap, l, 0) + 5120, modp(Ap, l, 1) + 5120};
            pg8::gemm_phase<EpiG2, SchedMoe, 1, true, 0>(Fp.lds, idxl, DEXP, S, E);
        }
        xcd_barrier(bar);
    }
    { KArgs Ap = get_args(); phase_final(Ap, F); }
    { KArgs Ap = get_args(); if (blockIdx.x == 0 && threadIdx.x == 0) { const unsigned t = xb_ld((unsigned*)(Ap->ws + WS_CTL) + CW_BAR + XB_TMO); if (t != 0u) { asm volatile("s_waitcnt vmcnt(0)" ::: "memory"); Ap->out[5] = __builtin_nanf(""); } } }
}

extern "C" void kernel_launch(void* const* d_in, const int* in_sizes, int n_in, void* d_out, int out_size, void* d_ws, size_t ws_size, hipStream_t stream) {
    static int grid = 0;
    if (grid == 0) {
        if (n_in != 23 || out_size != NTOK * DM || ws_size < WS_END) { fprintf(stderr, "kernel_launch: unexpected sizes (n_in %d out %d ws %zu)\n", n_in, out_size, ws_size); grid = -1; return; }
        int dev = 0, cus = 0, per_cu = 0;
        if (hipGetDevice(&dev) != hipSuccess || hipDeviceGetAttribute(&cus, hipDeviceAttributeMultiprocessorCount, dev) != hipSuccess) { grid = -1; return; }
        if (hipFuncSetAttribute((const void*)fwd_megakernel, hipFuncAttributeMaxDynamicSharedMemorySize, LDS_BYTES) != hipSuccess) { fprintf(stderr, "kernel_launch: hipFuncSetAttribute failed\n"); grid = -1; return; }
        if (hipOccupancyMaxActiveBlocksPerMultiprocessor(&per_cu, (const void*)fwd_megakernel, NWAVES * 64, LDS_BYTES) != hipSuccess || per_cu < 1) { fprintf(stderr, "kernel_launch: occupancy query says %d\n", per_cu); (void)hipGetLastError(); grid = -1; return; }
        grid = cus;
        if (grid != 256) fprintf(stderr, "kernel_launch: %d CUs (built for 256)\n", grid);
    }
    if (grid < 0) return;
    (void)hipMemsetAsync((char*)d_ws + WS_CTL, 0, CTL_ZERO_BYTES, stream);
    Args a{};
    const float** ap = (const float**)&a;
    for (int i = 0; i < 23; ++i) ap[i] = (const float*)d_in[i];
    a.out = (float*)d_out; a.ws = (unsigned char*)d_ws;
    void* args[] = {&a};
    hipError_t e = hipLaunchCooperativeKernel((const void*)fwd_megakernel, dim3(grid), dim3(NWAVES * 64), args, LDS_BYTES, stream);
    if (e != hipSuccess) fprintf(stderr, "kernel_launch: cooperative launch failed: %s\n", hipGetErrorString(e));
}
```

```cpp
#include <hip/hip_runtime.h>
#include <cstdio>
#include <cstdint>

#ifndef DUP
#define DUP 0
#endif
constexpr int NTOK = 16384, NCTX = 256, MROWS = NTOK + NCTX, DM = 1024, IN_DIM = 2304;
constexpr int NEXP = 16, DEXP = 512;
constexpr int PQKU_LD = 1536;
constexpr int VT_LD = MROWS;
constexpr float EPS = 1e-6f;
constexpr float LOG2E = 1.4426950408889634f;

#define LAS __attribute__((address_space(3)))
#define GAS __attribute__((address_space(1)))
typedef unsigned short bf16_t;
typedef short bf16x8 __attribute__((ext_vector_type(8)));
typedef short bf16x4 __attribute__((ext_vector_type(4)));
typedef float f32x4 __attribute__((ext_vector_type(4)));
typedef float f32x2 __attribute__((ext_vector_type(2)));
typedef unsigned u32x4 __attribute__((ext_vector_type(4)));
typedef unsigned u32x2 __attribute__((ext_vector_type(2)));

__device__ __forceinline__ unsigned cvt_pk_bf16(float lo, float hi) { unsigned r; asm volatile("v_cvt_pk_bf16_f32 %0, %1, %2" : "=v"(r) : "v"(lo), "v"(hi)); return r; }
__device__ __forceinline__ float bf2f(unsigned short b) { return __builtin_bit_cast(float, (unsigned)b << 16); }
__device__ __forceinline__ float gelu_tanh(float x) {
    const float y = x * (1.0f + 0.044715f * x * x);
    return x * __builtin_amdgcn_rcpf(1.0f + __builtin_amdgcn_exp2f(-2.3022082f * y));
}
__device__ __forceinline__ float silu_f(float x) { return x * __builtin_amdgcn_rcpf(1.0f + __builtin_amdgcn_exp2f(-LOG2E * x)); }
__device__ __forceinline__ float wave_sum(float v) {
#pragma unroll
    for (int o = 1; o < 64; o <<= 1) v += __shfl_xor(v, o);
    return v;
}

namespace pg8 {
constexpr int BM = 256, BK = 64, HALF = 128, HTB = HALF * BK * 2, STAGE_BYTES = 8 * HTB, NXCD = 8, WGM = 8;
__host__ __device__ __forceinline__ int lds_byte(int r, int c) { const int st = (r >> 4) * 2 + (c >> 5), rr = r & 15, cc = c & 31, ob = rr * 64 + cc * 2; return st * 1024 + (ob ^ (((ob >> 9) & 1) << 5)); }
__host__ __device__ __forceinline__ void stage_rc(int b, int& R, int& C) { const int st = b / 1024, sb = b % 1024, swz = sb ^ (((sb >> 9) & 1) << 5); R = (st >> 1) * 16 + swz / 64; C = (st & 1) * 32 + (swz % 64) / 2; }
__host__ __device__ __forceinline__ int perm32(int rho) { const int n = rho >> 4, i = rho & 15; return 8 * (i >> 2) + 4 * n + (i & 3); }

struct Unit { int pm, pn, e; };

__device__ __forceinline__ bool static_unit(int i, int G, int c, int nM, int nN, int& pm, int& pn) {
    const int nwg = nM * nN; const long L = (long)i * G + c; if (L >= nwg) return false;
    int wgid = (int)L; { const int q = nwg / NXCD, r = nwg % NXCD, xcd = wgid % NXCD, off = wgid / NXCD; wgid = (xcd < r ? xcd * (q + 1) : r * (q + 1) + (xcd - r) * q) + off; }
    const int nig = WGM * nN, gid = wgid / nig, fm = gid * WGM, gsz = (nM - fm) < WGM ? (nM - fm) : WGM;
    pm = fm + ((wgid % nig) % gsz); pn = (wgid % nig) / gsz; return true;
}

template <class Epi, class Sched, int BPERM, bool GATHER, int GSH>
__device__ __forceinline__ void gemm_phase(LAS unsigned char* lds, const LAS int* idxl, const int K, const Sched& S, const Epi& E) {
    int tid_ = threadIdx.x; asm volatile("" : "+v"(tid_));
    const int tid = tid_, wid = __builtin_amdgcn_readfirstlane(tid >> 6), lane = tid & 63, wr = wid >> 2, wc = wid & 3, fr = lane & 15, fq = lane >> 4;
    const int nt = K / BK;
    int R_[2], C_[2];
    unsigned voffA[2][2], voffB[2][2];
    const size_t hstep = (size_t)HALF * (size_t)K * 2u;
#pragma unroll
    for (int i = 0; i < 2; ++i) {
        stage_rc(tid * 16 + i * 8192, R_[i], C_[i]);
        const int R = R_[i], C = C_[i];
        voffA[0][i] = (unsigned)(R * K + C) * 2u; voffA[1][i] = 0u;
        if (BPERM == 2) {
#pragma unroll
            for (int bj = 0; bj < 2; ++bj) voffB[bj][i] = (unsigned)((64 * (R >> 5) + 32 * bj + perm32(R & 31)) * K + C) * 2u;
        } else {
            const int Rb = (BPERM == 1) ? ((R & ~31) + perm32(R & 31)) : R;
            voffB[0][i] = (unsigned)(Rb * K + C) * 2u; voffB[1][i] = 0u;
        }
    }
    const size_t kstep = (size_t)(BK * 2);
    const unsigned ldsw = (unsigned)wid * 1024u;
    const int aoff = lds_byte(wr * 64 + fr, fq * 8), boff = lds_byte(wc * 32 + fr, fq * 8);
#define PG8_SA(b, h) (((b) * 2 + (h)) * HTB)
#define PG8_SB(b, h) ((4 + (b) * 2 + (h)) * HTB)
#define PG8_STAGE(bufoff, gbase, voff) do { _Pragma("unroll") for (int _i = 0; _i < 2; ++_i) \
        __builtin_amdgcn_global_load_lds((const unsigned*)((const char*)(gbase) + (voff)[_i]), (LAS unsigned*)(lds + (bufoff) + ldsw + _i * 8192), 16, 0, 0); } while (0)
#define PG8_STA(bufoff, gbase, h) do { if (GATHER) PG8_STAGE(bufoff, gbase, voffA[h]); else PG8_STAGE(bufoff, (gbase) + (h) * hstep, voffA[0]); } while (0)
#define PG8_STB(bufoff, gbase, h) do { if (BPERM == 2) PG8_STAGE(bufoff, gbase, voffB[h]); else PG8_STAGE(bufoff, (gbase) + (h) * hstep, voffB[0]); } while (0)
#define PG8_GLOAD(u_) do { if (GATHER) { _Pragma("unroll") for (int _h = 0; _h < 2; ++_h) _Pragma("unroll") for (int _i = 0; _i < 2; ++_i) \
        voffA[_h][_i] = (unsigned)((((unsigned)idxl[(u_) * 256 + _h * 128 + R_[_i]] & 0x7fffffffu) >> GSH) * (unsigned)K + (unsigned)C_[_i]) * 2u; } } while (0)
#define PG8_LDA(dst, b, h) do { _Pragma("unroll") for (int m = 0; m < 4; ++m) _Pragma("unroll") for (int k = 0; k < 2; ++k) dst[m][k] = *(const LAS bf16x8*)(lds + PG8_SA(b, h) + aoff + m * 2048 + k * 1024); } while (0)
#define PG8_LDB(dst, b, h) do { _Pragma("unroll") for (int n = 0; n < 2; ++n) _Pragma("unroll") for (int k = 0; k < 2; ++k) dst[n][k] = *(const LAS bf16x8*)(lds + PG8_SB(b, h) + boff + n * 2048 + k * 1024); } while (0)
#define PG8_MMA(ai, bj, At, Bt) do { __builtin_amdgcn_s_setprio(1); _Pragma("unroll") for (int m = 0; m < 4; ++m) _Pragma("unroll") for (int n = 0; n < 2; ++n) _Pragma("unroll") for (int k = 0; k < 2; ++k) \
        acc[ai][bj][m][n] = __builtin_amdgcn_mfma_f32_16x16x32_bf16(Bt[n][k], At[m][k], acc[ai][bj][m][n], 0, 0, 0); __builtin_amdgcn_s_setprio(0); } while (0)
#define PG8_WAIT_V(n) asm volatile("s_waitcnt vmcnt(" #n ")" ::: "memory")
#define PG8_WAIT_L(n) asm volatile("s_waitcnt lgkmcnt(" #n ")" ::: "memory")
#define PG8_BAR __builtin_amdgcn_s_barrier()
#define PG8_SCHED __builtin_amdgcn_sched_barrier(0)
    Unit cur, nxt; int ui = 0;
    if (!S.next(0, cur)) return;
    f32x4 acc[2][2][4][2];
#pragma unroll
    for (int a = 0; a < 2; ++a)
#pragma unroll
        for (int b = 0; b < 2; ++b)
#pragma unroll
            for (int m = 0; m < 4; ++m)
#pragma unroll
                for (int n = 0; n < 2; ++n) acc[a][b][m][n] = (f32x4){0.f, 0.f, 0.f, 0.f};
    bf16x8 At[4][2], B0[2][2], B1[2][2];
    const char* cA = S.a_base(cur); const char* cB = S.b_base(cur);
    PG8_GLOAD(0);
    PG8_STB(PG8_SB(0, 0), cB, 0); PG8_STB(PG8_SB(0, 1), cB, 1); PG8_STA(PG8_SA(0, 0), cA, 0); PG8_STA(PG8_SA(0, 1), cA, 1);
    if (wr == 1) PG8_BAR;
    PG8_WAIT_V(2); PG8_BAR;
    PG8_STB(PG8_SB(1, 0), cB + kstep, 0); PG8_STA(PG8_SA(1, 0), cA + kstep, 0); PG8_STB(PG8_SB(1, 1), cB + kstep, 1);
    PG8_WAIT_V(6); PG8_BAR;
    for (;;) {
        const bool has_next = S.next(ui + 1, nxt);
        const char* nA = has_next ? S.a_base(nxt) : cA; const char* nB = has_next ? S.b_base(nxt) : cB;
        for (int t = 0; t < nt; t += 2) {
            const bool last = (t == nt - 2);
            const char* a1 = cA + (size_t)(t + 1) * kstep;
            const char* a2 = last ? nA : cA + (size_t)(t + 2) * kstep; const char* b2 = last ? nB : cB + (size_t)(t + 2) * kstep;
            const char* a3 = a2 + kstep; const char* b3 = b2 + kstep;
            PG8_LDB(B0, 0, 0); PG8_LDB(B1, 0, 1); PG8_SCHED; PG8_LDA(At, 0, 0); PG8_STA(PG8_SA(1, 1), a1, 1);
            if (GATHER) { if (last && has_next) PG8_GLOAD(ui + 1); }
            PG8_WAIT_V(8); PG8_WAIT_L(0); PG8_BAR; PG8_MMA(0, 0, At, B0); PG8_MMA(0, 1, At, B1); PG8_BAR; PG8_SCHED;
            PG8_LDA(At, 0, 1); PG8_STB(PG8_SB(0, 0), b2, 0); PG8_STB(PG8_SB(0, 1), b2, 1); PG8_STA(PG8_SA(0, 0), a2, 0);
            PG8_WAIT_V(8); PG8_WAIT_L(0); PG8_BAR; PG8_MMA(1, 0, At, B0); PG8_MMA(1, 1, At, B1); PG8_BAR; PG8_SCHED;
            PG8_LDB(B0, 1, 0); PG8_LDB(B1, 1, 1); PG8_SCHED; PG8_LDA(At, 1, 0); PG8_STA(PG8_SA(0, 1), a2, 1);
            PG8_WAIT_V(8); PG8_WAIT_L(0); PG8_BAR; PG8_MMA(0, 0, At, B0); PG8_MMA(0, 1, At, B1); PG8_BAR; PG8_SCHED;
            PG8_LDA(At, 1, 1); PG8_STB(PG8_SB(1, 0), b3, 0); PG8_STB(PG8_SB(1, 1), b3, 1); PG8_STA(PG8_SA(1, 0), a3, 0);
            PG8_WAIT_V(8); PG8_WAIT_L(0); PG8_BAR; PG8_MMA(1, 0, At, B0); PG8_MMA(1, 1, At, B1); PG8_BAR; PG8_SCHED;
        }
        if (wr == 0) PG8_BAR;
        E(acc, cur, ui, wr, wc, fr, fq);
        if (!has_next) break;
#pragma unroll
        for (int a = 0; a < 2; ++a)
#pragma unroll
            for (int b = 0; b < 2; ++b)
#pragma unroll
                for (int m = 0; m < 4; ++m)
#pragma unroll
                    for (int n = 0; n < 2; ++n) acc[a][b][m][n] = (f32x4){0.f, 0.f, 0.f, 0.f};
        cur = nxt; cA = nA; cB = nB; ++ui;
        if (wr == 1) PG8_BAR;
    }
    PG8_WAIT_V(0);
    PG8_BAR;
#undef PG8_SA
#undef PG8_SB
#undef PG8_STAGE
#undef PG8_GLOAD
#undef PG8_STA
#undef PG8_STB
#undef PG8_LDA
#undef PG8_LDB
#undef PG8_MMA
#undef PG8_WAIT_V
#undef PG8_WAIT_L
#undef PG8_BAR
#undef PG8_SCHED
}
}

constexpr size_t MiB = 1u << 20;
constexpr size_t WS_CTL = 0, CTL_ZERO_BYTES = 1 * MiB;
constexpr size_t WS_SMALL = 1 * MiB;
constexpr size_t WS_LIST = 4 * MiB;
constexpr size_t WS_GW = 7 * MiB;
constexpr size_t WS_HCTX = 8 * MiB;
constexpr size_t WS_WIN = 10 * MiB;
constexpr size_t WS_WOUT = 19 * MiB;
constexpr size_t WS_WGU = 24 * MiB;
constexpr size_t WS_WDN = 88 * MiB;
constexpr size_t WS_XN = 120 * MiB;
constexpr size_t WS_PQKU = 153 * MiB;
constexpr size_t WS_VT = 202 * MiB;
constexpr size_t WS_Y = WS_PQKU;
constexpr size_t WS_MIX = 227 * MiB;
constexpr size_t WS_H = WS_MIX;
constexpr size_t WS_END = 260 * MiB;
static_assert(WS_PQKU + (size_t)MROWS * PQKU_LD * 2 <= WS_VT && WS_VT + (size_t)768 * VT_LD * 2 <= WS_MIX && WS_Y + (size_t)2 * MROWS * DM * 2 <= WS_MIX && WS_MIX + (size_t)MROWS * DM * 2 <= WS_END, "ws map");
static_assert(WS_XN + (size_t)MROWS * DM * 2 <= WS_PQKU && WS_WDN + (size_t)2 * 16 * 1024 * 512 * 2 <= WS_XN && WS_WGU + (size_t)2 * 16 * 1024 * 1024 * 2 <= WS_WDN, "ws map 2");
constexpr int CW_BAR = 4096;
constexpr int CW_CNT = 8192;
constexpr int CW_MOD = 16384;
static_assert((CW_MOD + 4 * 6144) * 4 <= (int)CTL_ZERO_BYTES, "ctl");
constexpr size_t SM_SGW = 0;
constexpr size_t SM_POOLT = 256 * 1024;
constexpr size_t SM_B2 = 320 * 1024;
constexpr int LIST_CAP = 2 * MROWS;

constexpr int RING_BYTES = 131072;
constexpr int IDX_OFF = RING_BYTES;
constexpr int MISC_OFF = IDX_OFF + 8192;
constexpr int LDS_BYTES = 147456;
constexpr int NWAVES = 8;

#define XB_TMO      128
#define XB_XCNT(j)  (256  + 64 * (j))
#define XB_XSUB(j)  (1280 + 64 * (j))
#define XB_XGEN(j)  (2304 + 64 * (j))
#define XB_TOP      3328
#define XB_TOPGEN   3392
#define XCD_BAR_WORDS 3456
#define XB_SPIN_CAP (1u << 18)
__device__ __forceinline__ unsigned xb_ld(unsigned* p)              { return __hip_atomic_load(p, __ATOMIC_RELAXED, __HIP_MEMORY_SCOPE_AGENT); }
__device__ __forceinline__ unsigned xb_add(unsigned* p, unsigned v) { return __hip_atomic_fetch_add(p, v, __ATOMIC_RELAXED, __HIP_MEMORY_SCOPE_AGENT); }
__device__ __forceinline__ unsigned xb_xcc_id() { return (unsigned)__builtin_amdgcn_s_getreg((3 << 11) | 20) & 0xFu; }
#define XB_SPIN(cond, bar) do { unsigned _sp = 0; while (cond) { __builtin_amdgcn_s_sleep(1); \
    if ((++_sp & 255u) == 0u) { if (xb_ld(&(bar)[XB_TMO])) break; if (_sp > XB_SPIN_CAP) { atomicAdd(&(bar)[XB_TMO], 1u); break; } } } } while (0)
struct XcdBarrier { unsigned* bar; unsigned x; volatile LAS unsigned* st; };
__device__ __forceinline__ XcdBarrier xcd_barrier_post(unsigned* bar, volatile LAS unsigned* st) {
    XcdBarrier b; b.bar = bar; b.x = xb_xcc_id(); b.st = st;
    if (threadIdx.x == 0) (void)xb_add(&bar[XB_XCNT(b.x)], 1u);
    return b;
}
__device__ __forceinline__ void xcd_barrier_complete(unsigned* bar, unsigned x, unsigned& nloc, unsigned& nx) {
    const unsigned G = gridDim.x * gridDim.y * gridDim.z;
    unsigned sum, cnt, mine, sp = 0u;
    for (;;) {
        sum = 0u; cnt = 0u; mine = 0u;
#pragma unroll
        for (unsigned j = 0; j < 16; ++j) { const unsigned c = xb_ld(&bar[XB_XCNT(j)]); sum += c; cnt += (c > 0u) ? 1u : 0u; mine = (j == x) ? c : mine; }
        if (sum == G) break;
        __builtin_amdgcn_s_sleep(1);
        if ((++sp & 255u) == 0u) { if (xb_ld(&bar[XB_TMO])) break; if (sp > XB_SPIN_CAP) { atomicAdd(&bar[XB_TMO], 1u); break; } }
    }
    nloc = mine > 0u ? mine : 1u; nx = cnt > 0u ? cnt : 1u;
}
__device__ __forceinline__ void xcd_barrier(const XcdBarrier& b) {
    asm volatile("s_waitcnt vmcnt(0)" ::: "memory");
    __syncthreads();
    if (threadIdx.x == 0) {
        unsigned* bar = b.bar;
        __builtin_amdgcn_s_waitcnt(0);
        unsigned nloc = b.st[0], nx = b.st[1];
        if (nloc == 0u) { xcd_barrier_complete(bar, b.x, nloc, nx); b.st[0] = nloc; b.st[1] = nx; }
        const unsigned old = xb_add(&bar[XB_XSUB(b.x)], 1u);
        const unsigned gen = old / nloc;
        if (old + 1u == (gen + 1u) * nloc) {
            __builtin_amdgcn_fence(__ATOMIC_RELEASE, "agent");
            asm volatile("s_waitcnt vmcnt(0)" ::: "memory");
            const unsigned og = xb_add(&bar[XB_TOP], 1u);
            const unsigned tg = og / nx;
            if (og + 1u == (tg + 1u) * nx) xb_add(&bar[XB_TOPGEN], 1u);
            else XB_SPIN(xb_ld(&bar[XB_TOPGEN]) == tg, bar);
            __builtin_amdgcn_fence(__ATOMIC_ACQUIRE, "agent");
            xb_add(&bar[XB_XGEN(b.x)], 1u);
            asm volatile("s_waitcnt vmcnt(0)" ::: "memory");
        } else {
            XB_SPIN(xb_ld(&bar[XB_XGEN(b.x)]) == gen, bar);
            __builtin_amdgcn_fence(__ATOMIC_ACQUIRE, "agent");
            asm volatile("s_waitcnt vmcnt(0)" ::: "memory");
        }
    }
    __syncthreads();
}

struct Args {
    const float *x, *c, *ctx, *c_ctx, *w_ada, *b_ada, *norm1, *w_in, *pool_w, *pool_scale, *q_norm, *k_norm, *rpb, *sg_w, *sg_b, *sg_norm, *w_out, *norm2, *w_router, *b_router, *w_gate, *w_up, *w_down;
    float* out; unsigned char* ws;
};
struct Frame {
    LAS unsigned char* lds;
    int tid, lane, wave, vcu, G;
};
__device__ __forceinline__ Frame fresh(const Frame& F0) { Frame F = F0; asm volatile("" : "+v"(F.tid), "+v"(F.lane), "+s"(F.wave), "+s"(F.vcu), "+s"(F.G)); return F; }
typedef const __attribute__((address_space(4))) Args* KArgs;
__device__ __forceinline__ KArgs get_args() { KArgs p = (KArgs)__builtin_amdgcn_kernarg_segment_ptr(); asm volatile("" : "+s"(p)); return p; }

__device__ __forceinline__ unsigned f2bf(float f) { unsigned u = __builtin_bit_cast(unsigned, f); return (u + 0x7fffu + ((u >> 16) & 1u)) >> 16; }
__device__ __forceinline__ unsigned pk2(float lo, float hi) { return f2bf(lo) | (f2bf(hi) << 16); }
__device__ __forceinline__ void p0_transpose_item(const float* W, int K, int N, bf16_t* WT, int k0, int n0, int drow0, LAS float* scr, int lane) {
#pragma unroll 8
    for (int i = 0; i < 32; ++i) { const int kk = 2 * i + (lane >> 5); scr[kk * 33 + (lane & 31)] = W[(size_t)(k0 + kk) * N + n0 + (lane & 31)]; }
    asm volatile("s_waitcnt lgkmcnt(0)" ::: "memory");
    const int c = lane & 7;
#pragma unroll
    for (int j = 0; j < 4; ++j) { const int n = (lane >> 3) + 8 * j; const LAS float* s = scr + (8 * c) * 33 + n;
        u32x4 o; o.x = pk2(s[0 * 33], s[1 * 33]); o.y = pk2(s[2 * 33], s[3 * 33]); o.z = pk2(s[4 * 33], s[5 * 33]); o.w = pk2(s[6 * 33], s[7 * 33]);
        *(u32x4*)(WT + (size_t)(drow0 + n) * K + k0 + 8 * c) = o; }
    asm volatile("s_waitcnt lgkmcnt(0)" ::: "memory");
}
__device__ __forceinline__ int win_dst_row(int n) { return n < 1280 ? n : (n < 1792 ? 1536 + (n - 1280) : (n < 2048 ? 1280 + (n - 1792) : n)); }

__device__ __forceinline__ void p0_prologue(KArgs Ap, const Frame& F0) {
    const Frame F = fresh(F0);
    unsigned char* ws = Ap->ws;
    LAS float* scr = (LAS float*)(F.lds + F.wave * 16384);
    const int gw = F.vcu * NWAVES + F.wave, NGW = F.G * NWAVES;
    const int lane = F.lane;
    float* mod = (float*)(ws + WS_CTL) + CW_MOD;
    for (int it = gw; it < 2 * 24 * 8; it += NGW) {
        const int l = it / (24 * 8), r = it % (24 * 8), nb = r / 8, sb = r % 8;
        const int kq = lane >> 3, c4 = (lane & 7) * 4;
        const float* W = Ap->w_ada + (size_t)l * DM * 6144 + nb * 256 + sb * 32 + c4;
        f32x4 a0 = (f32x4){0.f, 0.f, 0.f, 0.f}, a1 = a0;
#pragma unroll 4
        for (int k = kq; k < DM; k += 8) {
            const float c0 = silu_f(Ap->c[k]), c1 = silu_f(Ap->c_ctx[k]);
            const f32x4 w = *(const f32x4*)(W + (size_t)k * 6144);
            a0 += w * c0; a1 += w * c1;
        }
#pragma unroll
        for (int j = 0; j < 4; ++j) { float x0 = a0[j], x1 = a1[j];
            x0 += __shfl_xor(x0, 8); x0 += __shfl_xor(x0, 16); x0 += __shfl_xor(x0, 32); x1 += __shfl_xor(x1, 8); x1 += __shfl_xor(x1, 16); x1 += __shfl_xor(x1, 32); a0[j] = x0; a1[j] = x1; }
        if (kq == 0) { const f32x4 b = *(const f32x4*)(Ap->b_ada + l * 6144 + nb * 256 + sb * 32 + c4);
            *(f32x4*)(mod + (l * 2 + 0) * 6144 + nb * 256 + sb * 32 + c4) = a0 + b; *(f32x4*)(mod + (l * 2 + 1) * 6144 + nb * 256 + sb * 32 + c4) = a1 + b; }
    }
    constexpr int I_IN = 16 * 72, I_OUT = 16 * 32, I_G = 16 * 16, I_D = 8 * 32;
    constexpr int PER_L = I_IN + I_OUT + 16 * (2 * I_G + I_D);
    for (int it = gw; it < 2 * PER_L; it += NGW) {
        const int l = it / PER_L; int r = it % PER_L;
        if (r < I_IN) { const int kb = r / 72, nb = r % 72;
            p0_transpose_item(Ap->w_in + (size_t)l * DM * IN_DIM, DM, IN_DIM, (bf16_t*)(ws + WS_WIN) + (size_t)l * IN_DIM * DM, kb * 64, nb * 32, win_dst_row(nb * 32), scr, lane); continue; }
        r -= I_IN;
        if (r < I_OUT) { const int kb = r / 32, nb = r % 32;
            p0_transpose_item(Ap->w_out + (size_t)l * DM * DM, DM, DM, (bf16_t*)(ws + WS_WOUT) + (size_t)l * DM * DM, kb * 64, nb * 32, nb * 32, scr, lane); continue; }
        r -= I_OUT;
        const int e = r / (2 * I_G + I_D); r = r % (2 * I_G + I_D);
        if (r < 2 * I_G) { const int up = r / I_G; r = r % I_G; const int kb = r / 16, nb = r % 16; const int j0 = nb * 32;
            const float* src = (up ? Ap->w_up : Ap->w_gate) + ((size_t)l * NEXP + e) * DM * DEXP;
            p0_transpose_item(src, DM, DEXP, (bf16_t*)(ws + WS_WGU) + ((size_t)l * NEXP + e) * 1024 * 1024, kb * 64, j0, (j0 >> 7) * 256 + (j0 & 127) + (up ? 128 : 0), scr, lane); continue; }
        r -= 2 * I_G;
        { const int kb = r / 32, nb = r % 32;
            p0_transpose_item(Ap->w_down + ((size_t)l * NEXP + e) * DEXP * DM, DEXP, DM, (bf16_t*)(ws + WS_WDN) + ((size_t)l * NEXP + e) * 1024 * 512, kb * 64, nb * 32, nb * 32, scr, lane); }
    }
    const int gt = F.vcu * NWAVES * 64 + F.tid, NGT = F.G * NWAVES * 64;
    bf16_t* sgw = (bf16_t*)(ws + WS_SMALL + SM_SGW);
    for (int i = gt; i < 2 * 4 * 128 * 128; i += NGT) sgw[i] = (bf16_t)f2bf(Ap->sg_w[i]);
    bf16_t* poolt = (bf16_t*)(ws + WS_SMALL + SM_POOLT);
    for (int i = gt; i < 2 * 4 * 64 * 64; i += NGT) { const int lg = i >> 12, d = (i >> 6) & 63, c = i & 63; poolt[i] = (bf16_t)f2bf(Ap->pool_w[(lg << 12) + c * 64 + d]); }
    if (gw < 16) {
        const int l = gw >> 3, h = gw & 7;
        float mq = fabsf(Ap->q_norm[(l * 8 + h) * 64 + lane]), mk = fabsf(Ap->k_norm[(l * 8 + h) * 64 + lane]), mb = 0.f;
        for (int i = lane; i < 15 * 31; i += 64) mb = fmaxf(mb, fabsf(Ap->rpb[(l * 8 + h) * 465 + i]));
#pragma unroll
        for (int o = 1; o < 64; o <<= 1) { mq = fmaxf(mq, __shfl_xor(mq, o)); mk = fmaxf(mk, __shfl_xor(mk, o)); mb = fmaxf(mb, __shfl_xor(mb, o)); }
        if (lane == 0) ((float*)(ws + WS_SMALL + SM_B2))[gw] = LOG2E * (8.0f * mq * mk + mb);
    }
}

__device__ __forceinline__ const float* modp(KArgs Ap, int l, int cls) { return (const float*)(Ap->ws + WS_CTL) + CW_MOD + (l * 2 + cls) * 6144; }

__device__ __forceinline__ void phase_n1(KArgs Ap, const Frame& F0, int l) {
    const Frame F = fresh(F0);
    const int gw = F.vcu * NWAVES + F.wave, NGW = F.G * NWAVES, lane = F.lane;
    bf16_t* XN = (bf16_t*)(Ap->ws + WS_XN); const bf16_t* Y = (const bf16_t*)(Ap->ws + WS_Y); float* hctx = (float*)(Ap->ws + WS_HCTX);
    for (int row = gw; row < MROWS; row += NGW) {
        const int cls = row >= NTOK;
        const float* src = (l == 0) ? (cls ? Ap->ctx + (size_t)(row - NTOK) * DM : Ap->x + (size_t)row * DM) : (cls ? hctx + (size_t)(row - NTOK) * DM : Ap->out + (size_t)row * DM);
        float* dst = cls ? hctx + (size_t)(row - NTOK) * DM : Ap->out + (size_t)row * DM;
        f32x4 v[4]; float ss = 0.f;
#pragma unroll
        for (int j = 0; j < 4; ++j) v[j] = *(const f32x4*)(src + lane * 4 + 256 * j);
        if (l > 0) {
#pragma unroll
            for (int j = 0; j < 4; ++j) {
                const bf16x4 y0 = *(const bf16x4*)(Y + (size_t)(2 * row) * DM + lane * 4 + 256 * j), y1 = *(const bf16x4*)(Y + (size_t)(2 * row + 1) * DM + lane * 4 + 256 * j);
#pragma unroll
                for (int q = 0; q < 4; ++q) v[j][q] += bf2f((unsigned short)y0[q]) + bf2f((unsigned short)y1[q]);
                *(f32x4*)(dst + lane * 4 + 256 * j) = v[j];
            }
        }
#pragma unroll
        for (int j = 0; j < 4; ++j) ss += (v[j].x * v[j].x + v[j].y * v[j].y) + (v[j].z * v[j].z + v[j].w * v[j].w);
        const float r = 1.0f / sqrtf(wave_sum(ss) * (1.0f / DM) + EPS);
        const float* md = modp(Ap, l, cls);
#pragma unroll
        for (int j = 0; j < 4; ++j) {
            const int k = lane * 4 + 256 * j;
            const f32x4 nw = *(const f32x4*)(Ap->norm1 + l * DM + k), sh = *(const f32x4*)(md + k), sc = *(const f32x4*)(md + 1024 + k);
            const f32x4 hn = v[j] * r * nw * (sc + 1.0f) + sh;
            u32x2 w; w.x = cvt_pk_bf16(hn.x, hn.y); w.y = cvt_pk_bf16(hn.z, hn.w);
            *(u32x2*)(XN + (size_t)row * DM + k) = w;
        }
    }
}
__device__ __forceinline__ void phase_final(KArgs Ap, const Frame& F0) {
    const Frame F = fresh(F0);
    const int gw = F.vcu * NWAVES + F.wave, NGW = F.G * NWAVES, lane = F.lane;
    const bf16_t* Y = (const bf16_t*)(Ap->ws + WS_Y);
    for (int row = gw; row < NTOK; row += NGW) {
        float* dst = Ap->out + (size_t)row * DM;
#pragma unroll
        for (int j = 0; j < 4; ++j) {
            f32x4 v = *(const f32x4*)(dst + lane * 4 + 256 * j);
            const bf16x4 y0 = *(const bf16x4*)(Y + (size_t)(2 * row) * DM + lane * 4 + 256 * j), y1 = *(const bf16x4*)(Y + (size_t)(2 * row + 1) * DM + lane * 4 + 256 * j);
#pragma unroll
            for (int q = 0; q < 4; ++q) v[q] += bf2f((unsigned short)y0[q]) + bf2f((unsigned short)y1[q]);
            *(f32x4*)(dst + lane * 4 + 256 * j) = v;
        }
    }
}

__device__ __forceinline__ void phase_n2(KArgs Ap, const Frame& F0, int l, bool dry = false) {
    const Frame F = fresh(F0);
    const int lane = F.lane;
    bf16_t* XN = (bf16_t*)(Ap->ws + WS_XN); float* hctx = (float*)(Ap->ws + WS_HCTX);
    LAS int* cntL = (LAS int*)(F.lds);
    LAS int* baseL = cntL + 16;
    LAS int* listL = cntL + 32;
    int* glist = (int*)(Ap->ws + WS_LIST); float* gwt = (float*)(Ap->ws + WS_GW);
    unsigned* gcnt = (unsigned*)(Ap->ws + WS_CTL) + CW_CNT + l * 16;
    if (F.tid < 16) cntL[F.tid] = 0;
    __syncthreads();
    const int nrows = (l == 0) ? MROWS : NTOK, rpb = nrows / F.G;
    const int r0 = F.vcu * rpb, r1 = (F.vcu == F.G - 1) ? nrows : r0 + rpb;
    for (int row = r0 + F.wave; row < r1; row += NWAVES) {
        const int cls = row >= NTOK;
        const float* src = cls ? hctx + (size_t)(row - NTOK) * DM : Ap->out + (size_t)row * DM;
        f32x4 v[4]; float ss = 0.f;
#pragma unroll
        for (int j = 0; j < 4; ++j) { v[j] = *(const f32x4*)(src + lane * 4 + 256 * j); ss += (v[j].x * v[j].x + v[j].y * v[j].y) + (v[j].z * v[j].z + v[j].w * v[j].w); }
        const float r = 1.0f / sqrtf(wave_sum(ss) * (1.0f / DM) + EPS);
        const float* md = modp(Ap, l, cls);
        float lg[16];
#pragma unroll
        for (int e = 0; e < 16; ++e) lg[e] = 0.f;
#pragma unroll
        for (int j = 0; j < 4; ++j) {
            const int k = lane * 4 + 256 * j;
            const f32x4 nw = *(const f32x4*)(Ap->norm2 + l * DM + k), sh = *(const f32x4*)(md + 3072 + k), sc = *(const f32x4*)(md + 4096 + k);
            const f32x4 hn = v[j] * r * nw * (sc + 1.0f) + sh;
            u32x2 w; w.x = cvt_pk_bf16(hn.x, hn.y); w.y = cvt_pk_bf16(hn.z, hn.w);
            *(u32x2*)(XN + (size_t)row * DM + k) = w;
#pragma unroll
            for (int q = 0; q < 4; ++q) {
                const float* wr_ = Ap->w_router + (size_t)(k + q) * 16;
#pragma unroll
                for (int e4 = 0; e4 < 4; ++e4) { const f32x4 ww = *(const f32x4*)(wr_ + e4 * 4);
                    lg[e4 * 4 + 0] += hn[q] * ww.x; lg[e4 * 4 + 1] += hn[q] * ww.y; lg[e4 * 4 + 2] += hn[q] * ww.z; lg[e4 * 4 + 3] += hn[q] * ww.w; }
            }
        }
        float mx = -3.0e38f;
#pragma unroll
        for (int e = 0; e < 16; ++e) { lg[e] = wave_sum(lg[e]) + Ap->b_router[e]; mx = fmaxf(mx, lg[e]); }
        float p[16];
#pragma unroll
        for (int e = 0; e < 16; ++e) p[e] = __expf(lg[e] - mx);
        float gs[4];
#pragma unroll
        for (int g = 0; g < 4; ++g) { const float a = p[4 * g], b = p[4 * g + 1], c = p[4 * g + 2], d = p[4 * g + 3];
            const float h1 = fmaxf(a, b), l1 = fminf(a, b), h2 = fmaxf(c, d), l2 = fminf(c, d);
            gs[g] = fmaxf(h1, h2) + fmaxf(fminf(h1, h2), fmaxf(l1, l2)); }
        int bg = 0; float bv = gs[0];
#pragma unroll
        for (int g = 1; g < 4; ++g) if (gs[g] > bv) { bv = gs[g]; bg = g; }
        float xg[4];
#pragma unroll
        for (int i = 0; i < 4; ++i) xg[i] = (bg == 0) ? p[i] : (bg == 1) ? p[4 + i] : (bg == 2) ? p[8 + i] : p[12 + i];
        int i1 = 0; float v1 = xg[0];
#pragma unroll
        for (int i = 1; i < 4; ++i) if (xg[i] > v1) { v1 = xg[i]; i1 = i; }
        int i2 = -1; float v2 = -1.f;
#pragma unroll
        for (int i = 0; i < 4; ++i) if (i != i1 && xg[i] > v2) { v2 = xg[i]; i2 = i; }
        const float inv = 1.0f / (v1 + v2);
        if (lane == 0 && !dry) {
            const int e1 = bg * 4 + i1, e2 = bg * 4 + i2;
            const int p1 = __hip_atomic_fetch_add(cntL + e1, 1, __ATOMIC_RELAXED, __HIP_MEMORY_SCOPE_WORKGROUP); listL[e1 * 136 + p1] = 2 * row;
            const int p2 = __hip_atomic_fetch_add(cntL + e2, 1, __ATOMIC_RELAXED, __HIP_MEMORY_SCOPE_WORKGROUP); listL[e2 * 136 + p2] = 2 * row + 1;
            gwt[2 * row] = v1 * inv; gwt[2 * row + 1] = v2 * inv;
        }
    }
    __syncthreads();
    if (dry) return;
    if (F.tid < 16) baseL[F.tid] = (int)__hip_atomic_fetch_add(gcnt + F.tid, (unsigned)cntL[F.tid], __ATOMIC_RELAXED, __HIP_MEMORY_SCOPE_AGENT);
    __syncthreads();
    for (int e = 0; e < 16; ++e) { const int n = cntL[e], b = baseL[e];
        for (int i = F.tid; i < n; i += NWAVES * 64) glist[(size_t)e * LIST_CAP + b + i] = listL[e * 136 + i]; }
    __syncthreads();
}

__device__ __forceinline__ bf16x8 ld8(const bf16_t* p) { return *(const bf16x8*)p; }
__device__ __forceinline__ bf16x8 ld4x2(const bf16_t* p0, const bf16_t* p1) { const bf16x4 a = *(const bf16x4*)p0, b = *(const bf16x4*)p1; return (bf16x8){a[0], a[1], a[2], a[3], b[0], b[1], b[2], b[3]}; }
#define MFMA16(a, b, c) __builtin_amdgcn_mfma_f32_16x16x32_bf16((a), (b), (c), 0, 0, 0)

template <int P, bool LOCAL>
__device__ __forceinline__ void attn_pair(const bf16x8 (&q)[4][2], f32x4 (&O)[4][4], float (&ls)[4], const bf16x8 (&k)[2][2], const bf16x8 (&v)[4],
                                          const LAS float* bl  , const int csg  , const int fr, const int g, const float B2) {
#pragma unroll
    for (int j = 0; j < 4; ++j) {
        if (LOCAL && ((P == 0 && j == 3) || (P == 1 && j == 0))) continue;
        float p[8];
#pragma unroll
        for (int s2 = 0; s2 < 2; ++s2) {
            const int kb = 2 * P + s2, dk = kb - j;
            if (LOCAL && (dk < -1 || dk > 1)) {
#pragma unroll
                for (int i = 0; i < 4; ++i) p[s2 * 4 + i] = 0.f;
                continue;
            }
            f32x4 S = MFMA16(k[s2][0], q[j][0], ((f32x4){0.f, 0.f, 0.f, 0.f}));
            S = MFMA16(k[s2][1], q[j][1], S);
#pragma unroll
            for (int i = 0; i < 4; ++i) {
                float pv;
                if (LOCAL) {
                    const int kc = 16 * kb + 4 * g + i;
                    const int cs = (j == 0) ? max(fr - 8, 0) : (j == 3) ? min(40 + fr, 48) : 16 * j + fr - 8;
                    const bool valid = (unsigned)(kc - cs) < 16u;
                    pv = __builtin_amdgcn_exp2f(S[i] + bl[16 * dk + i]); pv = valid ? pv : 0.f; }
                else pv = __builtin_amdgcn_exp2f(S[i] - B2);
                p[s2 * 4 + i] = pv; ls[j] += pv;
            }
        }
        u32x4 pw; pw.x = cvt_pk_bf16(p[0], p[1]); pw.y = cvt_pk_bf16(p[2], p[3]); pw.z = cvt_pk_bf16(p[4], p[5]); pw.w = cvt_pk_bf16(p[6], p[7]);
        const bf16x8 Pf = __builtin_bit_cast(bf16x8, pw);
#pragma unroll
        for (int d = 0; d < 4; ++d) O[j][d] = MFMA16(v[d], Pf, O[j][d]);
    }
}
template <bool LAT>
__device__ __forceinline__ void attn_row(KArgs Ap, const LAS float* biasL, const float B2, int r, int qt0, int h, int lane) {
    const char* PQKU = (const char*)(Ap->ws + WS_PQKU); const char* VT = (const char*)(Ap->ws + WS_VT); bf16_t* mix = (bf16_t*)(Ap->ws + WS_MIX);
    const int fr = lane & 15, g = lane >> 4;
    const unsigned koff = (unsigned)(fr * PQKU_LD + h * 64 + 8 * g) * 2u;
    const unsigned voff = (unsigned)((h * 64 + fr) * VT_LD + 4 * g) * 2u;
    bf16x8 q[4][2];
#pragma unroll
    for (int j = 0; j < 4; ++j) { const char* qp = PQKU + (size_t)(qt0 + 16 * j) * (PQKU_LD * 2) + 256 * 2; q[j][0] = *(const bf16x8*)(qp + koff); q[j][1] = *(const bf16x8*)(qp + koff + 64); }
    f32x4 O[4][4]; float ls[4];
#pragma unroll
    for (int j = 0; j < 4; ++j) { ls[j] = 0.f;
#pragma unroll
        for (int d = 0; d < 4; ++d) O[j][d] = (f32x4){0.f, 0.f, 0.f, 0.f}; }
#define ATT_LDK(kk, tok) do { const char* kp_ = PQKU + (size_t)(tok) * (PQKU_LD * 2) + 768 * 2; kk[0][0] = *(const bf16x8*)(kp_ + koff); kk[0][1] = *(const bf16x8*)(kp_ + koff + 64); \
        kk[1][0] = *(const bf16x8*)(kp_ + 16 * PQKU_LD * 2 + koff); kk[1][1] = *(const bf16x8*)(kp_ + 16 * PQKU_LD * 2 + koff + 64); } while (0)
#define ATT_LDV(vv, tok) do { _Pragma("unroll") for (int d_ = 0; d_ < 4; ++d_) { const char* vp_ = VT + ((size_t)(16 * d_) * VT_LD + (tok)) * 2; \
        const bf16x4 a_ = *(const bf16x4*)(vp_ + voff), b_ = *(const bf16x4*)(vp_ + voff + 32); vv[d_] = (bf16x8){a_[0], a_[1], a_[2], a_[3], b_[0], b_[1], b_[2], b_[3]}; } } while (0)
    bf16x8 kA[2][2], kB[2][2], v[4];
    const LAS float* blane = biasL + 16 + 4 * g - fr + 15;
    if (LAT) {
        const int rs = min(max(r - 4, 0), 248);
        ATT_LDK(kA, rs * 64);
#pragma unroll 1
        for (int a = 0; a < 8; ++a) {
            const int tb = (rs + a) * 64;
            const LAS float* bl = blane + (rs + a - r + 7) * 64;
            ATT_LDV(v, tb); ATT_LDK(kB, tb + 32);
            attn_pair<0, true>(q, O, ls, kA, v, bl, 0, fr, g, B2);
            ATT_LDV(v, tb + 32); ATT_LDK(kA, (a < 7) ? tb + 64 : NTOK);
            attn_pair<1, true>(q, O, ls, kB, v, bl, 0, fr, g, B2);
        }
    } else {
        ATT_LDK(kA, NTOK);
    }
#pragma unroll 1
    for (int cp = 0; cp < 8; cp += 2) {
        ATT_LDV(v, NTOK + 32 * cp); ATT_LDK(kB, NTOK + 32 * (cp + 1));
        attn_pair<0, false>(q, O, ls, kA, v, blane, 0, fr, g, B2);
        ATT_LDV(v, NTOK + 32 * (cp + 1)); ATT_LDK(kA, NTOK + 32 * min(cp + 2, 7));
        attn_pair<0, false>(q, O, ls, kB, v, blane, 0, fr, g, B2);
    }
#undef ATT_LDK
#undef ATT_LDV
#pragma unroll
    for (int j = 0; j < 4; ++j) {
        float l_ = ls[j]; l_ += __shfl_xor(l_, 16); l_ += __shfl_xor(l_, 32);
        const float inv = 1.0f / l_;
        bf16_t* op = mix + (size_t)(qt0 + 16 * j + fr) * DM + 256 + h * 64 + 4 * g;
#pragma unroll
        for (int d = 0; d < 4; ++d) { u32x2 w; w.x = cvt_pk_bf16(O[j][d][0] * inv, O[j][d][1] * inv); w.y = cvt_pk_bf16(O[j][d][2] * inv, O[j][d][3] * inv); *(u32x2*)(op + 16 * d) = w; }
    }
}
__device__ __forceinline__ void pool_item(KArgs Ap, int l, int t0, int g4, int lane) {
    const bf16_t* PQKU = (const bf16_t*)(Ap->ws + WS_PQKU); bf16_t* mix = (bf16_t*)(Ap->ws + WS_MIX);
    const bf16_t* WT = (const bf16_t*)(Ap->ws + WS_SMALL + SM_POOLT) + (size_t)(l * 4 + g4) * 4096;
    const int fr = lane & 15, gq = lane >> 4;
    const int t = t0 + fr, base = (t >= NTOK) ? NTOK : 0, L = (t >= NTOK) ? NCTX : NTOK, tt = t - base;
    const int hw = 1 << g4;
    const int lo = max(tt - hw, 0), hi = min(tt + hw, L);
    const float invn = 1.0f / (float)(hi - lo);
    bf16x8 Bf[2];
#pragma unroll
    for (int s = 0; s < 2; ++s) {
        const int c0 = g4 * 64 + 32 * s + 8 * gq;
        float acc8[8];
#pragma unroll
        for (int q = 0; q < 8; ++q) acc8[q] = 0.f;
        for (int u = lo; u < hi; ++u) { const bf16x8 vv = ld8(PQKU + (size_t)(base + u) * PQKU_LD + c0);
#pragma unroll
            for (int q = 0; q < 8; ++q) acc8[q] += bf2f((unsigned short)vv[q]); }
        const bf16x8 self = ld8(PQKU + (size_t)t * PQKU_LD + c0);
        u32x4 w;
        float dq[8];
#pragma unroll
        for (int q = 0; q < 8; ++q) dq[q] = acc8[q] * invn - bf2f((unsigned short)self[q]);
        w.x = cvt_pk_bf16(dq[0], dq[1]); w.y = cvt_pk_bf16(dq[2], dq[3]); w.z = cvt_pk_bf16(dq[4], dq[5]); w.w = cvt_pk_bf16(dq[6], dq[7]);
        Bf[s] = __builtin_bit_cast(bf16x8, w);
    }
#pragma unroll
    for (int mb = 0; mb < 4; ++mb) {
        const bf16_t* wp = WT + (size_t)(16 * mb + fr) * 64 + 8 * gq;
        f32x4 o = MFMA16(ld8(wp), Bf[0], ((f32x4){0.f, 0.f, 0.f, 0.f}));
        o = MFMA16(ld8(wp + 32), Bf[1], o);
        const f32x4 ps = *(const f32x4*)(Ap->pool_scale + l * 256 + g4 * 64 + 16 * mb + 4 * gq);
        u32x2 w; w.x = cvt_pk_bf16(o[0] * ps[0], o[1] * ps[1]); w.y = cvt_pk_bf16(o[2] * ps[2], o[3] * ps[3]);
        *(u32x2*)(mix + (size_t)t * DM + g4 * 64 + 16 * mb + 4 * gq) = w;
    }
}
__device__ __forceinline__ void sg_item(KArgs Ap, int l, int ch, int h, int pb, int lane) {
    const bf16_t* PQKU = (const bf16_t*)(Ap->ws + WS_PQKU); const bf16_t* VT = (const bf16_t*)(Ap->ws + WS_VT); bf16_t* mix = (bf16_t*)(Ap->ws + WS_MIX);
    const bf16_t* W = (const bf16_t*)(Ap->ws + WS_SMALL + SM_SGW) + (size_t)(l * 4 + h) * 16384;
    const int fr = lane & 15, gq = lane >> 4;
    const int p = 16 * pb + fr, tok = ch * 128 + p;
    f32x4 acc[4];
#pragma unroll
    for (int mb = 0; mb < 4; ++mb) acc[mb] = (f32x4){0.f, 0.f, 0.f, 0.f};
#pragma unroll
    for (int s = 0; s < 4; ++s) {
        const bf16x8 Bf = ld8(W + (size_t)p * 128 + 32 * s + 8 * gq);
#pragma unroll
        for (int mb = 0; mb < 4; ++mb) acc[mb] = MFMA16(ld8(VT + (size_t)(512 + h * 64 + 16 * mb + fr) * VT_LD + ch * 128 + 32 * s + 8 * gq), Bf, acc[mb]);
    }
    const float bias = Ap->sg_b[(l * 4 + h) * 128 + p];
#pragma unroll
    for (int mb = 0; mb < 4; ++mb) {
        const bf16x4 u4 = *(const bf16x4*)(PQKU + (size_t)tok * PQKU_LD + 1280 + h * 64 + 16 * mb + 4 * gq);
        u32x2 w; w.x = cvt_pk_bf16(bf2f((unsigned short)u4[0]) * (acc[mb][0] + bias), bf2f((unsigned short)u4[1]) * (acc[mb][1] + bias));
        w.y = cvt_pk_bf16(bf2f((unsigned short)u4[2]) * (acc[mb][2] + bias), bf2f((unsigned short)u4[3]) * (acc[mb][3] + bias));
        *(u32x2*)(mix + (size_t)tok * DM + 768 + h * 64 + 16 * mb + 4 * gq) = w;
    }
}
__device__ __forceinline__ void phase_mix(KArgs Ap, const Frame& F0, int l) {
    const Frame F = fresh(F0);
    const int gw = F.vcu * NWAVES + F.wave, NGW = F.G * NWAVES, lane = F.lane;
    LAS float* biasL = (LAS float*)F.lds;
    const float* B2t = (const float*)(Ap->ws + WS_SMALL + SM_B2) + l * 8;
    for (int i = F.tid; i < 8 * 15 * 64; i += NWAVES * 64) { const int h = i / 960, rr = (i % 960) >> 6, cc = (i & 63) - 16;
        biasL[i] = (cc >= 0 && cc < 31) ? Ap->rpb[(size_t)(l * 8 + h) * 465 + rr * 31 + cc] * LOG2E - B2t[h] : 0.f; }
    __syncthreads();
    const int n_att = 256 * 8, n_actx = (l == 0) ? 4 * 8 : 0;
    for (int it = gw; it < n_att + n_actx; it += NGW) {
        const int h = it & 7;
        if (it < n_att) attn_row<true>(Ap, biasL + h * 960, B2t[h], it >> 3, (it >> 3) * 64, h, lane);
        else attn_row<false>(Ap, biasL + h * 960, B2t[h], 0, NTOK + 64 * ((it - n_att) >> 3), h, lane);
    }
    const int nrow_t = (l == 0) ? MROWS : NTOK;
    const int n_pool = (nrow_t / 16) * 4, n_sg = (nrow_t / 128) * 4 * 8;
    for (int it = gw; it < n_pool + n_sg; it += NGW) {
        int r = it;
        if (r < n_pool) { pool_item(Ap, l, (r >> 2) * 16, r & 3, lane); continue; }
        r -= n_pool;
        sg_item(Ap, l, r >> 5, (r >> 3) & 3, r & 7, lane);
    }
    __syncthreads();
}

using pg8::Unit;
struct SchedInN { const char* A; const char* B; int G, c;
    __device__ __forceinline__ bool next(int i, Unit& u) const { u.e = 0; return pg8::static_unit(i, G, c, 65, 6, u.pm, u.pn); }
    __device__ __forceinline__ const char* a_base(const Unit& u) const { return A + (size_t)u.pm * 256 * DM * 2; }
    __device__ __forceinline__ const char* b_base(const Unit& u) const { return B + (size_t)u.pn * 256 * DM * 2; } };
struct SchedInT { const char* A; const char* B; int G, c;
    __device__ __forceinline__ bool next(int i, Unit& u) const { u.e = 0; return pg8::static_unit(i, G, c, 3, 65, u.pm, u.pn); }
    __device__ __forceinline__ const char* a_base(const Unit& u) const { return A + (size_t)(1536 + u.pm * 256) * DM * 2; }
    __device__ __forceinline__ const char* b_base(const Unit& u) const { return B + (size_t)u.pn * 256 * DM * 2; } };
struct SchedOut { const char* A; const char* B; int G, c, nM;
    __device__ __forceinline__ bool next(int i, Unit& u) const { u.e = 0; return pg8::static_unit(i, G, c, nM, 4, u.pm, u.pn); }
    __device__ __forceinline__ const char* a_base(const Unit& u) const { return A + (size_t)u.pm * 256 * DM * 2; }
    __device__ __forceinline__ const char* b_base(const Unit& u) const { return B + (size_t)u.pn * 256 * DM * 2; } };
struct SchedMoe { const char* A; const char* B; const LAS int* cnt; int G, c; size_t bstride_e, bstride_pn;
    __device__ __forceinline__ bool next(int i, Unit& u) const {
        int L = i * G + c;
#pragma unroll 1
        for (int e = 0; e < NEXP; ++e) { const int nu = ((cnt[e] + 255) >> 8) * 4; if (L < nu) { u.e = e; u.pm = L >> 2; u.pn = L & 3; return true; } L -= nu; }
        return false; }
    __device__ __forceinline__ const char* a_base(const Unit&) const { return A; }
    __device__ __forceinline__ const char* b_base(const Unit& u) const { return B + (size_t)u.e * bstride_e + (size_t)u.pn * bstride_pn; } };

struct EpiInN {
    bf16_t* O; const float* qw; const float* kw;
    __device__ __forceinline__ void operator()(f32x4 (&acc)[2][2][4][2], const Unit& u, int, int wr, int wc, int fr, int fq) const {
        const int type = (u.pn == 0) ? 0 : (u.pn <= 2) ? 1 : (u.pn <= 4) ? 2 : 3;
        const int head = (type == 1) ? (u.pn - 1) * 4 + wc : (type == 2) ? (u.pn - 3) * 4 + wc : 0;
        f32x4 wv[2][2];
#pragma unroll
        for (int bj = 0; bj < 2; ++bj)
#pragma unroll
            for (int n = 0; n < 2; ++n) {
                const int d = 32 * bj + 8 * fq + 4 * n;
                wv[bj][n] = (type == 1) ? *(const f32x4*)(qw + head * 64 + d) * (0.125f * LOG2E) : (type == 2) ? *(const f32x4*)(kw + head * 64 + d) : (f32x4){1.f, 1.f, 1.f, 1.f};
            }
        const int row0 = u.pm * 256 + wr * 64 + fr, col0 = u.pn * 256 + wc * 64 + 8 * fq;
#pragma unroll
        for (int ai = 0; ai < 2; ++ai)
#pragma unroll
            for (int m = 0; m < 4; ++m) {
                f32x4 v[2][2];
#pragma unroll
                for (int bj = 0; bj < 2; ++bj)
#pragma unroll
                    for (int n = 0; n < 2; ++n) v[bj][n] = acc[ai][bj][m][n];
                if (type == 1 || type == 2) {
                    float ss = 0.f;
#pragma unroll
                    for (int bj = 0; bj < 2; ++bj)
#pragma unroll
                        for (int n = 0; n < 2; ++n) ss += (v[bj][n][0] * v[bj][n][0] + v[bj][n][1] * v[bj][n][1]) + (v[bj][n][2] * v[bj][n][2] + v[bj][n][3] * v[bj][n][3]);
                    ss += __shfl_xor(ss, 16); ss += __shfl_xor(ss, 32);
                    const float r = 1.0f / sqrtf(ss * (1.0f / 64.0f) + EPS);
#pragma unroll
                    for (int bj = 0; bj < 2; ++bj)
#pragma unroll
                        for (int n = 0; n < 2; ++n) v[bj][n] = v[bj][n] * r * wv[bj][n];
                } else if (type == 3) {
#pragma unroll
                    for (int bj = 0; bj < 2; ++bj)
#pragma unroll
                        for (int n = 0; n < 2; ++n)
#pragma unroll
                            for (int q = 0; q < 4; ++q) v[bj][n][q] = gelu_tanh(v[bj][n][q]);
                }
                bf16_t* rowp = O + (size_t)(row0 + ai * 128 + m * 16) * PQKU_LD + col0;
#pragma unroll
                for (int bj = 0; bj < 2; ++bj) { u32x4 w; w.x = cvt_pk_bf16(v[bj][0][0], v[bj][0][1]); w.y = cvt_pk_bf16(v[bj][0][2], v[bj][0][3]); w.z = cvt_pk_bf16(v[bj][1][0], v[bj][1][1]); w.w = cvt_pk_bf16(v[bj][1][2], v[bj][1][3]);
                    *(u32x4*)(rowp + 32 * bj) = w; }
            }
    }
};
struct EpiInT {
    bf16_t* O; const float* sgn;
    __device__ __forceinline__ void operator()(f32x4 (&acc)[2][2][4][2], const Unit& u, int, int wr, int wc, int fr, int fq) const {
        const int col0 = u.pn * 256 + wc * 32 + 8 * fq;
#pragma unroll
        for (int ai = 0; ai < 2; ++ai) {
            if (u.pm == 2) {
                const int head = 2 * ai + wr;
                float sw[4];
#pragma unroll
                for (int m = 0; m < 4; ++m) sw[m] = sgn[head * 64 + 16 * m + fr];
#pragma unroll
                for (int bj = 0; bj < 2; ++bj)
#pragma unroll
                    for (int n = 0; n < 2; ++n) {
                        f32x4 ss = (f32x4){0.f, 0.f, 0.f, 0.f};
#pragma unroll
                        for (int m = 0; m < 4; ++m) {
#pragma unroll
                            for (int q = 0; q < 4; ++q) acc[ai][bj][m][n][q] = gelu_tanh(acc[ai][bj][m][n][q]);
                            ss += acc[ai][bj][m][n] * acc[ai][bj][m][n]; }
#pragma unroll
                        for (int q = 0; q < 4; ++q) { float t = ss[q]; t += __shfl_xor(t, 1); t += __shfl_xor(t, 2); t += __shfl_xor(t, 4); t += __shfl_xor(t, 8); ss[q] = 1.0f / sqrtf(t * (1.0f / 64.0f) + EPS); }
#pragma unroll
                        for (int m = 0; m < 4; ++m) acc[ai][bj][m][n] = acc[ai][bj][m][n] * ss * sw[m];
                    }
            }
#pragma unroll
            for (int m = 0; m < 4; ++m) {
                bf16_t* rowp = O + (size_t)(u.pm * 256 + ai * 128 + wr * 64 + m * 16 + fr) * VT_LD + col0;
#pragma unroll
                for (int bj = 0; bj < 2; ++bj) { const f32x4 v0 = acc[ai][bj][m][0], v1 = acc[ai][bj][m][1];
                    u32x4 w; w.x = cvt_pk_bf16(v0[0], v0[1]); w.y = cvt_pk_bf16(v0[2], v0[3]); w.z = cvt_pk_bf16(v1[0], v1[1]); w.w = cvt_pk_bf16(v1[2], v1[3]);
                    *(u32x4*)(rowp + 128 * bj) = w; }
            }
        }
    }
};
struct EpiOut {
    const float* base_lat; const float* base_ctx; float* out_lat; float* out_ctx; const float* g_lat; const float* g_ctx;
    __device__ __forceinline__ void operator()(f32x4 (&acc)[2][2][4][2], const Unit& u, int, int wr, int wc, int fr, int fq) const {
        const bool cx = u.pm >= 64;
        const float* base = cx ? base_ctx : base_lat; float* out = cx ? out_ctx : out_lat; const float* gt = cx ? g_ctx : g_lat;
        const int row0 = (cx ? 0 : u.pm * 256) + wr * 64 + fr, col0 = u.pn * 256 + wc * 32 + 4 * fq;
        f32x4 gv[2][2];
#pragma unroll
        for (int bj = 0; bj < 2; ++bj)
#pragma unroll
            for (int n = 0; n < 2; ++n) gv[bj][n] = *(const f32x4*)(gt + col0 + bj * 128 + n * 16);
#pragma unroll
        for (int ai = 0; ai < 2; ++ai)
#pragma unroll
            for (int m = 0; m < 4; ++m) { const size_t off = (size_t)(row0 + ai * 128 + m * 16) * DM + col0;
#pragma unroll
                for (int bj = 0; bj < 2; ++bj)
#pragma unroll
                    for (int n = 0; n < 2; ++n) { const f32x4 b = *(const f32x4*)(base + off + bj * 128 + n * 16); *(f32x4*)(out + off + bj * 128 + n * 16) = b + gv[bj][n] * acc[ai][bj][m][n]; } }
    }
};
struct EpiG1 {
    bf16_t* H; const LAS int* idxl;
    __device__ __forceinline__ void operator()(f32x4 (&acc)[2][2][4][2], const Unit& u, int ui, int wr, int wc, int fr, int fq) const {
        const int col0 = u.pn * 128 + wc * 32 + 8 * fq;
#pragma unroll
        for (int ai = 0; ai < 2; ++ai)
#pragma unroll
            for (int m = 0; m < 4; ++m) {
                const int ent = idxl[ui * 256 + ai * 128 + wr * 64 + m * 16 + fr];
                float hv[8];
#pragma unroll
                for (int n = 0; n < 2; ++n)
#pragma unroll
                    for (int q = 0; q < 4; ++q) hv[n * 4 + q] = silu_f(acc[ai][0][m][n][q]) * acc[ai][1][m][n][q];
                if (ent >= 0) { u32x4 w; w.x = cvt_pk_bf16(hv[0], hv[1]); w.y = cvt_pk_bf16(hv[2], hv[3]); w.z = cvt_pk_bf16(hv[4], hv[5]); w.w = cvt_pk_bf16(hv[6], hv[7]);
                    *(u32x4*)(H + (size_t)ent * DEXP + col0) = w; }
            }
    }
};
struct EpiG2 {
    bf16_t* Y; const LAS int* idxl; const float* gwt; const float* g_lat; const float* g_ctx;
    __device__ __forceinline__ void operator()(f32x4 (&acc)[2][2][4][2], const Unit& u, int ui, int wr, int wc, int fr, int fq) const {
        const int col0 = u.pn * 256 + wc * 32 + 8 * fq;
#pragma unroll
        for (int ai = 0; ai < 2; ++ai)
#pragma unroll
            for (int m = 0; m < 4; ++m) {
                const int ent = idxl[ui * 256 + ai * 128 + wr * 64 + m * 16 + fr];
                if (ent >= 0) {
                    const float gwv = gwt[ent]; const float* gt = (ent >= 2 * NTOK) ? g_ctx : g_lat;
#pragma unroll
                    for (int bj = 0; bj < 2; ++bj) {
                        const f32x4 g0 = *(const f32x4*)(gt + col0 + bj * 128), g1 = *(const f32x4*)(gt + col0 + bj * 128 + 4);
                        const f32x4 v0 = acc[ai][bj][m][0] * g0 * gwv, v1 = acc[ai][bj][m][1] * g1 * gwv;
                        u32x4 w; w.x = cvt_pk_bf16(v0[0], v0[1]); w.y = cvt_pk_bf16(v0[2], v0[3]); w.z = cvt_pk_bf16(v1[0], v1[1]); w.w = cvt_pk_bf16(v1[2], v1[3]);
                        *(u32x4*)(Y + (size_t)ent * DM + col0 + bj * 128) = w; }
                }
            }
    }
};

__device__ __forceinline__ void moe_setup(KArgs Ap, const Frame& F0, int l, LAS int* cntL, LAS int* idxl) {
    const Frame F = fresh(F0);
    const unsigned* gcnt = (const unsigned*)(Ap->ws + WS_CTL) + CW_CNT + l * 16;
    const int* glist = (const int*)(Ap->ws + WS_LIST);
    if (F.tid < 16) cntL[F.tid] = (int)gcnt[F.tid];
    __syncthreads();
    SchedMoe S{nullptr, nullptr, cntL, F.G, (int)blockIdx.x, 0, 0};
    Unit u;
    for (int i = 0; i < 8 && S.next(i, u); ++i) {
        const int n = cntL[u.e];
        if (F.tid < 256) { const int pos = u.pm * 256 + F.tid; const int* le = glist + (size_t)u.e * LIST_CAP;
            idxl[i * 256 + F.tid] = (pos < n) ? le[pos] : (int)((unsigned)le[0] | 0x80000000u); }
    }
    __syncthreads();
}

__global__ void __launch_bounds__(NWAVES * 64, 2) fwd_megakernel(Args A_unused) {
    extern __shared__ __attribute__((aligned(16))) unsigned char lds_raw[];
    Frame F;
    F.lds = (LAS unsigned char*)lds_raw;
    F.tid = threadIdx.x; F.lane = F.tid & 63; F.wave = __builtin_amdgcn_readfirstlane(F.tid >> 6);
    F.G = gridDim.x; { const int bx = blockIdx.x; F.vcu = (F.G % 8 == 0) ? (bx % 8) * (F.G / 8) + bx / 8 : bx; }
    volatile LAS unsigned* MISC = (volatile LAS unsigned*)(F.lds + MISC_OFF);
    for (int u = F.tid; u < 64; u += NWAVES * 64) MISC[u] = 0u;
    __syncthreads();
    XcdBarrier bar;
    { KArgs Ap = get_args(); bar = xcd_barrier_post((unsigned*)(Ap->ws + WS_CTL) + CW_BAR, MISC + 16); }
    LAS int* cntL = (LAS int*)(F.lds + MISC_OFF);
    LAS int* idxl = (LAS int*)(F.lds + IDX_OFF);

#define REPS(k, cond) (((DUP == (k)) && (cond)) ? 2 : 1)
#pragma unroll 1
    for (int rep = 0; rep < REPS(1, true); ++rep) { { KArgs Ap = get_args(); p0_prologue(Ap, F); } xcd_barrier(bar); }
#pragma unroll 1
    for (int l = 0; l < 2; ++l) {
#pragma unroll 1
        for (int rep = 0; rep < REPS(2, l == 0); ++rep) { { KArgs Ap = get_args(); phase_n1(Ap, F, l); } xcd_barrier(bar); }
#pragma unroll 1
        for (int rep = 0; rep < REPS(3, true); ++rep) {
        {
            KArgs Ap = get_args(); unsigned char* ws = Ap->ws; const Frame Fp = fresh(F); int bx = (int)blockIdx.x; asm volatile("" : "+s"(bx));
            SchedInN S1{(const char*)(ws + WS_XN), (const char*)(ws + WS_WIN) + (size_t)l * IN_DIM * DM * 2, Fp.G, bx};
            EpiInN E1{(bf16_t*)(ws + WS_PQKU), Ap->q_norm + l * 512, Ap->k_norm + l * 512};
            pg8::gemm_phase<EpiInN, SchedInN, 2, false, 0>(Fp.lds, idxl, DM, S1, E1);
        }
        {
            KArgs Ap = get_args(); unsigned char* ws = Ap->ws; const Frame Fp = fresh(F); int bx = (int)blockIdx.x; asm volatile("" : "+s"(bx));
            SchedInT S2{(const char*)(ws + WS_WIN) + (size_t)l * IN_DIM * DM * 2, (const char*)(ws + WS_XN), Fp.G, Fp.G - 1 - bx};
            EpiInT E2{(bf16_t*)(ws + WS_VT), Ap->sg_norm + l * 256};
            pg8::gemm_phase<EpiInT, SchedInT, 1, false, 0>(Fp.lds, idxl, DM, S2, E2);
        }
        xcd_barrier(bar);
        }
#pragma unroll 1
        for (int rep = 0; rep < REPS(4, true); ++rep) { { KArgs Ap = get_args(); phase_mix(Ap, F, l); } xcd_barrier(bar); }
#pragma unroll 1
        for (int rep = 0; rep < REPS(5, l == 0); ++rep) {
        {
            KArgs Ap = get_args(); unsigned char* ws = Ap->ws; const Frame Fp = fresh(F); int bx = (int)blockIdx.x; asm volatile("" : "+s"(bx));
            SchedOut S{(const char*)(ws + WS_MIX), (const char*)(ws + WS_WOUT) + (size_t)l * DM * DM * 2, Fp.G, bx, (l == 0) ? 65 : 64};
            EpiOut E{(l == 0) ? Ap->x : Ap->out, (l == 0) ? Ap->ctx : (const float*)(ws + WS_HCTX), Ap->out, (float*)(ws + WS_HCTX), modp(Ap, l, 0) + 2048, modp(Ap, l, 1) + 2048};
            pg8::gemm_phase<EpiOut, SchedOut, 0, false, 0>(Fp.lds, idxl, DM, S, E);
        }
        xcd_barrier(bar);
        }
        if (DUP == 8) { { KArgs Ap = get_args(); phase_n2(Ap, F, l, true); } xcd_barrier(bar); }
        { KArgs Ap = get_args(); phase_n2(Ap, F, l); }
        xcd_barrier(bar);
        { KArgs Ap = get_args(); moe_setup(Ap, F, l, cntL, idxl); }
#pragma unroll 1
        for (int rep = 0; rep < REPS(6, true); ++rep) {
        {
            KArgs Ap = get_args(); unsigned char* ws = Ap->ws; const Frame Fp = fresh(F); int bx = (int)blockIdx.x; asm volatile("" : "+s"(bx));
            SchedMoe S{(const char*)(ws + WS_XN), (const char*)(ws + WS_WGU) + (size_t)l * NEXP * 1024 * 1024 * 2, cntL, Fp.G, bx, (size_t)1024 * 1024 * 2, (size_t)256 * DM * 2};
            EpiG1 E{(bf16_t*)(ws + WS_H), idxl};
            pg8::gemm_phase<EpiG1, SchedMoe, 1, true, 1>(Fp.lds, idxl, DM, S, E);
        }
        xcd_barrier(bar);
        }
#pragma unroll 1
        for (int rep = 0; rep < REPS(7, true); ++rep) {
        {
            KArgs Ap = get_args(); unsigned char* ws = Ap->ws; const Frame Fp = fresh(F); int bx = (int)blockIdx.x; asm volatile("" : "+s"(bx));
            SchedMoe S{(const char*)(ws + WS_H), (const char*)(ws + WS_WDN) + (size_t)l * NEXP * 1024 * 512 * 2, cntL, Fp.G, bx, (size_t)1024 * 512 * 2, (size_t)256 * DEXP * 2};
            EpiG2 E{(bf16_t*)(ws + WS_Y), idxl, (const float*)(ws + WS_GW), modp(Ap, l, 0) + 5120, modp(Ap, l, 1) + 5120};
            pg8::gemm_phase<EpiG2, SchedMoe, 1, true, 0>(Fp.lds, idxl, DEXP, S, E);
        }
        xcd_barrier(bar);
        }
    }
    if (DUP == 9) { for (int rep = 0; rep < 16; ++rep) xcd_barrier(bar); }
    { KArgs Ap = get_args(); phase_final(Ap, F); }
    { KArgs Ap = get_args(); if (blockIdx.x == 0 && threadIdx.x == 0) { const unsigned t = xb_ld((unsigned*)(Ap->ws + WS_CTL) + CW_BAR + XB_TMO); if (t != 0u) { asm volatile("s_waitcnt vmcnt(0)" ::: "memory"); Ap->out[5] = __builtin_nanf(""); } } }
}

extern "C" void kernel_launch(void* const* d_in, const int* in_sizes, int n_in, void* d_out, int out_size, void* d_ws, size_t ws_size, hipStream_t stream) {
    static int grid = 0;
    if (grid == 0) {
        if (n_in != 23 || out_size != NTOK * DM || ws_size < WS_END) { fprintf(stderr, "kernel_launch: unexpected sizes (n_in %d out %d ws %zu)\n", n_in, out_size, ws_size); grid = -1; return; }
        int dev = 0, cus = 0, per_cu = 0;
        if (hipGetDevice(&dev) != hipSuccess || hipDeviceGetAttribute(&cus, hipDeviceAttributeMultiprocessorCount, dev) != hipSuccess) { grid = -1; return; }
        if (hipFuncSetAttribute((const void*)fwd_megakernel, hipFuncAttributeMaxDynamicSharedMemorySize, LDS_BYTES) != hipSuccess) { fprintf(stderr, "kernel_launch: hipFuncSetAttribute failed\n"); grid = -1; return; }
        if (hipOccupancyMaxActiveBlocksPerMultiprocessor(&per_cu, (const void*)fwd_megakernel, NWAVES * 64, LDS_BYTES) != hipSuccess || per_cu < 1) { fprintf(stderr, "kernel_launch: occupancy query says %d\n", per_cu); (void)hipGetLastError(); grid = -1; return; }
        grid = cus;
        if (grid != 256) fprintf(stderr, "kernel_launch: %d CUs (built for 256)\n", grid);
    }
    if (grid < 0) return;
    (void)hipMemsetAsync((char*)d_ws + WS_CTL, 0, CTL_ZERO_BYTES, stream);
    Args a{};
    const float** ap = (const float**)&a;
    for (int i = 0; i < 23; ++i) ap[i] = (const float*)d_in[i];
    a.out = (float*)d_out; a.ws = (unsigned char*)d_ws;
    void* args[] = {&a};
    hipError_t e = hipLaunchCooperativeKernel((const void*)fwd_megakernel, dim3(grid), dim3(NWAVES * 64), args, LDS_BYTES, stream);
    if (e != hipSuccess) fprintf(stderr, "kernel_launch: cooperative launch failed: %s\n", hipGetErrorString(e));
}
```

```cpp
#include <hip/hip_runtime.h>
#include <cstdio>
#include <cstdint>

#ifndef DUP
#define DUP 0
#endif
constexpr int NTOK = 16384, NCTX = 256, MROWS = NTOK + NCTX, DM = 1024, IN_DIM = 2304;
constexpr int NEXP = 16, DEXP = 512;
constexpr int PU_LD = 512;
constexpr int NBLK16 = MROWS / 16, NGRP32 = MROWS / 32, NCHUNK = MROWS / 128;
constexpr float EPS = 1e-6f;
constexpr float LOG2E = 1.4426950408889634f;

#define LAS __attribute__((address_space(3)))
#define GAS __attribute__((address_space(1)))
typedef unsigned short bf16_t;
typedef short bf16x8 __attribute__((ext_vector_type(8)));
typedef short bf16x4 __attribute__((ext_vector_type(4)));
typedef float f32x4 __attribute__((ext_vector_type(4)));
typedef float f32x2 __attribute__((ext_vector_type(2)));
typedef unsigned u32x4 __attribute__((ext_vector_type(4)));
typedef unsigned u32x2 __attribute__((ext_vector_type(2)));

__device__ __forceinline__ unsigned cvt_pk_bf16(float lo, float hi) { unsigned r; asm volatile("v_cvt_pk_bf16_f32 %0, %1, %2" : "=v"(r) : "v"(lo), "v"(hi)); return r; }
__device__ __forceinline__ float bf2f(unsigned short b) { return __builtin_bit_cast(float, (unsigned)b << 16); }
__device__ __forceinline__ float gelu_tanh(float x) {
    const float y = x * (1.0f + 0.044715f * x * x);
    return x * __builtin_amdgcn_rcpf(1.0f + __builtin_amdgcn_exp2f(-2.3022082f * y));
}
__device__ __forceinline__ float silu_f(float x) { return x * __builtin_amdgcn_rcpf(1.0f + __builtin_amdgcn_exp2f(-LOG2E * x)); }
__device__ __forceinline__ float wave_sum(float v) {
#pragma unroll
    for (int o = 1; o < 64; o <<= 1) v += __shfl_xor(v, o);
    return v;
}

namespace pg8 {
constexpr int BM = 256, BK = 64, HALF = 128, HTB = HALF * BK * 2, STAGE_BYTES = 8 * HTB, NXCD = 8, WGM = 8;
__host__ __device__ __forceinline__ int lds_byte(int r, int c) { const int st = (r >> 4) * 2 + (c >> 5), rr = r & 15, cc = c & 31, ob = rr * 64 + cc * 2; return st * 1024 + (ob ^ (((ob >> 9) & 1) << 5)); }
__host__ __device__ __forceinline__ void stage_rc(int b, int& R, int& C) { const int st = b / 1024, sb = b % 1024, swz = sb ^ (((sb >> 9) & 1) << 5); R = (st >> 1) * 16 + swz / 64; C = (st & 1) * 32 + (swz % 64) / 2; }
__host__ __device__ __forceinline__ int perm32(int rho) { const int n = rho >> 4, i = rho & 15; return 8 * (i >> 2) + 4 * n + (i & 3); }

struct Unit { int pm, pn, e; };

__device__ __forceinline__ bool static_unit(int i, int G, int c, int nM, int nN, int& pm, int& pn) {
    const int nwg = nM * nN; const long L = (long)i * G + c; if (L >= nwg) return false;
    int wgid = (int)L; { const int q = nwg / NXCD, r = nwg % NXCD, xcd = wgid % NXCD, off = wgid / NXCD; wgid = (xcd < r ? xcd * (q + 1) : r * (q + 1) + (xcd - r) * q) + off; }
    const int nig = WGM * nN, gid = wgid / nig, fm = gid * WGM, gsz = (nM - fm) < WGM ? (nM - fm) : WGM;
    pm = fm + ((wgid % nig) % gsz); pn = (wgid % nig) / gsz; return true;
}

template <class Epi, class Sched, int BPERM, bool GATHER, int GSH>
__device__ __forceinline__ void gemm_phase(LAS unsigned char* lds, const LAS int* idxl, const int K, const Sched& S, const Epi& E) {
    int tid_ = threadIdx.x; asm volatile("" : "+v"(tid_));
    const int tid = tid_, wid = __builtin_amdgcn_readfirstlane(tid >> 6), lane = tid & 63, wr = wid >> 2, wc = wid & 3, fr = lane & 15, fq = lane >> 4;
    const int nt = K / BK;
    int R_[2], C_[2];
    unsigned voffA[2][2], voffB[2][2];
    const size_t hstep = (size_t)HALF * (size_t)K * 2u;
#pragma unroll
    for (int i = 0; i < 2; ++i) {
        stage_rc(tid * 16 + i * 8192, R_[i], C_[i]);
        const int R = R_[i], C = C_[i];
        voffA[0][i] = (unsigned)(R * K + C) * 2u; voffA[1][i] = 0u;
        if (BPERM == 2) {
#pragma unroll
            for (int bj = 0; bj < 2; ++bj) voffB[bj][i] = (unsigned)((64 * (R >> 5) + 32 * bj + perm32(R & 31)) * K + C) * 2u;
        } else {
            const int Rb = (BPERM == 1) ? ((R & ~31) + perm32(R & 31)) : R;
            voffB[0][i] = (unsigned)(Rb * K + C) * 2u; voffB[1][i] = 0u;
        }
    }
    const size_t kstep = (size_t)(BK * 2);
    const unsigned ldsw = (unsigned)wid * 1024u;
    const int aoff = lds_byte(wr * 64 + fr, fq * 8), boff = lds_byte(wc * 32 + fr, fq * 8);
#define PG8_SA(b, h) (((b) * 2 + (h)) * HTB)
#define PG8_SB(b, h) ((4 + (b) * 2 + (h)) * HTB)
#define PG8_STAGE(bufoff, gbase, voff) do { _Pragma("unroll") for (int _i = 0; _i < 2; ++_i) \
        __builtin_amdgcn_global_load_lds((const unsigned*)((const char*)(gbase) + (voff)[_i]), (LAS unsigned*)(lds + (bufoff) + ldsw + _i * 8192), 16, 0, 0); } while (0)
#define PG8_STA(bufoff, gbase, h) do { if (GATHER) PG8_STAGE(bufoff, gbase, voffA[h]); else PG8_STAGE(bufoff, (gbase) + (h) * hstep, voffA[0]); } while (0)
#define PG8_STB(bufoff, gbase, h) do { if (BPERM == 2) PG8_STAGE(bufoff, gbase, voffB[h]); else PG8_STAGE(bufoff, (gbase) + (h) * hstep, voffB[0]); } while (0)
#define PG8_GLOAD(u_) do { if (GATHER) { _Pragma("unroll") for (int _h = 0; _h < 2; ++_h) _Pragma("unroll") for (int _i = 0; _i < 2; ++_i) \
        voffA[_h][_i] = (unsigned)((((unsigned)idxl[(u_) * 256 + _h * 128 + R_[_i]] & 0x7fffffffu) >> GSH) * (unsigned)K + (unsigned)C_[_i]) * 2u; } } while (0)
#define PG8_LDA(dst, b, h) do { _Pragma("unroll") for (int m = 0; m < 4; ++m) _Pragma("unroll") for (int k = 0; k < 2; ++k) dst[m][k] = *(const LAS bf16x8*)(lds + PG8_SA(b, h) + aoff + m * 2048 + k * 1024); } while (0)
#define PG8_LDB(dst, b, h) do { _Pragma("unroll") for (int n = 0; n < 2; ++n) _Pragma("unroll") for (int k = 0; k < 2; ++k) dst[n][k] = *(const LAS bf16x8*)(lds + PG8_SB(b, h) + boff + n * 2048 + k * 1024); } while (0)
#define PG8_MMA(ai, bj, At, Bt) do { __builtin_amdgcn_s_setprio(1); _Pragma("unroll") for (int m = 0; m < 4; ++m) _Pragma("unroll") for (int n = 0; n < 2; ++n) _Pragma("unroll") for (int k = 0; k < 2; ++k) \
        acc[ai][bj][m][n] = __builtin_amdgcn_mfma_f32_16x16x32_bf16(Bt[n][k], At[m][k], acc[ai][bj][m][n], 0, 0, 0); __builtin_amdgcn_s_setprio(0); } while (0)
#define PG8_WAIT_V(n) asm volatile("s_waitcnt vmcnt(" #n ")" ::: "memory")
#define PG8_WAIT_L(n) asm volatile("s_waitcnt lgkmcnt(" #n ")" ::: "memory")
#define PG8_BAR __builtin_amdgcn_s_barrier()
#define PG8_SCHED __builtin_amdgcn_sched_barrier(0)
    Unit cur, nxt; int ui = 0;
    if (!S.next(0, cur)) return;
    f32x4 acc[2][2][4][2];
#pragma unroll
    for (int a = 0; a < 2; ++a)
#pragma unroll
        for (int b = 0; b < 2; ++b)
#pragma unroll
            for (int m = 0; m < 4; ++m)
#pragma unroll
                for (int n = 0; n < 2; ++n) acc[a][b][m][n] = (f32x4){0.f, 0.f, 0.f, 0.f};
    bf16x8 At[4][2], B0[2][2], B1[2][2];
    const char* cA = S.a_base(cur); const char* cB = S.b_base(cur);
    PG8_GLOAD(0);
    PG8_STB(PG8_SB(0, 0), cB, 0); PG8_STB(PG8_SB(0, 1), cB, 1); PG8_STA(PG8_SA(0, 0), cA, 0); PG8_STA(PG8_SA(0, 1), cA, 1);
    if (wr == 1) PG8_BAR;
    PG8_WAIT_V(2); PG8_BAR;
    PG8_STB(PG8_SB(1, 0), cB + kstep, 0); PG8_STA(PG8_SA(1, 0), cA + kstep, 0); PG8_STB(PG8_SB(1, 1), cB + kstep, 1);
    PG8_WAIT_V(6); PG8_BAR;
    for (;;) {
        const bool has_next = S.next(ui + 1, nxt);
        const char* nA = has_next ? S.a_base(nxt) : cA; const char* nB = has_next ? S.b_base(nxt) : cB;
        for (int t = 0; t < nt; t += 2) {
            const bool last = (t == nt - 2);
            const char* a1 = cA + (size_t)(t + 1) * kstep;
            const char* a2 = last ? nA : cA + (size_t)(t + 2) * kstep; const char* b2 = last ? nB : cB + (size_t)(t + 2) * kstep;
            const char* a3 = a2 + kstep; const char* b3 = b2 + kstep;
            PG8_LDB(B0, 0, 0); PG8_LDB(B1, 0, 1); PG8_SCHED; PG8_LDA(At, 0, 0); PG8_STA(PG8_SA(1, 1), a1, 1);
            if (GATHER) { if (last && has_next) PG8_GLOAD(ui + 1); }
            PG8_WAIT_V(8); PG8_WAIT_L(0); PG8_BAR; PG8_MMA(0, 0, At, B0); PG8_MMA(0, 1, At, B1); PG8_BAR; PG8_SCHED;
            PG8_LDA(At, 0, 1); PG8_STB(PG8_SB(0, 0), b2, 0); PG8_STB(PG8_SB(0, 1), b2, 1); PG8_STA(PG8_SA(0, 0), a2, 0);
            PG8_WAIT_V(8); PG8_WAIT_L(0); PG8_BAR; PG8_MMA(1, 0, At, B0); PG8_MMA(1, 1, At, B1); PG8_BAR; PG8_SCHED;
            PG8_LDB(B0, 1, 0); PG8_LDB(B1, 1, 1); PG8_SCHED; PG8_LDA(At, 1, 0); PG8_STA(PG8_SA(0, 1), a2, 1);
            PG8_WAIT_V(8); PG8_WAIT_L(0); PG8_BAR; PG8_MMA(0, 0, At, B0); PG8_MMA(0, 1, At, B1); PG8_BAR; PG8_SCHED;
            PG8_LDA(At, 1, 1); PG8_STB(PG8_SB(1, 0), b3, 0); PG8_STB(PG8_SB(1, 1), b3, 1); PG8_STA(PG8_SA(1, 0), a3, 0);
            PG8_WAIT_V(8); PG8_WAIT_L(0); PG8_BAR; PG8_MMA(1, 0, At, B0); PG8_MMA(1, 1, At, B1); PG8_BAR; PG8_SCHED;
        }
        if (wr == 0) PG8_BAR;
        E(acc, cur, ui, wr, wc, fr, fq);
        if (!has_next) break;
#pragma unroll
        for (int a = 0; a < 2; ++a)
#pragma unroll
            for (int b = 0; b < 2; ++b)
#pragma unroll
                for (int m = 0; m < 4; ++m)
#pragma unroll
                    for (int n = 0; n < 2; ++n) acc[a][b][m][n] = (f32x4){0.f, 0.f, 0.f, 0.f};
        cur = nxt; cA = nA; cB = nB; ++ui;
        if (wr == 1) PG8_BAR;
    }
    PG8_WAIT_V(0);
    PG8_BAR;
#undef PG8_SA
#undef PG8_SB
#undef PG8_STAGE
#undef PG8_GLOAD
#undef PG8_STA
#undef PG8_STB
#undef PG8_LDA
#undef PG8_LDB
#undef PG8_MMA
#undef PG8_WAIT_V
#undef PG8_WAIT_L
#undef PG8_BAR
#undef PG8_SCHED
}
}

constexpr size_t MiB = 1u << 20;
constexpr size_t WS_CTL = 0, CTL_ZERO_BYTES = 1 * MiB;
constexpr size_t WS_SMALL = 1 * MiB;
constexpr size_t WS_LIST = 4 * MiB;
constexpr size_t WS_GW = 7 * MiB;
constexpr size_t WS_HCTX = 8 * MiB;
constexpr size_t WS_WIN = 10 * MiB;
constexpr size_t WS_WOUT = 19 * MiB;
constexpr size_t WS_WGU = 24 * MiB;
constexpr size_t WS_WDN = 88 * MiB;
constexpr size_t WS_XN = 120 * MiB;
constexpr size_t WS_PU = 153 * MiB;
constexpr size_t WS_QF = 170 * MiB, WS_KF = 187 * MiB, WS_VF = 204 * MiB;
constexpr size_t WS_SGF = 221 * MiB;
constexpr size_t WS_Y = WS_PU;
constexpr size_t WS_MIX = 230 * MiB;
constexpr size_t WS_H = WS_MIX;
constexpr size_t WS_END = 263 * MiB;
static_assert(WS_PU + (size_t)MROWS * PU_LD * 2 <= WS_QF && WS_QF + (size_t)MROWS * 512 * 2 <= WS_KF && WS_KF + (size_t)MROWS * 512 * 2 <= WS_VF && WS_VF + (size_t)MROWS * 512 * 2 <= WS_SGF && WS_SGF + (size_t)MROWS * 256 * 2 <= WS_MIX, "ws map");
static_assert(WS_Y + (size_t)2 * MROWS * DM * 2 <= WS_MIX && WS_MIX + (size_t)MROWS * DM * 2 <= WS_END && WS_XN + (size_t)MROWS * DM * 2 <= WS_PU && WS_WDN + (size_t)2 * 16 * 1024 * 512 * 2 <= WS_XN && WS_WGU + (size_t)2 * 16 * 1024 * 1024 * 2 <= WS_WDN, "ws map 2");
constexpr int CW_BAR = 4096;
constexpr int CW_CNT = 8192;
constexpr int CW_MOD = 16384;
static_assert((CW_MOD + 4 * 6144) * 4 <= (int)CTL_ZERO_BYTES, "ctl");
constexpr size_t SM_SGW = 0;
constexpr size_t SM_POOLT = 256 * 1024;
constexpr size_t SM_B2 = 320 * 1024;
constexpr int LIST_CAP = 2 * MROWS;

constexpr int RING_BYTES = 131072;
constexpr int IDX_OFF = RING_BYTES;
constexpr int MISC_OFF = IDX_OFF + 8192;
constexpr int LDS_BYTES = 147456;
constexpr int NWAVES = 8;

#define XB_TMO      128
#define XB_XCNT(j)  (256  + 64 * (j))
#define XB_XSUB(j)  (1280 + 64 * (j))
#define XB_XGEN(j)  (2304 + 64 * (j))
#define XB_TOP      3328
#define XB_TOPGEN   3392
#define XCD_BAR_WORDS 3456
#define XB_SPIN_CAP (1u << 18)
__device__ __forceinline__ unsigned xb_ld(unsigned* p)              { return __hip_atomic_load(p, __ATOMIC_RELAXED, __HIP_MEMORY_SCOPE_AGENT); }
__device__ __forceinline__ unsigned xb_add(unsigned* p, unsigned v) { return __hip_atomic_fetch_add(p, v, __ATOMIC_RELAXED, __HIP_MEMORY_SCOPE_AGENT); }
__device__ __forceinline__ unsigned xb_xcc_id() { return (unsigned)__builtin_amdgcn_s_getreg((3 << 11) | 20) & 0xFu; }
#define XB_SPIN(cond, bar) do { unsigned _sp = 0; while (cond) { __builtin_amdgcn_s_sleep(1); \
    if ((++_sp & 255u) == 0u) { if (xb_ld(&(bar)[XB_TMO])) break; if (_sp > XB_SPIN_CAP) { atomicAdd(&(bar)[XB_TMO], 1u); break; } } } } while (0)
struct XcdBarrier { unsigned* bar; unsigned x; volatile LAS unsigned* st; };
__device__ __forceinline__ XcdBarrier xcd_barrier_post(unsigned* bar, volatile LAS unsigned* st) {
    XcdBarrier b; b.bar = bar; b.x = xb_xcc_id(); b.st = st;
    if (threadIdx.x == 0) (void)xb_add(&bar[XB_XCNT(b.x)], 1u);
    return b;
}
__device__ __forceinline__ void xcd_barrier_complete(unsigned* bar, unsigned x, unsigned& nloc, unsigned& nx) {
    const unsigned G = gridDim.x * gridDim.y * gridDim.z;
    unsigned sum, cnt, mine, sp = 0u;
    for (;;) {
        sum = 0u; cnt = 0u; mine = 0u;
#pragma unroll
        for (unsigned j = 0; j < 16; ++j) { const unsigned c = xb_ld(&bar[XB_XCNT(j)]); sum += c; cnt += (c > 0u) ? 1u : 0u; mine = (j == x) ? c : mine; }
        if (sum == G) break;
        __builtin_amdgcn_s_sleep(1);
        if ((++sp & 255u) == 0u) { if (xb_ld(&bar[XB_TMO])) break; if (sp > XB_SPIN_CAP) { atomicAdd(&bar[XB_TMO], 1u); break; } }
    }
    nloc = mine > 0u ? mine : 1u; nx = cnt > 0u ? cnt : 1u;
}
__device__ __forceinline__ void xcd_barrier(const XcdBarrier& b) {
    asm volatile("s_waitcnt vmcnt(0)" ::: "memory");
    __syncthreads();
    if (threadIdx.x == 0) {
        unsigned* bar = b.bar;
        __builtin_amdgcn_s_waitcnt(0);
        unsigned nloc = b.st[0], nx = b.st[1];
        if (nloc == 0u) { xcd_barrier_complete(bar, b.x, nloc, nx); b.st[0] = nloc; b.st[1] = nx; }
        const unsigned old = xb_add(&bar[XB_XSUB(b.x)], 1u);
        const unsigned gen = old / nloc;
        if (old + 1u == (gen + 1u) * nloc) {
            __builtin_amdgcn_fence(__ATOMIC_RELEASE, "agent");
            asm volatile("s_waitcnt vmcnt(0)" ::: "memory");
            const unsigned og = xb_add(&bar[XB_TOP], 1u);
            const unsigned tg = og / nx;
            if (og + 1u == (tg + 1u) * nx) xb_add(&bar[XB_TOPGEN], 1u);
            else XB_SPIN(xb_ld(&bar[XB_TOPGEN]) == tg, bar);
            __builtin_amdgcn_fence(__ATOMIC_ACQUIRE, "agent");
            xb_add(&bar[XB_XGEN(b.x)], 1u);
            asm volatile("s_waitcnt vmcnt(0)" ::: "memory");
        } else {
            XB_SPIN(xb_ld(&bar[XB_XGEN(b.x)]) == gen, bar);
            __builtin_amdgcn_fence(__ATOMIC_ACQUIRE, "agent");
            asm volatile("s_waitcnt vmcnt(0)" ::: "memory");
        }
    }
    __syncthreads();
}

struct Args {
    const float *x, *c, *ctx, *c_ctx, *w_ada, *b_ada, *norm1, *w_in, *pool_w, *pool_scale, *q_norm, *k_norm, *rpb, *sg_w, *sg_b, *sg_norm, *w_out, *norm2, *w_router, *b_router, *w_gate, *w_up, *w_down;
    float* out; unsigned char* ws;
};
struct Frame {
    LAS unsigned char* lds;
    int tid, lane, wave, vcu, G;
};
__device__ __forceinline__ Frame fresh(const Frame& F0) { Frame F = F0; asm volatile("" : "+v"(F.tid), "+v"(F.lane), "+s"(F.wave), "+s"(F.vcu), "+s"(F.G)); return F; }
typedef const __attribute__((address_space(4))) Args* KArgs;
__device__ __forceinline__ KArgs get_args() { KArgs p = (KArgs)__builtin_amdgcn_kernarg_segment_ptr(); asm volatile("" : "+s"(p)); return p; }

__device__ __forceinline__ unsigned f2bf(float f) { unsigned u = __builtin_bit_cast(unsigned, f); return (u + 0x7fffu + ((u >> 16) & 1u)) >> 16; }
__device__ __forceinline__ unsigned pk2(float lo, float hi) { return f2bf(lo) | (f2bf(hi) << 16); }
__device__ __forceinline__ void p0_transpose_item(const float* W, int K, int N, bf16_t* WT, int k0, int n0, int drow0, LAS float* scr, int lane) {
#pragma unroll 8
    for (int i = 0; i < 32; ++i) { const int kk = 2 * i + (lane >> 5); scr[kk * 33 + (lane & 31)] = W[(size_t)(k0 + kk) * N + n0 + (lane & 31)]; }
    asm volatile("s_waitcnt lgkmcnt(0)" ::: "memory");
    const int c = lane & 7;
#pragma unroll
    for (int j = 0; j < 4; ++j) { const int n = (lane >> 3) + 8 * j; const LAS float* s = scr + (8 * c) * 33 + n;
        u32x4 o; o.x = pk2(s[0 * 33], s[1 * 33]); o.y = pk2(s[2 * 33], s[3 * 33]); o.z = pk2(s[4 * 33], s[5 * 33]); o.w = pk2(s[6 * 33], s[7 * 33]);
        *(u32x4*)(WT + (size_t)(drow0 + n) * K + k0 + 8 * c) = o; }
    asm volatile("s_waitcnt lgkmcnt(0)" ::: "memory");
}
__device__ __forceinline__ int win_dst_row(int n) { return n < 1280 ? n : (n < 1792 ? 1536 + (n - 1280) : (n < 2048 ? 1280 + (n - 1792) : n)); }

__device__ __forceinline__ void p0_prologue(KArgs Ap, const Frame& F0) {
    const Frame F = fresh(F0);
    unsigned char* ws = Ap->ws;
    LAS float* scr = (LAS float*)(F.lds + F.wave * 16384);
    const int gw = F.vcu * NWAVES + F.wave, NGW = F.G * NWAVES;
    const int lane = F.lane;
    float* mod = (float*)(ws + WS_CTL) + CW_MOD;
    for (int it = gw; it < 2 * 24 * 8; it += NGW) {
        const int l = it / (24 * 8), r = it % (24 * 8), nb = r / 8, sb = r % 8;
        const int kq = lane >> 3, c4 = (lane & 7) * 4;
        const float* W = Ap->w_ada + (size_t)l * DM * 6144 + nb * 256 + sb * 32 + c4;
        f32x4 a0 = (f32x4){0.f, 0.f, 0.f, 0.f}, a1 = a0;
#pragma unroll 4
        for (int k = kq; k < DM; k += 8) {
            const float c0 = silu_f(Ap->c[k]), c1 = silu_f(Ap->c_ctx[k]);
            const f32x4 w = *(const f32x4*)(W + (size_t)k * 6144);
            a0 += w * c0; a1 += w * c1;
        }
#pragma unroll
        for (int j = 0; j < 4; ++j) { float x0 = a0[j], x1 = a1[j];
            x0 += __shfl_xor(x0, 8); x0 += __shfl_xor(x0, 16); x0 += __shfl_xor(x0, 32); x1 += __shfl_xor(x1, 8); x1 += __shfl_xor(x1, 16); x1 += __shfl_xor(x1, 32); a0[j] = x0; a1[j] = x1; }
        if (kq == 0) { const f32x4 b = *(const f32x4*)(Ap->b_ada + l * 6144 + nb * 256 + sb * 32 + c4);
            *(f32x4*)(mod + (l * 2 + 0) * 6144 + nb * 256 + sb * 32 + c4) = a0 + b; *(f32x4*)(mod + (l * 2 + 1) * 6144 + nb * 256 + sb * 32 + c4) = a1 + b; }
    }
    constexpr int I_IN = 16 * 72, I_OUT = 16 * 32, I_G = 16 * 16, I_D = 8 * 32;
    constexpr int PER_L = I_IN + I_OUT + 16 * (2 * I_G + I_D);
    for (int it = gw; it < 2 * PER_L; it += NGW) {
        const int l = it / PER_L; int r = it % PER_L;
        if (r < I_IN) { const int kb = r / 72, nb = r % 72;
            p0_transpose_item(Ap->w_in + (size_t)l * DM * IN_DIM, DM, IN_DIM, (bf16_t*)(ws + WS_WIN) + (size_t)l * IN_DIM * DM, kb * 64, nb * 32, win_dst_row(nb * 32), scr, lane); continue; }
        r -= I_IN;
        if (r < I_OUT) { const int kb = r / 32, nb = r % 32;
            p0_transpose_item(Ap->w_out + (size_t)l * DM * DM, DM, DM, (bf16_t*)(ws + WS_WOUT) + (size_t)l * DM * DM, kb * 64, nb * 32, nb * 32, scr, lane); continue; }
        r -= I_OUT;
        const int e = r / (2 * I_G + I_D); r = r % (2 * I_G + I_D);
        if (r < 2 * I_G) { const int up = r / I_G; r = r % I_G; const int kb = r / 16, nb = r % 16; const int j0 = nb * 32;
            const float* src = (up ? Ap->w_up : Ap->w_gate) + ((size_t)l * NEXP + e) * DM * DEXP;
            p0_transpose_item(src, DM, DEXP, (bf16_t*)(ws + WS_WGU) + ((size_t)l * NEXP + e) * 1024 * 1024, kb * 64, j0, (j0 >> 7) * 256 + (j0 & 127) + (up ? 128 : 0), scr, lane); continue; }
        r -= 2 * I_G;
        { const int kb = r / 32, nb = r % 32;
            p0_transpose_item(Ap->w_down + ((size_t)l * NEXP + e) * DEXP * DM, DEXP, DM, (bf16_t*)(ws + WS_WDN) + ((size_t)l * NEXP + e) * 1024 * 512, kb * 64, nb * 32, nb * 32, scr, lane); }
    }
    const int gt = F.vcu * NWAVES * 64 + F.tid, NGT = F.G * NWAVES * 64;
    bf16_t* sgw = (bf16_t*)(ws + WS_SMALL + SM_SGW);
    for (int i = gt; i < 2 * 4 * 128 * 128; i += NGT) { const int j8 = i & 7, ln = (i >> 3) & 63, ss = (i >> 9) & 3, pb = (i >> 11) & 7, lh = i >> 14;
        sgw[i] = (bf16_t)f2bf(Ap->sg_w[(size_t)lh * 16384 + (16 * pb + (ln & 15)) * 128 + 32 * ss + 8 * (ln >> 4) + j8]); }
    bf16_t* poolt = (bf16_t*)(ws + WS_SMALL + SM_POOLT);
    for (int i = gt; i < 2 * 4 * 64 * 64; i += NGT) { const int lg = i >> 12, d = (i >> 6) & 63, c = i & 63; poolt[i] = (bf16_t)f2bf(Ap->pool_w[(lg << 12) + c * 64 + d]); }
    if (gw < 16) {
        const int l = gw >> 3, h = gw & 7;
        float mq = fabsf(Ap->q_norm[(l * 8 + h) * 64 + lane]), mk = fabsf(Ap->k_norm[(l * 8 + h) * 64 + lane]), mb = 0.f;
        for (int i = lane; i < 15 * 31; i += 64) mb = fmaxf(mb, fabsf(Ap->rpb[(l * 8 + h) * 465 + i]));
#pragma unroll
        for (int o = 1; o < 64; o <<= 1) { mq = fmaxf(mq, __shfl_xor(mq, o)); mk = fmaxf(mk, __shfl_xor(mk, o)); mb = fmaxf(mb, __shfl_xor(mb, o)); }
        if (lane == 0) ((float*)(ws + WS_SMALL + SM_B2))[gw] = LOG2E * (8.0f * mq * mk + mb);
    }
}

__device__ __forceinline__ const float* modp(KArgs Ap, int l, int cls) { return (const float*)(Ap->ws + WS_CTL) + CW_MOD + (l * 2 + cls) * 6144; }

__device__ __forceinline__ void phase_n1(KArgs Ap, const Frame& F0, int l) {
    const Frame F = fresh(F0);
    const int gw = F.vcu * NWAVES + F.wave, NGW = F.G * NWAVES, lane = F.lane;
    bf16_t* XN = (bf16_t*)(Ap->ws + WS_XN); const bf16_t* Y = (const bf16_t*)(Ap->ws + WS_Y); float* hctx = (float*)(Ap->ws + WS_HCTX);
    for (int row = gw; row < MROWS; row += NGW) {
        const int cls = row >= NTOK;
        const float* src = (l == 0) ? (cls ? Ap->ctx + (size_t)(row - NTOK) * DM : Ap->x + (size_t)row * DM) : (cls ? hctx + (size_t)(row - NTOK) * DM : Ap->out + (size_t)row * DM);
        float* dst = cls ? hctx + (size_t)(row - NTOK) * DM : Ap->out + (size_t)row * DM;
        f32x4 v[4]; float ss = 0.f;
#pragma unroll
        for (int j = 0; j < 4; ++j) v[j] = *(const f32x4*)(src + lane * 4 + 256 * j);
        if (l > 0) {
#pragma unroll
            for (int j = 0; j < 4; ++j) {
                const bf16x4 y0 = *(const bf16x4*)(Y + (size_t)(2 * row) * DM + lane * 4 + 256 * j), y1 = *(const bf16x4*)(Y + (size_t)(2 * row + 1) * DM + lane * 4 + 256 * j);
#pragma unroll
                for (int q = 0; q < 4; ++q) v[j][q] += bf2f((unsigned short)y0[q]) + bf2f((unsigned short)y1[q]);
                *(f32x4*)(dst + lane * 4 + 256 * j) = v[j];
            }
        }
#pragma unroll
        for (int j = 0; j < 4; ++j) ss += (v[j].x * v[j].x + v[j].y * v[j].y) + (v[j].z * v[j].z + v[j].w * v[j].w);
        const float r = 1.0f / sqrtf(wave_sum(ss) * (1.0f / DM) + EPS);
        const float* md = modp(Ap, l, cls);
#pragma unroll
        for (int j = 0; j < 4; ++j) {
            const int k = lane * 4 + 256 * j;
            const f32x4 nw = *(const f32x4*)(Ap->norm1 + l * DM + k), sh = *(const f32x4*)(md + k), sc = *(const f32x4*)(md + 1024 + k);
            const f32x4 hn = v[j] * r * nw * (sc + 1.0f) + sh;
            u32x2 w; w.x = cvt_pk_bf16(hn.x, hn.y); w.y = cvt_pk_bf16(hn.z, hn.w);
            *(u32x2*)(XN + (size_t)row * DM + k) = w;
        }
    }
}
__device__ __forceinline__ void phase_final(KArgs Ap, const Frame& F0) {
    const Frame F = fresh(F0);
    const int gw = F.vcu * NWAVES + F.wave, NGW = F.G * NWAVES, lane = F.lane;
    const bf16_t* Y = (const bf16_t*)(Ap->ws + WS_Y);
    for (int row = gw; row < NTOK; row += NGW) {
        float* dst = Ap->out + (size_t)row * DM;
#pragma unroll
        for (int j = 0; j < 4; ++j) {
            f32x4 v = *(const f32x4*)(dst + lane * 4 + 256 * j);
            const bf16x4 y0 = *(const bf16x4*)(Y + (size_t)(2 * row) * DM + lane * 4 + 256 * j), y1 = *(const bf16x4*)(Y + (size_t)(2 * row + 1) * DM + lane * 4 + 256 * j);
#pragma unroll
            for (int q = 0; q < 4; ++q) v[q] += bf2f((unsigned short)y0[q]) + bf2f((unsigned short)y1[q]);
            *(f32x4*)(dst + lane * 4 + 256 * j) = v;
        }
    }
}

__device__ __forceinline__ void phase_n2(KArgs Ap, const Frame& F0, int l, bool dry = false) {
    const Frame F = fresh(F0);
    const int lane = F.lane;
    bf16_t* XN = (bf16_t*)(Ap->ws + WS_XN); float* hctx = (float*)(Ap->ws + WS_HCTX);
    LAS int* cntL = (LAS int*)(F.lds);
    LAS int* baseL = cntL + 16;
    LAS int* listL = cntL + 32;
    int* glist = (int*)(Ap->ws + WS_LIST); float* gwt = (float*)(Ap->ws + WS_GW);
    unsigned* gcnt = (unsigned*)(Ap->ws + WS_CTL) + CW_CNT + l * 16;
    if (F.tid < 16) cntL[F.tid] = 0;
    __syncthreads();
    const int nrows = (l == 0) ? MROWS : NTOK, rpb = nrows / F.G;
    const int r0 = F.vcu * rpb, r1 = (F.vcu == F.G - 1) ? nrows : r0 + rpb;
    for (int row = r0 + F.wave; row < r1; row += NWAVES) {
        const int cls = row >= NTOK;
        const float* src = cls ? hctx + (size_t)(row - NTOK) * DM : Ap->out + (size_t)row * DM;
        f32x4 v[4]; float ss = 0.f;
#pragma unroll
        for (int j = 0; j < 4; ++j) { v[j] = *(const f32x4*)(src + lane * 4 + 256 * j); ss += (v[j].x * v[j].x + v[j].y * v[j].y) + (v[j].z * v[j].z + v[j].w * v[j].w); }
        const float r = 1.0f / sqrtf(wave_sum(ss) * (1.0f / DM) + EPS);
        const float* md = modp(Ap, l, cls);
        float lg[16];
#pragma unroll
        for (int e = 0; e < 16; ++e) lg[e] = 0.f;
#pragma unroll
        for (int j = 0; j < 4; ++j) {
            const int k = lane * 4 + 256 * j;
            const f32x4 nw = *(const f32x4*)(Ap->norm2 + l * DM + k), sh = *(const f32x4*)(md + 3072 + k), sc = *(const f32x4*)(md + 4096 + k);
            const f32x4 hn = v[j] * r * nw * (sc + 1.0f) + sh;
            u32x2 w; w.x = cvt_pk_bf16(hn.x, hn.y); w.y = cvt_pk_bf16(hn.z, hn.w);
            *(u32x2*)(XN + (size_t)row * DM + k) = w;
#pragma unroll
            for (int q = 0; q < 4; ++q) {
                const float* wr_ = Ap->w_router + (size_t)(k + q) * 16;
#pragma unroll
                for (int e4 = 0; e4 < 4; ++e4) { const f32x4 ww = *(const f32x4*)(wr_ + e4 * 4);
                    lg[e4 * 4 + 0] += hn[q] * ww.x; lg[e4 * 4 + 1] += hn[q] * ww.y; lg[e4 * 4 + 2] += hn[q] * ww.z; lg[e4 * 4 + 3] += hn[q] * ww.w; }
            }
        }
        float mx = -3.0e38f;
#pragma unroll
        for (int e = 0; e < 16; ++e) { lg[e] = wave_sum(lg[e]) + Ap->b_router[e]; mx = fmaxf(mx, lg[e]); }
        float p[16];
#pragma unroll
        for (int e = 0; e < 16; ++e) p[e] = __expf(lg[e] - mx);
        float gs[4];
#pragma unroll
        for (int g = 0; g < 4; ++g) { const float a = p[4 * g], b = p[4 * g + 1], c = p[4 * g + 2], d = p[4 * g + 3];
            const float h1 = fmaxf(a, b), l1 = fminf(a, b), h2 = fmaxf(c, d), l2 = fminf(c, d);
            gs[g] = fmaxf(h1, h2) + fmaxf(fminf(h1, h2), fmaxf(l1, l2)); }
        int bg = 0; float bv = gs[0];
#pragma unroll
        for (int g = 1; g < 4; ++g) if (gs[g] > bv) { bv = gs[g]; bg = g; }
        float xg[4];
#pragma unroll
        for (int i = 0; i < 4; ++i) xg[i] = (bg == 0) ? p[i] : (bg == 1) ? p[4 + i] : (bg == 2) ? p[8 + i] : p[12 + i];
        int i1 = 0; float v1 = xg[0];
#pragma unroll
        for (int i = 1; i < 4; ++i) if (xg[i] > v1) { v1 = xg[i]; i1 = i; }
        int i2 = -1; float v2 = -1.f;
#pragma unroll
        for (int i = 0; i < 4; ++i) if (i != i1 && xg[i] > v2) { v2 = xg[i]; i2 = i; }
        const float inv = 1.0f / (v1 + v2);
        if (lane == 0 && !dry) {
            const int e1 = bg * 4 + i1, e2 = bg * 4 + i2;
            const int p1 = __hip_atomic_fetch_add(cntL + e1, 1, __ATOMIC_RELAXED, __HIP_MEMORY_SCOPE_WORKGROUP); listL[e1 * 136 + p1] = 2 * row;
            const int p2 = __hip_atomic_fetch_add(cntL + e2, 1, __ATOMIC_RELAXED, __HIP_MEMORY_SCOPE_WORKGROUP); listL[e2 * 136 + p2] = 2 * row + 1;
            gwt[2 * row] = v1 * inv; gwt[2 * row + 1] = v2 * inv;
        }
    }
    __syncthreads();
    if (dry) return;
    if (F.tid < 16) baseL[F.tid] = (int)__hip_atomic_fetch_add(gcnt + F.tid, (unsigned)cntL[F.tid], __ATOMIC_RELAXED, __HIP_MEMORY_SCOPE_AGENT);
    __syncthreads();
    for (int e = 0; e < 16; ++e) { const int n = cntL[e], b = baseL[e];
        for (int i = F.tid; i < n; i += NWAVES * 64) glist[(size_t)e * LIST_CAP + b + i] = listL[e * 136 + i]; }
    __syncthreads();
}

__device__ __forceinline__ bf16x8 ld8(const bf16_t* p) { return *(const bf16x8*)p; }
__device__ __forceinline__ bf16x8 ld4x2(const bf16_t* p0, const bf16_t* p1) { const bf16x4 a = *(const bf16x4*)p0, b = *(const bf16x4*)p1; return (bf16x8){a[0], a[1], a[2], a[3], b[0], b[1], b[2], b[3]}; }
#define MFMA16(a, b, c) __builtin_amdgcn_mfma_f32_16x16x32_bf16((a), (b), (c), 0, 0, 0)

template <int P, bool LOCAL>
__device__ __forceinline__ void attn_pair(const bf16x8 (&q)[4][2], f32x4 (&O)[4][4], float (&ls)[4], const bf16x8 (&k)[2][2], const bf16x8 (&v)[4],
                                          const LAS float* bl  , const int csg  , const int fr, const int g, const float B2) {
#pragma unroll
    for (int j = 0; j < 4; ++j) {
        if (LOCAL && ((P == 0 && j == 3) || (P == 1 && j == 0))) continue;
        float p[8];
#pragma unroll
        for (int s2 = 0; s2 < 2; ++s2) {
            const int kb = 2 * P + s2, dk = kb - j;
            if (LOCAL && (dk < -1 || dk > 1)) {
#pragma unroll
                for (int i = 0; i < 4; ++i) p[s2 * 4 + i] = 0.f;
                continue;
            }
            f32x4 S = MFMA16(k[s2][0], q[j][0], ((f32x4){0.f, 0.f, 0.f, 0.f}));
            S = MFMA16(k[s2][1], q[j][1], S);
#pragma unroll
            for (int i = 0; i < 4; ++i) {
                float pv;
                if (LOCAL) {
                    const int kc = 16 * kb + 4 * g + i;
                    const int cs = (j == 0) ? max(fr - 8, 0) : (j == 3) ? min(40 + fr, 48) : 16 * j + fr - 8;
                    const bool valid = (unsigned)(kc - cs) < 16u;
                    pv = __builtin_amdgcn_exp2f(S[i] + bl[16 * dk + i]); pv = valid ? pv : 0.f; }
                else pv = __builtin_amdgcn_exp2f(S[i] - B2);
                p[s2 * 4 + i] = pv; ls[j] += pv;
            }
        }
        u32x4 pw; pw.x = cvt_pk_bf16(p[0], p[1]); pw.y = cvt_pk_bf16(p[2], p[3]); pw.z = cvt_pk_bf16(p[4], p[5]); pw.w = cvt_pk_bf16(p[6], p[7]);
        const bf16x8 Pf = __builtin_bit_cast(bf16x8, pw);
#pragma unroll
        for (int d = 0; d < 4; ++d) O[j][d] = MFMA16(v[d], Pf, O[j][d]);
    }
}
template <bool LAT>
__device__ __forceinline__ void attn_row(KArgs Ap, const LAS float* biasL, const float B2, int r, int qt0, int h, int lane) {
    const char* QF = (const char*)(Ap->ws + WS_QF) + (size_t)h * NBLK16 * 2048; const char* KF = (const char*)(Ap->ws + WS_KF) + (size_t)h * NBLK16 * 2048;
    const char* VF = (const char*)(Ap->ws + WS_VF) + (size_t)h * NGRP32 * 4096; bf16_t* mix = (bf16_t*)(Ap->ws + WS_MIX);
    const int fr = lane & 15, g = lane >> 4;
    const unsigned loff = (unsigned)lane * 16u;
    bf16x8 q[4][2];
#pragma unroll
    for (int j = 0; j < 4; ++j) { const char* qp = QF + (size_t)((qt0 >> 4) + j) * 2048; q[j][0] = *(const bf16x8*)(qp + loff); q[j][1] = *(const bf16x8*)(qp + 1024 + loff); }
    f32x4 O[4][4]; float ls[4];
#pragma unroll
    for (int j = 0; j < 4; ++j) { ls[j] = 0.f;
#pragma unroll
        for (int d = 0; d < 4; ++d) O[j][d] = (f32x4){0.f, 0.f, 0.f, 0.f}; }
#define ATT_LDK(kk, tok) do { const char* kp_ = KF + (size_t)((tok) >> 4) * 2048; kk[0][0] = *(const bf16x8*)(kp_ + loff); kk[0][1] = *(const bf16x8*)(kp_ + 1024 + loff); \
        kk[1][0] = *(const bf16x8*)(kp_ + 2048 + loff); kk[1][1] = *(const bf16x8*)(kp_ + 3072 + loff); } while (0)
#define ATT_LDV(vv, tok) do { const char* vp_ = VF + (size_t)((tok) >> 5) * 4096; _Pragma("unroll") for (int d_ = 0; d_ < 4; ++d_) vv[d_] = *(const bf16x8*)(vp_ + d_ * 1024 + loff); } while (0)
    bf16x8 kA[2][2], kB[2][2], v[4];
    const LAS float* blane = biasL + 16 + 4 * g - fr + 15;
    if (LAT) {
        const int rs = min(max(r - 4, 0), 248);
        ATT_LDK(kA, rs * 64);
#pragma unroll 1
        for (int a = 0; a < 8; ++a) {
            const int tb = (rs + a) * 64;
            const LAS float* bl = blane + (rs + a - r + 7) * 64;
            ATT_LDV(v, tb); ATT_LDK(kB, tb + 32);
            attn_pair<0, true>(q, O, ls, kA, v, bl, 0, fr, g, B2);
            ATT_LDV(v, tb + 32); ATT_LDK(kA, (a < 7) ? tb + 64 : NTOK);
            attn_pair<1, true>(q, O, ls, kB, v, bl, 0, fr, g, B2);
        }
    } else {
        ATT_LDK(kA, NTOK);
    }
#pragma unroll 1
    for (int cp = 0; cp < 8; cp += 2) {
        ATT_LDV(v, NTOK + 32 * cp); ATT_LDK(kB, NTOK + 32 * (cp + 1));
        attn_pair<0, false>(q, O, ls, kA, v, blane, 0, fr, g, B2);
        ATT_LDV(v, NTOK + 32 * (cp + 1)); ATT_LDK(kA, NTOK + 32 * min(cp + 2, 7));
        attn_pair<0, false>(q, O, ls, kB, v, blane, 0, fr, g, B2);
    }
#undef ATT_LDK
#undef ATT_LDV
#pragma unroll
    for (int j = 0; j < 4; ++j) {
        float l_ = ls[j]; l_ += __shfl_xor(l_, 16); l_ += __shfl_xor(l_, 32);
        const float inv = 1.0f / l_;
        bf16_t* op = mix + (size_t)(qt0 + 16 * j + fr) * DM + 256 + h * 64 + 4 * g;
#pragma unroll
        for (int d = 0; d < 4; ++d) { u32x2 w; w.x = cvt_pk_bf16(O[j][d][0] * inv, O[j][d][1] * inv); w.y = cvt_pk_bf16(O[j][d][2] * inv, O[j][d][3] * inv); *(u32x2*)(op + 16 * d) = w; }
    }
}
__device__ __forceinline__ void pool_item(KArgs Ap, int l, int t0, int g4, int lane) {
    const bf16_t* PU = (const bf16_t*)(Ap->ws + WS_PU); bf16_t* mix = (bf16_t*)(Ap->ws + WS_MIX);
    const bf16_t* WT = (const bf16_t*)(Ap->ws + WS_SMALL + SM_POOLT) + (size_t)(l * 4 + g4) * 4096;
    const int fr = lane & 15, gq = lane >> 4;
    const int t = t0 + fr, base = (t >= NTOK) ? NTOK : 0, L = (t >= NTOK) ? NCTX : NTOK, tt = t - base;
    const int hw = 1 << g4;
    const int lo = max(tt - hw, 0), hi = min(tt + hw, L);
    const float invn = 1.0f / (float)(hi - lo);
    bf16x8 Bf[2];
#pragma unroll
    for (int s = 0; s < 2; ++s) {
        const int c0 = g4 * 64 + 32 * s + 8 * gq;
        float acc8[8];
#pragma unroll
        for (int q = 0; q < 8; ++q) acc8[q] = 0.f;
        for (int u = lo; u < hi; ++u) { const bf16x8 vv = ld8(PU + (size_t)(base + u) * PU_LD + c0);
#pragma unroll
            for (int q = 0; q < 8; ++q) acc8[q] += bf2f((unsigned short)vv[q]); }
        const bf16x8 self = ld8(PU + (size_t)t * PU_LD + c0);
        u32x4 w;
        float dq[8];
#pragma unroll
        for (int q = 0; q < 8; ++q) dq[q] = acc8[q] * invn - bf2f((unsigned short)self[q]);
        w.x = cvt_pk_bf16(dq[0], dq[1]); w.y = cvt_pk_bf16(dq[2], dq[3]); w.z = cvt_pk_bf16(dq[4], dq[5]); w.w = cvt_pk_bf16(dq[6], dq[7]);
        Bf[s] = __builtin_bit_cast(bf16x8, w);
    }
#pragma unroll
    for (int mb = 0; mb < 4; ++mb) {
        const bf16_t* wp = WT + (size_t)(16 * mb + fr) * 64 + 8 * gq;
        f32x4 o = MFMA16(ld8(wp), Bf[0], ((f32x4){0.f, 0.f, 0.f, 0.f}));
        o = MFMA16(ld8(wp + 32), Bf[1], o);
        const f32x4 ps = *(const f32x4*)(Ap->pool_scale + l * 256 + g4 * 64 + 16 * mb + 4 * gq);
        u32x2 w; w.x = cvt_pk_bf16(o[0] * ps[0], o[1] * ps[1]); w.y = cvt_pk_bf16(o[2] * ps[2], o[3] * ps[3]);
        *(u32x2*)(mix + (size_t)t * DM + g4 * 64 + 16 * mb + 4 * gq) = w;
    }
}
__device__ __forceinline__ void sg_item(KArgs Ap, int l, int ch, int h, int pb, int lane) {
    const bf16_t* PU = (const bf16_t*)(Ap->ws + WS_PU); bf16_t* mix = (bf16_t*)(Ap->ws + WS_MIX);
    const char* SGF = (const char*)(Ap->ws + WS_SGF) + (size_t)(h * NCHUNK + ch) * 16384;
    const char* W = (const char*)(Ap->ws + WS_SMALL + SM_SGW) + (size_t)((l * 4 + h) * 8 + pb) * 4096;
    const int fr = lane & 15, gq = lane >> 4;
    const unsigned loff = (unsigned)lane * 16u;
    const int p = 16 * pb + fr, tok = ch * 128 + p;
    f32x4 acc[4];
#pragma unroll
    for (int mb = 0; mb < 4; ++mb) acc[mb] = (f32x4){0.f, 0.f, 0.f, 0.f};
#pragma unroll
    for (int s = 0; s < 4; ++s) {
        const bf16x8 Bf = *(const bf16x8*)(W + s * 1024 + loff);
#pragma unroll
        for (int mb = 0; mb < 4; ++mb) acc[mb] = MFMA16(*(const bf16x8*)(SGF + (s * 4 + mb) * 1024 + loff), Bf, acc[mb]);
    }
    const float bias = Ap->sg_b[(l * 4 + h) * 128 + p];
#pragma unroll
    for (int mb = 0; mb < 4; ++mb) {
        const bf16x4 u4 = *(const bf16x4*)(PU + (size_t)tok * PU_LD + 256 + h * 64 + 16 * mb + 4 * gq);
        u32x2 w; w.x = cvt_pk_bf16(bf2f((unsigned short)u4[0]) * (acc[mb][0] + bias), bf2f((unsigned short)u4[1]) * (acc[mb][1] + bias));
        w.y = cvt_pk_bf16(bf2f((unsigned short)u4[2]) * (acc[mb][2] + bias), bf2f((unsigned short)u4[3]) * (acc[mb][3] + bias));
        *(u32x2*)(mix + (size_t)tok * DM + 768 + h * 64 + 16 * mb + 4 * gq) = w;
    }
}
__device__ __forceinline__ void phase_mix(KArgs Ap, const Frame& F0, int l) {
    const Frame F = fresh(F0);
    const int gw = F.vcu * NWAVES + F.wave, NGW = F.G * NWAVES, lane = F.lane;
    LAS float* biasL = (LAS float*)F.lds;
    const float* B2t = (const float*)(Ap->ws + WS_SMALL + SM_B2) + l * 8;
    for (int i = F.tid; i < 8 * 15 * 64; i += NWAVES * 64) { const int h = i / 960, rr = (i % 960) >> 6, cc = (i & 63) - 16;
        biasL[i] = (cc >= 0 && cc < 31) ? Ap->rpb[(size_t)(l * 8 + h) * 465 + rr * 31 + cc] * LOG2E - B2t[h] : 0.f; }
    __syncthreads();
    const int n_att = 256 * 8, n_actx = (l == 0) ? 4 * 8 : 0;
#pragma unroll 1
    for (int rep = 0; rep < ((DUP == 41) ? 2 : 1); ++rep)
    for (int it = gw; it < n_att + n_actx; it += NGW) {
        const int h = it & 7;
        if (it < n_att) attn_row<true>(Ap, biasL + h * 960, B2t[h], it >> 3, (it >> 3) * 64, h, lane);
        else attn_row<false>(Ap, biasL + h * 960, B2t[h], 0, NTOK + 64 * ((it - n_att) >> 3), h, lane);
    }
    const int nrow_t = (l == 0) ? MROWS : NTOK;
    const int n_pool = (nrow_t / 16) * 4, n_sg = (nrow_t / 128) * 4 * 8;
#pragma unroll 1
    for (int rep = 0; rep < ((DUP == 42) ? 2 : 1); ++rep)
    for (int it = gw; it < n_pool; it += NGW) pool_item(Ap, l, (it >> 2) * 16, it & 3, lane);
#pragma unroll 1
    for (int rep = 0; rep < ((DUP == 43) ? 2 : 1); ++rep)
    for (int it = gw; it < n_sg; it += NGW) sg_item(Ap, l, it >> 5, (it >> 3) & 3, it & 7, lane);
    __syncthreads();
}

using pg8::Unit;
struct SchedInN { const char* A; const char* B; int G, c;
    __device__ __forceinline__ bool next(int i, Unit& u) const { u.e = 0; return pg8::static_unit(i, G, c, 65, 6, u.pm, u.pn); }
    __device__ __forceinline__ const char* a_base(const Unit& u) const { return A + (size_t)u.pm * 256 * DM * 2; }
    __device__ __forceinline__ const char* b_base(const Unit& u) const { return B + (size_t)u.pn * 256 * DM * 2; } };
struct SchedInT { const char* A; const char* B; int G, c;
    __device__ __forceinline__ bool next(int i, Unit& u) const { u.e = 0; return pg8::static_unit(i, G, c, 3, 65, u.pm, u.pn); }
    __device__ __forceinline__ const char* a_base(const Unit& u) const { return A + (size_t)(1536 + u.pm * 256) * DM * 2; }
    __device__ __forceinline__ const char* b_base(const Unit& u) const { return B + (size_t)u.pn * 256 * DM * 2; } };
struct SchedOut { const char* A; const char* B; int G, c, nM;
    __device__ __forceinline__ bool next(int i, Unit& u) const { u.e = 0; return pg8::static_unit(i, G, c, nM, 4, u.pm, u.pn); }
    __device__ __forceinline__ const char* a_base(const Unit& u) const { return A + (size_t)u.pm * 256 * DM * 2; }
    __device__ __forceinline__ const char* b_base(const Unit& u) const { return B + (size_t)u.pn * 256 * DM * 2; } };
struct SchedMoe { const char* A; const char* B; const LAS int* cnt; int G, c; size_t bstride_e, bstride_pn;
    __device__ __forceinline__ bool next(int i, Unit& u) const {
        int L = i * G + c;
#pragma unroll 1
        for (int e = 0; e < NEXP; ++e) { const int nu = ((cnt[e] + 255) >> 8) * 4; if (L < nu) { u.e = e; u.pm = L >> 2; u.pn = L & 3; return true; } L -= nu; }
        return false; }
    __device__ __forceinline__ const char* a_base(const Unit&) const { return A; }
    __device__ __forceinline__ const char* b_base(const Unit& u) const { return B + (size_t)u.e * bstride_e + (size_t)u.pn * bstride_pn; } };

struct EpiInN {
    bf16_t* PU; bf16_t* QF; const float* qw; const float* kw;
    __device__ __forceinline__ void operator()(f32x4 (&acc)[2][2][4][2], const Unit& u, int, int wr, int wc, int fr, int fq) const {
        const int type = (u.pn == 0) ? 0 : (u.pn <= 2) ? 1 : (u.pn <= 4) ? 2 : 3;
        const int head = (type == 1) ? (u.pn - 1) * 4 + wc : (type == 2) ? (u.pn - 3) * 4 + wc : 0;
        f32x4 wv[2][2];
#pragma unroll
        for (int bj = 0; bj < 2; ++bj)
#pragma unroll
            for (int n = 0; n < 2; ++n) {
                const int d = 32 * bj + 8 * fq + 4 * n;
                wv[bj][n] = (type == 1) ? *(const f32x4*)(qw + head * 64 + d) * (0.125f * LOG2E) : (type == 2) ? *(const f32x4*)(kw + head * 64 + d) : (f32x4){1.f, 1.f, 1.f, 1.f};
            }
        const int row0 = u.pm * 256 + wr * 64 + fr;
#pragma unroll
        for (int ai = 0; ai < 2; ++ai)
#pragma unroll
            for (int m = 0; m < 4; ++m) {
                f32x4 v[2][2];
#pragma unroll
                for (int bj = 0; bj < 2; ++bj)
#pragma unroll
                    for (int n = 0; n < 2; ++n) v[bj][n] = acc[ai][bj][m][n];
                const int row = row0 + ai * 128 + m * 16;
                bf16_t* dst; int dstep;
                if (type == 1 || type == 2) {
                    float ss = 0.f;
#pragma unroll
                    for (int bj = 0; bj < 2; ++bj)
#pragma unroll
                        for (int n = 0; n < 2; ++n) ss += (v[bj][n][0] * v[bj][n][0] + v[bj][n][1] * v[bj][n][1]) + (v[bj][n][2] * v[bj][n][2] + v[bj][n][3] * v[bj][n][3]);
                    ss += __shfl_xor(ss, 16); ss += __shfl_xor(ss, 32);
                    const float r = 1.0f / sqrtf(ss * (1.0f / 64.0f) + EPS);
#pragma unroll
                    for (int bj = 0; bj < 2; ++bj)
#pragma unroll
                        for (int n = 0; n < 2; ++n) v[bj][n] = v[bj][n] * r * wv[bj][n];
                    dst = QF + (type == 2 ? (WS_KF - WS_QF) / 2 : (size_t)0) + ((size_t)(head * NBLK16 + (row >> 4)) * 2 * 64 + ((fq << 4) | fr)) * 8; dstep = 512;
                } else {
                    if (type == 3) {
#pragma unroll
                        for (int bj = 0; bj < 2; ++bj)
#pragma unroll
                            for (int n = 0; n < 2; ++n)
#pragma unroll
                                for (int q = 0; q < 4; ++q) v[bj][n][q] = gelu_tanh(v[bj][n][q]);
                    }
                    dst = PU + (size_t)row * PU_LD + (type == 3 ? 256 : 0) + wc * 64 + 8 * fq; dstep = 32;
                }
#pragma unroll
                for (int bj = 0; bj < 2; ++bj) { u32x4 w; w.x = cvt_pk_bf16(v[bj][0][0], v[bj][0][1]); w.y = cvt_pk_bf16(v[bj][0][2], v[bj][0][3]); w.z = cvt_pk_bf16(v[bj][1][0], v[bj][1][1]); w.w = cvt_pk_bf16(v[bj][1][2], v[bj][1][3]);
                    *(u32x4*)(dst + bj * dstep) = w; }
            }
    }
};
struct EpiInT {
    bf16_t* VF; bf16_t* SGF; const float* sgn;
    __device__ __forceinline__ void operator()(f32x4 (&acc)[2][2][4][2], const Unit& u, int, int wr, int wc, int fr, int fq) const {
#pragma unroll
        for (int ai = 0; ai < 2; ++ai) {
            const int head = 2 * ai + wr;
            if (u.pm == 2) {
                float sw[4];
#pragma unroll
                for (int m = 0; m < 4; ++m) sw[m] = sgn[head * 64 + 16 * m + fr];
#pragma unroll
                for (int bj = 0; bj < 2; ++bj)
#pragma unroll
                    for (int n = 0; n < 2; ++n) {
                        f32x4 ss = (f32x4){0.f, 0.f, 0.f, 0.f};
#pragma unroll
                        for (int m = 0; m < 4; ++m) {
#pragma unroll
                            for (int q = 0; q < 4; ++q) acc[ai][bj][m][n][q] = gelu_tanh(acc[ai][bj][m][n][q]);
                            ss += acc[ai][bj][m][n] * acc[ai][bj][m][n]; }
#pragma unroll
                        for (int q = 0; q < 4; ++q) { float t = ss[q]; t += __shfl_xor(t, 1); t += __shfl_xor(t, 2); t += __shfl_xor(t, 4); t += __shfl_xor(t, 8); ss[q] = 1.0f / sqrtf(t * (1.0f / 64.0f) + EPS); }
#pragma unroll
                        for (int m = 0; m < 4; ++m) acc[ai][bj][m][n] = acc[ai][bj][m][n] * ss * sw[m];
                    }
#pragma unroll
                for (int m = 0; m < 4; ++m)
#pragma unroll
                    for (int bj = 0; bj < 2; ++bj) { const f32x4 v0 = acc[ai][bj][m][0], v1 = acc[ai][bj][m][1];
                        u32x4 w; w.x = cvt_pk_bf16(v0[0], v0[1]); w.y = cvt_pk_bf16(v0[2], v0[3]); w.z = cvt_pk_bf16(v1[0], v1[1]); w.w = cvt_pk_bf16(v1[2], v1[3]);
                        *(u32x4*)(SGF + ((((size_t)(head * NCHUNK + 2 * u.pn + bj) * 4 + wc) * 4 + m) * 64 + ((fq << 4) | fr)) * 8) = w; }
            } else {
#pragma unroll
                for (int m = 0; m < 4; ++m)
#pragma unroll
                    for (int bj = 0; bj < 2; ++bj)
#pragma unroll
                        for (int n = 0; n < 2; ++n) { const f32x4 v0 = acc[ai][bj][m][n];
                            u32x2 w; w.x = cvt_pk_bf16(v0[0], v0[1]); w.y = cvt_pk_bf16(v0[2], v0[3]);
                            *(u32x2*)(VF + ((((size_t)((4 * u.pm + head) * NGRP32 + 8 * u.pn + 4 * bj + wc) * 4 + m) * 64 + (((2 * (fq & 1) + n) << 4) | fr)) * 8 + 4 * (fq >> 1))) = w; }
            }
        }
    }
};
struct EpiOut {
    const float* base_lat; const float* base_ctx; float* out_lat; float* out_ctx; const float* g_lat; const float* g_ctx;
    __device__ __forceinline__ void operator()(f32x4 (&acc)[2][2][4][2], const Unit& u, int, int wr, int wc, int fr, int fq) const {
        const bool cx = u.pm >= 64;
        const float* base = cx ? base_ctx : base_lat; float* out = cx ? out_ctx : out_lat; const float* gt = cx ? g_ctx : g_lat;
        const int row0 = (cx ? 0 : u.pm * 256) + wr * 64 + fr, col0 = u.pn * 256 + wc * 32 + 4 * fq;
        f32x4 gv[2][2];
#pragma unroll
        for (int bj = 0; bj < 2; ++bj)
#pragma unroll
            for (int n = 0; n < 2; ++n) gv[bj][n] = *(const f32x4*)(gt + col0 + bj * 128 + n * 16);
#pragma unroll
        for (int ai = 0; ai < 2; ++ai)
#pragma unroll
            for (int m = 0; m < 4; ++m) { const size_t off = (size_t)(row0 + ai * 128 + m * 16) * DM + col0;
#pragma unroll
                for (int bj = 0; bj < 2; ++bj)
#pragma unroll
                    for (int n = 0; n < 2; ++n) { const f32x4 b = *(const f32x4*)(base + off + bj * 128 + n * 16); *(f32x4*)(out + off + bj * 128 + n * 16) = b + gv[bj][n] * acc[ai][bj][m][n]; } }
    }
};
struct EpiG1 {
    bf16_t* H; const LAS int* idxl;
    __device__ __forceinline__ void operator()(f32x4 (&acc)[2][2][4][2], const Unit& u, int ui, int wr, int wc, int fr, int fq) const {
        const int col0 = u.pn * 128 + wc * 32 + 8 * fq;
#pragma unroll
        for (int ai = 0; ai < 2; ++ai)
#pragma unroll
            for (int m = 0; m < 4; ++m) {
                const int ent = idxl[ui * 256 + ai * 128 + wr * 64 + m * 16 + fr];
                float hv[8];
#pragma unroll
                for (int n = 0; n < 2; ++n)
#pragma unroll
                    for (int q = 0; q < 4; ++q) hv[n * 4 + q] = silu_f(acc[ai][0][m][n][q]) * acc[ai][1][m][n][q];
                if (ent >= 0) { u32x4 w; w.x = cvt_pk_bf16(hv[0], hv[1]); w.y = cvt_pk_bf16(hv[2], hv[3]); w.z = cvt_pk_bf16(hv[4], hv[5]); w.w = cvt_pk_bf16(hv[6], hv[7]);
                    *(u32x4*)(H + (size_t)ent * DEXP + col0) = w; }
            }
    }
};
struct EpiG2 {
    bf16_t* Y; const LAS int* idxl; const float* gwt; const float* g_lat; const float* g_ctx;
    __device__ __forceinline__ void operator()(f32x4 (&acc)[2][2][4][2], const Unit& u, int ui, int wr, int wc, int fr, int fq) const {
        const int col0 = u.pn * 256 + wc * 32 + 8 * fq;
#pragma unroll
        for (int ai = 0; ai < 2; ++ai)
#pragma unroll
            for (int m = 0; m < 4; ++m) {
                const int ent = idxl[ui * 256 + ai * 128 + wr * 64 + m * 16 + fr];
                if (ent >= 0) {
                    const float gwv = gwt[ent]; const float* gt = (ent >= 2 * NTOK) ? g_ctx : g_lat;
#pragma unroll
                    for (int bj = 0; bj < 2; ++bj) {
                        const f32x4 g0 = *(const f32x4*)(gt + col0 + bj * 128), g1 = *(const f32x4*)(gt + col0 + bj * 128 + 4);
                        const f32x4 v0 = acc[ai][bj][m][0] * g0 * gwv, v1 = acc[ai][bj][m][1] * g1 * gwv;
                        u32x4 w; w.x = cvt_pk_bf16(v0[0], v0[1]); w.y = cvt_pk_bf16(v0[2], v0[3]); w.z = cvt_pk_bf16(v1[0], v1[1]); w.w = cvt_pk_bf16(v1[2], v1[3]);
                        *(u32x4*)(Y + (size_t)ent * DM + col0 + bj * 128) = w; }
                }
            }
    }
};

__device__ __forceinline__ void moe_setup(KArgs Ap, const Frame& F0, int l, LAS int* cntL, LAS int* idxl) {
    const Frame F = fresh(F0);
    const unsigned* gcnt = (const unsigned*)(Ap->ws + WS_CTL) + CW_CNT + l * 16;
    const int* glist = (const int*)(Ap->ws + WS_LIST);
    if (F.tid < 16) cntL[F.tid] = (int)gcnt[F.tid];
    __syncthreads();
    SchedMoe S{nullptr, nullptr, cntL, F.G, (int)blockIdx.x, 0, 0};
    Unit u;
    for (int i = 0; i < 8 && S.next(i, u); ++i) {
        const int n = cntL[u.e];
        if (F.tid < 256) { const int pos = u.pm * 256 + F.tid; const int* le = glist + (size_t)u.e * LIST_CAP;
            idxl[i * 256 + F.tid] = (pos < n) ? le[pos] : (int)((unsigned)le[0] | 0x80000000u); }
    }
    __syncthreads();
}

__global__ void __launch_bounds__(NWAVES * 64, 2) fwd_megakernel(Args A_unused) {
    extern __shared__ __attribute__((aligned(16))) unsigned char lds_raw[];
    Frame F;
    F.lds = (LAS unsigned char*)lds_raw;
    F.tid = threadIdx.x; F.lane = F.tid & 63; F.wave = __builtin_amdgcn_readfirstlane(F.tid >> 6);
    F.G = gridDim.x; { const int bx = blockIdx.x; F.vcu = (F.G % 8 == 0) ? (bx % 8) * (F.G / 8) + bx / 8 : bx; }
    volatile LAS unsigned* MISC = (volatile LAS unsigned*)(F.lds + MISC_OFF);
    for (int u = F.tid; u < 64; u += NWAVES * 64) MISC[u] = 0u;
    __syncthreads();
    XcdBarrier bar;
    { KArgs Ap = get_args(); bar = xcd_barrier_post((unsigned*)(Ap->ws + WS_CTL) + CW_BAR, MISC + 16); }
    LAS int* cntL = (LAS int*)(F.lds + MISC_OFF);
    LAS int* idxl = (LAS int*)(F.lds + IDX_OFF);

#define REPS(k, cond) (((DUP == (k)) && (cond)) ? 2 : 1)
#pragma unroll 1
    for (int rep = 0; rep < REPS(1, true); ++rep) { { KArgs Ap = get_args(); p0_prologue(Ap, F); } xcd_barrier(bar); }
#pragma unroll 1
    for (int l = 0; l < 2; ++l) {
#pragma unroll 1
        for (int rep = 0; rep < REPS(2, l == 0); ++rep) { { KArgs Ap = get_args(); phase_n1(Ap, F, l); } xcd_barrier(bar); }
#pragma unroll 1
        for (int rep = 0; rep < REPS(3, true); ++rep) {
        {
            KArgs Ap = get_args(); unsigned char* ws = Ap->ws; const Frame Fp = fresh(F); int bx = (int)blockIdx.x; asm volatile("" : "+s"(bx));
            SchedInN S1{(const char*)(ws + WS_XN), (const char*)(ws + WS_WIN) + (size_t)l * IN_DIM * DM * 2, Fp.G, bx};
            EpiInN E1{(bf16_t*)(ws + WS_PU), (bf16_t*)(ws + WS_QF), Ap->q_norm + l * 512, Ap->k_norm + l * 512};
            pg8::gemm_phase<EpiInN, SchedInN, 2, false, 0>(Fp.lds, idxl, DM, S1, E1);
        }
        {
            KArgs Ap = get_args(); unsigned char* ws = Ap->ws; const Frame Fp = fresh(F); int bx = (int)blockIdx.x; asm volatile("" : "+s"(bx));
            SchedInT S2{(const char*)(ws + WS_WIN) + (size_t)l * IN_DIM * DM * 2, (const char*)(ws + WS_XN), Fp.G, Fp.G - 1 - bx};
            EpiInT E2{(bf16_t*)(ws + WS_VF), (bf16_t*)(ws + WS_SGF), Ap->sg_norm + l * 256};
            pg8::gemm_phase<EpiInT, SchedInT, 1, false, 0>(Fp.lds, idxl, DM, S2, E2);
        }
        xcd_barrier(bar);
        }
#pragma unroll 1
        for (int rep = 0; rep < REPS(4, true); ++rep) { { KArgs Ap = get_args(); phase_mix(Ap, F, l); } xcd_barrier(bar); }
#pragma unroll 1
        for (int rep = 0; rep < REPS(5, l == 0); ++rep) {
        {
            KArgs Ap = get_args(); unsigned char* ws = Ap->ws; const Frame Fp = fresh(F); int bx = (int)blockIdx.x; asm volatile("" : "+s"(bx));
            SchedOut S{(const char*)(ws + WS_MIX), (const char*)(ws + WS_WOUT) + (size_t)l * DM * DM * 2, Fp.G, bx, (l == 0) ? 65 : 64};
            EpiOut E{(l == 0) ? Ap->x : Ap->out, (l == 0) ? Ap->ctx : (const float*)(ws + WS_HCTX), Ap->out, (float*)(ws + WS_HCTX), modp(Ap, l, 0) + 2048, modp(Ap, l, 1) + 2048};
            pg8::gemm_phase<EpiOut, SchedOut, 0, false, 0>(Fp.lds, idxl, DM, S, E);
        }
        xcd_barrier(bar);
        }
        if (DUP == 8) { { KArgs Ap = get_args(); phase_n2(Ap, F, l, true); } xcd_barrier(bar); }
        { KArgs Ap = get_args(); phase_n2(Ap, F, l); }
        xcd_barrier(bar);
        { KArgs Ap = get_args(); moe_setup(Ap, F, l, cntL, idxl); }
#pragma unroll 1
        for (int rep = 0; rep < REPS(6, true); ++rep) {
        {
            KArgs Ap = get_args(); unsigned char* ws = Ap->ws; const Frame Fp = fresh(F); int bx = (int)blockIdx.x; asm volatile("" : "+s"(bx));
            SchedMoe S{(const char*)(ws + WS_XN), (const char*)(ws + WS_WGU) + (size_t)l * NEXP * 1024 * 1024 * 2, cntL, Fp.G, bx, (size_t)1024 * 1024 * 2, (size_t)256 * DM * 2};
            EpiG1 E{(bf16_t*)(ws + WS_H), idxl};
            pg8::gemm_phase<EpiG1, SchedMoe, 1, true, 1>(Fp.lds, idxl, DM, S, E);
        }
        xcd_barrier(bar);
        }
#pragma unroll 1
        for (int rep = 0; rep < REPS(7, true); ++rep) {
        {
            KArgs Ap = get_args(); unsigned char* ws = Ap->ws; const Frame Fp = fresh(F); int bx = (int)blockIdx.x; asm volatile("" : "+s"(bx));
            SchedMoe S{(const char*)(ws + WS_H), (const char*)(ws + WS_WDN) + (size_t)l * NEXP * 1024 * 512 * 2, cntL, Fp.G, bx, (size_t)1024 * 512 * 2, (size_t)256 * DEXP * 2};
            EpiG2 E{(bf16_t*)(ws + WS_Y), idxl, (const float*)(ws + WS_GW), modp(Ap, l, 0) + 5120, modp(Ap, l, 1) + 5120};
            pg8::gemm_phase<EpiG2, SchedMoe, 1, true, 0>(Fp.lds, idxl, DEXP, S, E);
        }
        xcd_barrier(bar);
        }
    }
    if (DUP == 9) { for (int rep = 0; rep < 16; ++rep) xcd_barrier(bar); }
    { KArgs Ap = get_args(); phase_final(Ap, F); }
    { KArgs Ap = get_args(); if (blockIdx.x == 0 && threadIdx.x == 0) { const unsigned t = xb_ld((unsigned*)(Ap->ws + WS_CTL) + CW_BAR + XB_TMO); if (t != 0u) { asm volatile("s_waitcnt vmcnt(0)" ::: "memory"); Ap->out[5] = __builtin_nanf(""); } } }
}

extern "C" void kernel_launch(void* const* d_in, const int* in_sizes, int n_in, void* d_out, int out_size, void* d_ws, size_t ws_size, hipStream_t stream) {
    static int grid = 0;
    if (grid == 0) {
        if (n_in != 23 || out_size != NTOK * DM || ws_size < WS_END) { fprintf(stderr, "kernel_launch: unexpected sizes (n_in %d out %d ws %zu)\n", n_in, out_size, ws_size); grid = -1; return; }
        int dev = 0, cus = 0, per_cu = 0;
        if (hipGetDevice(&dev) != hipSuccess || hipDeviceGetAttribute(&cus, hipDeviceAttributeMultiprocessorCount, dev) != hipSuccess) { grid = -1; return; }
        if (hipFuncSetAttribute((const void*)fwd_megakernel, hipFuncAttributeMaxDynamicSharedMemorySize, LDS_BYTES) != hipSuccess) { fprintf(stderr, "kernel_launch: hipFuncSetAttribute failed\n"); grid = -1; return; }
        if (hipOccupancyMaxActiveBlocksPerMultiprocessor(&per_cu, (const void*)fwd_megakernel, NWAVES * 64, LDS_BYTES) != hipSuccess || per_cu < 1) { fprintf(stderr, "kernel_launch: occupancy query says %d\n", per_cu); (void)hipGetLastError(); grid = -1; return; }
        grid = cus;
        if (grid != 256) fprintf(stderr, "kernel_launch: %d CUs (built for 256)\n", grid);
    }
    if (grid < 0) return;
    (void)hipMemsetAsync((char*)d_ws + WS_CTL, 0, CTL_ZERO_BYTES, stream);
    Args a{};
    const float** ap = (const float**)&a;
    for (int i = 0; i < 23; ++i) ap[i] = (const float*)d_in[i];
    a.out = (float*)d_out; a.ws = (unsigned char*)d_ws;
    void* args[] = {&a};
    hipError_t e = hipLaunchCooperativeKernel((const void*)fwd_megakernel, dim3(grid), dim3(NWAVES * 64), args, LDS_BYTES, stream);
    if (e != hipSuccess) fprintf(stderr, "kernel_launch: cooperative launch failed: %s\n", hipGetErrorString(e));
}
```

```cpp
#include <hip/hip_runtime.h>
#include <cstdio>
#include <cstdint>

#ifndef DUP
#define DUP 0
#endif
#define TS_A -1
#define TS_B -1
#define TS_SCALE 1.0f
constexpr int NTOK = 16384, NCTX = 256, MROWS = NTOK + NCTX, DM = 1024, IN_DIM = 2304;
constexpr int NEXP = 16, DEXP = 512;
constexpr int PU_LD = 512;
constexpr int NBLK16 = MROWS / 16, NGRP32 = MROWS / 32, NCHUNK = MROWS / 128;
constexpr float EPS = 1e-6f;
constexpr float LOG2E = 1.4426950408889634f;

#define LAS __attribute__((address_space(3)))
#define GAS __attribute__((address_space(1)))
typedef unsigned short bf16_t;
typedef short bf16x8 __attribute__((ext_vector_type(8)));
typedef short bf16x4 __attribute__((ext_vector_type(4)));
typedef float f32x4 __attribute__((ext_vector_type(4)));
typedef float f32x2 __attribute__((ext_vector_type(2)));
typedef unsigned u32x4 __attribute__((ext_vector_type(4)));
typedef unsigned u32x2 __attribute__((ext_vector_type(2)));

__device__ __forceinline__ unsigned cvt_pk_bf16_pin(float lo, float hi) { unsigned r; asm volatile("v_cvt_pk_bf16_f32 %0, %1, %2" : "=v"(r) : "v"(lo), "v"(hi)); return r; }
typedef __bf16 bf16x2_t __attribute__((ext_vector_type(2)));
__device__ __forceinline__ unsigned cvt_pk_bf16(float lo, float hi) { const f32x2 v = {lo, hi}; return __builtin_bit_cast(unsigned, __builtin_convertvector(v, bf16x2_t)); }
__device__ __forceinline__ float bf2f(unsigned short b) { return __builtin_bit_cast(float, (unsigned)b << 16); }
__device__ __forceinline__ f32x4 ld4bf(const bf16_t* p) { const bf16x4 a = *(const bf16x4*)p; return (f32x4){bf2f((unsigned short)a[0]), bf2f((unsigned short)a[1]), bf2f((unsigned short)a[2]), bf2f((unsigned short)a[3])}; }
#define BF2X4(w_) ((f32x4){__builtin_bit_cast(float, (w_).x << 16), __builtin_bit_cast(float, (w_).x & 0xffff0000u), __builtin_bit_cast(float, (w_).y << 16), __builtin_bit_cast(float, (w_).y & 0xffff0000u)})
__device__ __forceinline__ float gelu_tanh(float x) {
    const float y = x * (1.0f + 0.044715f * x * x);
    return x * __builtin_amdgcn_rcpf(1.0f + __builtin_amdgcn_exp2f(-2.3022082f * y));
}
__device__ __forceinline__ float silu_f(float x) { return x * __builtin_amdgcn_rcpf(1.0f + __builtin_amdgcn_exp2f(-LOG2E * x)); }
__device__ __forceinline__ float wave_sum(float v) {
#pragma unroll
    for (int o = 1; o < 64; o <<= 1) v += __shfl_xor(v, o);
    return v;
}

namespace pg8 {
constexpr int BM = 256, BK = 64, HALF = 128, HTB = HALF * BK * 2, STAGE_BYTES = 8 * HTB, NXCD = 8, WGM = 8;
__host__ __device__ __forceinline__ int lds_byte(int r, int c) { const int st = (r >> 4) * 2 + (c >> 5), rr = r & 15, cc = c & 31, ob = rr * 64 + cc * 2; return st * 1024 + (ob ^ (((ob >> 9) & 1) << 5)); }
__host__ __device__ __forceinline__ void stage_rc(int b, int& R, int& C) { const int st = b / 1024, sb = b % 1024, swz = sb ^ (((sb >> 9) & 1) << 5); R = (st >> 1) * 16 + swz / 64; C = (st & 1) * 32 + (swz % 64) / 2; }
__host__ __device__ __forceinline__ int perm32(int rho) { const int n = rho >> 4, i = rho & 15; return 8 * (i >> 2) + 4 * n + (i & 3); }

struct Unit { int pm, pn, e; };

__device__ __forceinline__ bool static_unit(int i, int G, int c, int nM, int nN, int& pm, int& pn) {
    const int nwg = nM * nN; const long L = (long)i * G + c; if (L >= nwg) return false;
    int wgid = (int)L; { const int q = nwg / NXCD, r = nwg % NXCD, xcd = wgid % NXCD, off = wgid / NXCD; wgid = (xcd < r ? xcd * (q + 1) : r * (q + 1) + (xcd - r) * q) + off; }
    const int nig = WGM * nN, gid = wgid / nig, fm = gid * WGM, gsz = (nM - fm) < WGM ? (nM - fm) : WGM;
    pm = fm + ((wgid % nig) % gsz); pn = (wgid % nig) / gsz; return true;
}

template <class Epi, class Sched, int BPERM, bool GATHER, int GSH>
__device__ __forceinline__ void gemm_phase(LAS unsigned char* lds, const LAS int* idxl, const int K, const Sched& S, const Epi& E) {
    int tid_ = threadIdx.x; asm volatile("" : "+v"(tid_));
    const int tid = tid_, wid = __builtin_amdgcn_readfirstlane(tid >> 6), lane = tid & 63, wr = wid >> 2, wc = wid & 3, fr = lane & 15, fq = lane >> 4;
    const int nt = K / BK;
    int R_[2], C_[2];
    unsigned voffA[2][2], voffB[2][2];
    const size_t hstep = (size_t)HALF * (size_t)K * 2u;
#pragma unroll
    for (int i = 0; i < 2; ++i) {
        stage_rc(tid * 16 + i * 8192, R_[i], C_[i]);
        const int R = R_[i], C = C_[i];
        voffA[0][i] = (unsigned)(R * K + C) * 2u; voffA[1][i] = 0u;
        if (BPERM == 2) {
#pragma unroll
            for (int bj = 0; bj < 2; ++bj) voffB[bj][i] = (unsigned)((64 * (R >> 5) + 32 * bj + perm32(R & 31)) * K + C) * 2u;
        } else {
            const int Rb = (BPERM == 1) ? ((R & ~31) + perm32(R & 31)) : R;
            voffB[0][i] = (unsigned)(Rb * K + C) * 2u; voffB[1][i] = 0u;
        }
    }
    const size_t kstep = (size_t)(BK * 2);
    const unsigned ldsw = (unsigned)wid * 1024u;
    const int aoff = lds_byte(wr * 64 + fr, fq * 8), boff = lds_byte(wc * 32 + fr, fq * 8);
#define PG8_SA(b, h) (((b) * 2 + (h)) * HTB)
#define PG8_SB(b, h) ((4 + (b) * 2 + (h)) * HTB)
#define PG8_STAGE(bufoff, gbase, voff) do { _Pragma("unroll") for (int _i = 0; _i < 2; ++_i) \
        __builtin_amdgcn_global_load_lds((const unsigned*)((const char*)(gbase) + (voff)[_i]), (LAS unsigned*)(lds + (bufoff) + ldsw + _i * 8192), 16, 0, 0); } while (0)
#define PG8_STA(bufoff, gbase, h) do { if (GATHER) PG8_STAGE(bufoff, gbase, voffA[h]); else PG8_STAGE(bufoff, (gbase) + (h) * hstep, voffA[0]); } while (0)
#define PG8_STB(bufoff, gbase, h) do { if (BPERM == 2) PG8_STAGE(bufoff, gbase, voffB[h]); else PG8_STAGE(bufoff, (gbase) + (h) * hstep, voffB[0]); } while (0)
#define PG8_GLOAD(u_) do { if (GATHER) { _Pragma("unroll") for (int _h = 0; _h < 2; ++_h) _Pragma("unroll") for (int _i = 0; _i < 2; ++_i) \
        voffA[_h][_i] = (unsigned)((((unsigned)idxl[(u_) * 256 + _h * 128 + R_[_i]] & 0x7fffffffu) >> GSH) * (unsigned)K + (unsigned)C_[_i]) * 2u; } } while (0)
#define PG8_LDA(dst, b, h) do { _Pragma("unroll") for (int m = 0; m < 4; ++m) _Pragma("unroll") for (int k = 0; k < 2; ++k) dst[m][k] = *(const LAS bf16x8*)(lds + PG8_SA(b, h) + aoff + m * 2048 + k * 1024); } while (0)
#define PG8_LDB(dst, b, h) do { _Pragma("unroll") for (int n = 0; n < 2; ++n) _Pragma("unroll") for (int k = 0; k < 2; ++k) dst[n][k] = *(const LAS bf16x8*)(lds + PG8_SB(b, h) + boff + n * 2048 + k * 1024); } while (0)
#define PG8_MMA(ai, bj, At, Bt) do { __builtin_amdgcn_s_setprio(1); _Pragma("unroll") for (int m = 0; m < 4; ++m) _Pragma("unroll") for (int n = 0; n < 2; ++n) _Pragma("unroll") for (int k = 0; k < 2; ++k) \
        acc[ai][bj][m][n] = __builtin_amdgcn_mfma_f32_16x16x32_bf16(Bt[n][k], At[m][k], acc[ai][bj][m][n], 0, 0, 0); __builtin_amdgcn_s_setprio(0); } while (0)
#define PG8_WAIT_V(n) asm volatile("s_waitcnt vmcnt(" #n ")" ::: "memory")
#define PG8_WAIT_L(n) asm volatile("s_waitcnt lgkmcnt(" #n ")" ::: "memory")
#define PG8_BAR __builtin_amdgcn_s_barrier()
#define PG8_SCHED __builtin_amdgcn_sched_barrier(0)
    Unit cur, nxt; int ui = 0;
    if (!S.next(0, cur)) return;
    f32x4 acc[2][2][4][2];
#pragma unroll
    for (int a = 0; a < 2; ++a)
#pragma unroll
        for (int b = 0; b < 2; ++b)
#pragma unroll
            for (int m = 0; m < 4; ++m)
#pragma unroll
                for (int n = 0; n < 2; ++n) acc[a][b][m][n] = (f32x4){0.f, 0.f, 0.f, 0.f};
    bf16x8 At[4][2], B0[2][2], B1[2][2];
    const char* cA = S.a_base(cur); const char* cB = S.b_base(cur);
    PG8_GLOAD(0);
    PG8_STB(PG8_SB(0, 0), cB, 0); PG8_STB(PG8_SB(0, 1), cB, 1); PG8_STA(PG8_SA(0, 0), cA, 0); PG8_STA(PG8_SA(0, 1), cA, 1);
    if (wr == 1) PG8_BAR;
    PG8_WAIT_V(2); PG8_BAR;
    PG8_STB(PG8_SB(1, 0), cB + kstep, 0); PG8_STA(PG8_SA(1, 0), cA + kstep, 0); PG8_STB(PG8_SB(1, 1), cB + kstep, 1);
    PG8_WAIT_V(6); PG8_BAR;
    for (;;) {
        const bool has_next = S.next(ui + 1, nxt);
        const char* nA = has_next ? S.a_base(nxt) : cA; const char* nB = has_next ? S.b_base(nxt) : cB;
        for (int t = 0; t < nt; t += 2) {
            const bool last = (t == nt - 2);
            const char* a1 = cA + (size_t)(t + 1) * kstep;
            const char* a2 = last ? nA : cA + (size_t)(t + 2) * kstep; const char* b2 = last ? nB : cB + (size_t)(t + 2) * kstep;
            const char* a3 = a2 + kstep; const char* b3 = b2 + kstep;
            PG8_LDB(B0, 0, 0); PG8_LDB(B1, 0, 1); PG8_SCHED; PG8_LDA(At, 0, 0); PG8_STA(PG8_SA(1, 1), a1, 1);
            if (GATHER) { if (last && has_next) PG8_GLOAD(ui + 1); }
            PG8_WAIT_V(8); PG8_WAIT_L(0); PG8_BAR; PG8_MMA(0, 0, At, B0); PG8_MMA(0, 1, At, B1); PG8_BAR; PG8_SCHED;
            PG8_LDA(At, 0, 1); PG8_STB(PG8_SB(0, 0), b2, 0); PG8_STB(PG8_SB(0, 1), b2, 1); PG8_STA(PG8_SA(0, 0), a2, 0);
            PG8_WAIT_V(8); PG8_WAIT_L(0); PG8_BAR; PG8_MMA(1, 0, At, B0); PG8_MMA(1, 1, At, B1); PG8_BAR; PG8_SCHED;
            PG8_LDB(B0, 1, 0); PG8_LDB(B1, 1, 1); PG8_SCHED; PG8_LDA(At, 1, 0); PG8_STA(PG8_SA(0, 1), a2, 1);
            PG8_WAIT_V(8); PG8_WAIT_L(0); PG8_BAR; PG8_MMA(0, 0, At, B0); PG8_MMA(0, 1, At, B1); PG8_BAR; PG8_SCHED;
            PG8_LDA(At, 1, 1); PG8_STB(PG8_SB(1, 0), b3, 0); PG8_STB(PG8_SB(1, 1), b3, 1); PG8_STA(PG8_SA(1, 0), a3, 0);
            PG8_WAIT_V(8); PG8_WAIT_L(0); PG8_BAR; PG8_MMA(1, 0, At, B0); PG8_MMA(1, 1, At, B1); PG8_BAR; PG8_SCHED;
        }
        if (wr == 0) PG8_BAR;
        E(acc, cur, ui, wr, wc, fr, fq);
        if (!has_next) break;
#pragma unroll
        for (int a = 0; a < 2; ++a)
#pragma unroll
            for (int b = 0; b < 2; ++b)
#pragma unroll
                for (int m = 0; m < 4; ++m)
#pragma unroll
                    for (int n = 0; n < 2; ++n) acc[a][b][m][n] = (f32x4){0.f, 0.f, 0.f, 0.f};
        cur = nxt; cA = nA; cB = nB; ++ui;
        if (wr == 1) PG8_BAR;
    }
    PG8_WAIT_V(0);
    PG8_BAR;
#undef PG8_SA
#undef PG8_SB
#undef PG8_STAGE
#undef PG8_GLOAD
#undef PG8_STA
#undef PG8_STB
#undef PG8_LDA
#undef PG8_LDB
#undef PG8_MMA
#undef PG8_WAIT_V
#undef PG8_WAIT_L
#undef PG8_BAR
#undef PG8_SCHED
}
}

constexpr size_t MiB = 1u << 20;
constexpr size_t WS_CTL = 0, CTL_ZERO_BYTES = 65536;
constexpr size_t WS_SMALL = 1 * MiB;
constexpr size_t WS_LIST = 4 * MiB;
constexpr size_t WS_GW = 7 * MiB;
constexpr size_t WS_HCTX = 8 * MiB;
constexpr size_t WS_WIN = 10 * MiB;
constexpr size_t WS_WOUT = 19 * MiB;
constexpr size_t WS_WGU = 24 * MiB;
constexpr size_t WS_WDN = 88 * MiB;
constexpr size_t WS_XN = 120 * MiB;
constexpr size_t WS_PU = 153 * MiB;
constexpr size_t WS_QF = 170 * MiB, WS_KF = 187 * MiB, WS_VF = 204 * MiB;
constexpr size_t WS_SGF = 221 * MiB;
constexpr size_t WS_Y = WS_PU;
constexpr size_t WS_MIX = 230 * MiB;
constexpr size_t WS_H = WS_MIX;
constexpr size_t WS_HRES = 263 * MiB;
constexpr size_t WS_END = 296 * MiB;
static_assert(WS_PU + (size_t)MROWS * PU_LD * 2 <= WS_QF && WS_QF + (size_t)MROWS * 512 * 2 <= WS_KF && WS_KF + (size_t)MROWS * 512 * 2 <= WS_VF && WS_VF + (size_t)MROWS * 512 * 2 <= WS_SGF && WS_SGF + (size_t)MROWS * 256 * 2 <= WS_MIX, "ws map");
static_assert(WS_Y + (size_t)2 * MROWS * DM * 2 <= WS_MIX && WS_MIX + (size_t)MROWS * DM * 2 <= WS_HRES && WS_HRES + (size_t)MROWS * DM * 2 <= WS_END && WS_XN + (size_t)MROWS * DM * 2 <= WS_PU && WS_WDN + (size_t)2 * 16 * 1024 * 512 * 2 <= WS_XN && WS_WGU + (size_t)2 * 16 * 1024 * 1024 * 2 <= WS_WDN, "ws map 2");
constexpr int CW_BAR = 4096;
constexpr int CW_CNT = 8192;
constexpr int CW_MOD = 16384;
static_assert(CW_MOD * 4 >= (int)CTL_ZERO_BYTES && (CW_CNT + 32) * 4 <= (int)CTL_ZERO_BYTES && (CW_MOD + 4 * 6144) * 4 <= (int)(1 * MiB), "ctl");
constexpr size_t SM_SGW = 0;
constexpr size_t SM_POOLT = 256 * 1024;
constexpr size_t SM_B2 = 320 * 1024;
constexpr size_t SM_TS = 324 * 1024;
constexpr size_t SM_C0 = 328 * 1024;
constexpr int LIST_CAP = 2 * MROWS;

constexpr int RING_BYTES = 131072;
constexpr int IDX_OFF = RING_BYTES;
constexpr int MISC_OFF = IDX_OFF + 8192;
constexpr int LDS_BYTES = 147456;
constexpr int NWAVES = 8;

#define XB_TMO      128
#define XB_XCNT(j)  (256  + 64 * (j))
#define XB_XSUB(j)  (1280 + 64 * (j))
#define XB_XGEN(j)  (2304 + 64 * (j))
#define XB_TOP      3328
#define XB_TOPGEN   3392
#define XCD_BAR_WORDS 3456
#define XB_SPIN_CAP (1u << 18)
__device__ __forceinline__ unsigned xb_ld(unsigned* p)              { return __hip_atomic_load(p, __ATOMIC_RELAXED, __HIP_MEMORY_SCOPE_AGENT); }
__device__ __forceinline__ unsigned xb_add(unsigned* p, unsigned v) { return __hip_atomic_fetch_add(p, v, __ATOMIC_RELAXED, __HIP_MEMORY_SCOPE_AGENT); }
__device__ __forceinline__ unsigned xb_xcc_id() { return (unsigned)__builtin_amdgcn_s_getreg((3 << 11) | 20) & 0xFu; }
#define XB_SPIN(cond, bar) do { unsigned _sp = 0; while (cond) { __builtin_amdgcn_s_sleep(1); \
    if ((++_sp & 255u) == 0u) { if (xb_ld(&(bar)[XB_TMO])) break; if (_sp > XB_SPIN_CAP) { atomicAdd(&(bar)[XB_TMO], 1u); break; } } } } while (0)
struct XcdBarrier { unsigned* bar; unsigned x; volatile LAS unsigned* st; };
__device__ __forceinline__ XcdBarrier xcd_barrier_post(unsigned* bar, volatile LAS unsigned* st) {
    XcdBarrier b; b.bar = bar; b.x = xb_xcc_id(); b.st = st;
    if (threadIdx.x == 0) (void)xb_add(&bar[XB_XCNT(b.x)], 1u);
    return b;
}
__device__ __forceinline__ void xcd_barrier_complete(unsigned* bar, unsigned x, unsigned& nloc, unsigned& nx) {
    const unsigned G = gridDim.x * gridDim.y * gridDim.z;
    unsigned sum, cnt, mine, sp = 0u;
    for (;;) {
        sum = 0u; cnt = 0u; mine = 0u;
#pragma unroll
        for (unsigned j = 0; j < 16; ++j) { const unsigned c = xb_ld(&bar[XB_XCNT(j)]); sum += c; cnt += (c > 0u) ? 1u : 0u; mine = (j == x) ? c : mine; }
        if (sum == G) break;
        __builtin_amdgcn_s_sleep(1);
        if ((++sp & 255u) == 0u) { if (xb_ld(&bar[XB_TMO])) break; if (sp > XB_SPIN_CAP) { atomicAdd(&bar[XB_TMO], 1u); break; } }
    }
    nloc = mine > 0u ? mine : 1u; nx = cnt > 0u ? cnt : 1u;
}
__device__ __forceinline__ void xcd_barrier(const XcdBarrier& b) {
    asm volatile("s_waitcnt vmcnt(0)" ::: "memory");
    __syncthreads();
    if (threadIdx.x == 0) {
        unsigned* bar = b.bar;
        __builtin_amdgcn_s_waitcnt(0);
        unsigned nloc = b.st[0], nx = b.st[1];
        if (nloc == 0u) { xcd_barrier_complete(bar, b.x, nloc, nx); b.st[0] = nloc; b.st[1] = nx; }
        const unsigned old = xb_add(&bar[XB_XSUB(b.x)], 1u);
        const unsigned gen = old / nloc;
        if (old + 1u == (gen + 1u) * nloc) {
            __builtin_amdgcn_fence(__ATOMIC_RELEASE, "agent");
            asm volatile("s_waitcnt vmcnt(0)" ::: "memory");
            const unsigned og = xb_add(&bar[XB_TOP], 1u);
            const unsigned tg = og / nx;
            if (og + 1u == (tg + 1u) * nx) xb_add(&bar[XB_TOPGEN], 1u);
            else XB_SPIN(xb_ld(&bar[XB_TOPGEN]) == tg, bar);
            __builtin_amdgcn_fence(__ATOMIC_ACQUIRE, "agent");
            xb_add(&bar[XB_XGEN(b.x)], 1u);
            asm volatile("s_waitcnt vmcnt(0)" ::: "memory");
        } else {
            XB_SPIN(xb_ld(&bar[XB_XGEN(b.x)]) == gen, bar);
            __builtin_amdgcn_fence(__ATOMIC_ACQUIRE, "agent");
            asm volatile("s_waitcnt vmcnt(0)" ::: "memory");
        }
    }
    __syncthreads();
}

struct Args {
    const float *x, *c, *ctx, *c_ctx, *w_ada, *b_ada, *norm1, *w_in, *pool_w, *pool_scale, *q_norm, *k_norm, *rpb, *sg_w, *sg_b, *sg_norm, *w_out, *norm2, *w_router, *b_router, *w_gate, *w_up, *w_down;
    float* out; unsigned char* ws;
};
struct Frame {
    LAS unsigned char* lds;
    int tid, lane, wave, vcu, G;
};
__device__ __forceinline__ Frame fresh(const Frame& F0) { Frame F = F0; asm volatile("" : "+v"(F.tid), "+v"(F.lane), "+s"(F.wave), "+s"(F.vcu), "+s"(F.G)); return F; }
typedef const __attribute__((address_space(4))) Args* KArgs;
__device__ __forceinline__ KArgs get_args() { KArgs p = (KArgs)__builtin_amdgcn_kernarg_segment_ptr(); asm volatile("" : "+s"(p)); return p; }

__device__ __forceinline__ unsigned f2bf(float f) { unsigned u = __builtin_bit_cast(unsigned, f); return (u + 0x7fffu + ((u >> 16) & 1u)) >> 16; }
__device__ __forceinline__ unsigned pk2(float lo, float hi) { return f2bf(lo) | (f2bf(hi) << 16); }
struct CvItem { const float* src; bf16_t* dst; int N, Kd; };
__device__ __forceinline__ void cv_load(const CvItem& c, float (&tv)[32], int lane) {
#pragma unroll
    for (int i = 0; i < 32; ++i) tv[i] = c.src[(size_t)(2 * i + (lane >> 5)) * c.N + (lane & 31)];
}
__device__ __forceinline__ void cv_finish(const CvItem& c, const float (&tv)[32], LAS float* scr, int lane) {
#pragma unroll
    for (int i = 0; i < 32; ++i) scr[(2 * i + (lane >> 5)) * 33 + (lane & 31)] = tv[i];
    asm volatile("s_waitcnt lgkmcnt(0)" ::: "memory");
    const int cc = lane & 7;
#pragma unroll
    for (int j = 0; j < 4; ++j) { const int n = (lane >> 3) + 8 * j; const LAS float* sp = scr + (8 * cc) * 33 + n;
        u32x4 o; o.x = pk2(sp[0 * 33], sp[1 * 33]); o.y = pk2(sp[2 * 33], sp[3 * 33]); o.z = pk2(sp[4 * 33], sp[5 * 33]); o.w = pk2(sp[6 * 33], sp[7 * 33]);
        *(u32x4*)(c.dst + (size_t)n * c.Kd + 8 * cc) = o; }
    asm volatile("s_waitcnt lgkmcnt(0)" ::: "memory");
}
__device__ __forceinline__ int win_dst_row(int n) { return n < 1280 ? n : (n < 1792 ? 1536 + (n - 1280) : (n < 2048 ? 1280 + (n - 1792) : n)); }

constexpr int CV_I_IN = 16 * 72, CV_I_OUT = 16 * 32, CV_I_G = 16 * 16, CV_I_D = 8 * 32;
constexpr int CV_IO = CV_I_IN + CV_I_OUT, CV_PER_L = CV_IO + 16 * (2 * CV_I_G + CV_I_D);
__device__ __forceinline__ CvItem cv_decode(KArgs Ap, int l, int r) {
    unsigned char* ws = Ap->ws; CvItem c;
    if (r < CV_I_IN) { const int kb = r / 72, nb = r % 72;
        c.src = Ap->w_in + (size_t)l * DM * IN_DIM + (size_t)(kb * 64) * IN_DIM + nb * 32; c.N = IN_DIM; c.Kd = DM;
        c.dst = (bf16_t*)(ws + WS_WIN) + (size_t)l * IN_DIM * DM + (size_t)win_dst_row(nb * 32) * DM + kb * 64; return c; }
    r -= CV_I_IN;
    if (r < CV_I_OUT) { const int kb = r / 32, nb = r % 32;
        c.src = Ap->w_out + (size_t)l * DM * DM + (size_t)(kb * 64) * DM + nb * 32; c.N = DM; c.Kd = DM;
        c.dst = (bf16_t*)(ws + WS_WOUT) + (size_t)l * DM * DM + (size_t)(nb * 32) * DM + kb * 64; return c; }
    r -= CV_I_OUT;
    const int e = r / (2 * CV_I_G + CV_I_D); r = r % (2 * CV_I_G + CV_I_D);
    if (r < 2 * CV_I_G) { const int up = r / CV_I_G; r = r % CV_I_G; const int kb = r / 16, nb = r % 16; const int j0 = nb * 32;
        c.src = (up ? Ap->w_up : Ap->w_gate) + ((size_t)l * NEXP + e) * DM * DEXP + (size_t)(kb * 64) * DEXP + j0; c.N = DEXP; c.Kd = DM;
        c.dst = (bf16_t*)(ws + WS_WGU) + ((size_t)l * NEXP + e) * 1024 * 1024 + (size_t)((j0 >> 7) * 256 + (j0 & 127) + (up ? 128 : 0)) * DM + kb * 64; return c; }
    r -= 2 * CV_I_G;
    { const int kb = r / 32, nb = r % 32;
        c.src = Ap->w_down + ((size_t)l * NEXP + e) * DEXP * DM + (size_t)(kb * 64) * DM + nb * 32; c.N = DM; c.Kd = DEXP;
        c.dst = (bf16_t*)(ws + WS_WDN) + ((size_t)l * NEXP + e) * 1024 * 512 + (size_t)(nb * 32) * DEXP + kb * 64; return c; }
}
__device__ __forceinline__ CvItem cv_decode_g(KArgs Ap, int g) { const int l = (g >= CV_PER_L) ? 1 : 0; return cv_decode(Ap, l, g - l * CV_PER_L); }
__device__ __forceinline__ void convert_stream(KArgs Ap, int first, int step, int end, LAS float* scr, int lane) {
    if (first >= end) return;
    float tvA[32], tvB[32];
    CvItem ca = cv_decode_g(Ap, first), cb = ca;
    cv_load(ca, tvA, lane);
    for (int it = first; it < end; it += 2 * step) {
        const bool hb = it + step < end;
        if (hb) { cb = cv_decode_g(Ap, it + step); cv_load(cb, tvB, lane); }
        cv_finish(ca, tvA, scr, lane);
        if (!hb) break;
        const bool ha = it + 2 * step < end;
        if (ha) { ca = cv_decode_g(Ap, it + 2 * step); cv_load(ca, tvA, lane); }
        cv_finish(cb, tvB, scr, lane);
    }
}
constexpr int CVG_P0 = CV_IO;
constexpr int CVG_IN0 = CVG_P0;
constexpr int CVG_OUT0 = 2 * CV_PER_L;
constexpr int CVG_G10 = 2 * CV_PER_L;
constexpr int CVG_END = 2 * CV_PER_L;
__device__ __forceinline__ void convert_fill_rank(KArgs Ap, const Frame& F0, int rank, int nfill, int lo, int hi) {
    const Frame F = fresh(F0);
    LAS float* scr = (LAS float*)(F.lds + F.wave * 16384);
    convert_stream(Ap, lo + rank * NWAVES + F.wave, nfill * NWAVES, hi, scr, F.lane);
}
__device__ __forceinline__ void convert_fill(KArgs Ap, const Frame& F0, int bx, int total_units, int lo, int hi) {
    const int G = F0.G, maxu = (total_units + G - 1) / G, nbig = total_units - (maxu - 1) * G;
    if (G - nbig >= G / 2) { if (bx >= nbig) convert_fill_rank(Ap, F0, bx - nbig, G - nbig, lo, hi); }
    else convert_fill_rank(Ap, F0, bx, G, lo, hi);
}
__device__ __forceinline__ void p0_prologue(KArgs Ap, const Frame& F0) {
    const Frame F = fresh(F0);
    unsigned char* ws = Ap->ws;
    LAS float* scr = (LAS float*)(F.lds + F.wave * 16384);
    const int gw = F.vcu * NWAVES + F.wave, NGW = F.G * NWAVES;
    const int lane = F.lane;
    float* mod = (float*)(ws + WS_CTL) + CW_MOD;
    for (int it = F.wave * F.G + F.vcu; it < 2 * 24 * 8; it += NGW) {
        const int l = it / (24 * 8), r = it % (24 * 8), nb = r / 8, sb = r % 8;
        const int kq = lane >> 3, c4 = (lane & 7) * 4;
        const float* W = Ap->w_ada + (size_t)l * DM * 6144 + nb * 256 + sb * 32 + c4;
        f32x4 a0 = (f32x4){0.f, 0.f, 0.f, 0.f}, a1 = a0;
#pragma unroll 1
        for (int k0 = kq; k0 < DM; k0 += 8 * 16) {
            f32x4 w[16];
#pragma unroll
            for (int u = 0; u < 16; ++u) w[u] = *(const f32x4*)(W + (size_t)(k0 + 8 * u) * 6144);
#pragma unroll
            for (int u = 0; u < 16; ++u) { const float c0 = silu_f(Ap->c[k0 + 8 * u]), c1 = silu_f(Ap->c_ctx[k0 + 8 * u]); a0 += w[u] * c0; a1 += w[u] * c1; }
        }
#pragma unroll
        for (int j = 0; j < 4; ++j) { float x0 = a0[j], x1 = a1[j];
            x0 += __shfl_xor(x0, 8); x0 += __shfl_xor(x0, 16); x0 += __shfl_xor(x0, 32); x1 += __shfl_xor(x1, 8); x1 += __shfl_xor(x1, 16); x1 += __shfl_xor(x1, 32); a0[j] = x0; a1[j] = x1; }
        if (kq == 0) { const f32x4 b = *(const f32x4*)(Ap->b_ada + l * 6144 + nb * 256 + sb * 32 + c4);
            *(f32x4*)(mod + (l * 2 + 0) * 6144 + nb * 256 + sb * 32 + c4) = a0 + b; *(f32x4*)(mod + (l * 2 + 1) * 6144 + nb * 256 + sb * 32 + c4) = a1 + b; }
    }
    convert_stream(Ap, gw, NGW, CVG_P0, scr, lane);
    const int gt = F.vcu * NWAVES * 64 + F.tid, NGT = F.G * NWAVES * 64;
    bf16_t* sgw = (bf16_t*)(ws + WS_SMALL + SM_SGW);
    for (int i = gt; i < 2 * 4 * 128 * 128; i += NGT) { const int j8 = i & 7, ln = (i >> 3) & 63, ss = (i >> 9) & 3, pb = (i >> 11) & 7, lh = i >> 14;
        sgw[i] = (bf16_t)f2bf(Ap->sg_w[(size_t)lh * 16384 + (16 * pb + (ln & 15)) * 128 + 32 * ss + 8 * (ln >> 4) + j8]); }
    bf16_t* poolt = (bf16_t*)(ws + WS_SMALL + SM_POOLT);
    for (int i = gt; i < 2 * 4 * 64 * 64; i += NGT) { const int lg = i >> 12, d = (i >> 6) & 63, c = i & 63; poolt[i] = (bf16_t)f2bf(Ap->pool_w[(lg << 12) + c * 64 + d]); }
    if (gw < 16) {
        const int l = gw >> 3, h = gw & 7;
        float mq = fabsf(Ap->q_norm[(l * 8 + h) * 64 + lane]), mk = fabsf(Ap->k_norm[(l * 8 + h) * 64 + lane]), mb = 0.f;
        for (int i = lane; i < 15 * 31; i += 64) mb = fmaxf(mb, fabsf(Ap->rpb[(l * 8 + h) * 465 + i]));
#pragma unroll
        for (int o = 1; o < 64; o <<= 1) { mq = fmaxf(mq, __shfl_xor(mq, o)); mk = fmaxf(mk, __shfl_xor(mk, o)); mb = fmaxf(mb, __shfl_xor(mb, o)); }
        if (lane == 0) ((float*)(ws + WS_SMALL + SM_B2))[gw] = LOG2E * (8.0f * mq * mk + mb);
    }
}

__device__ __forceinline__ const float* modp(KArgs Ap, int l, int cls) { return (const float*)(Ap->ws + WS_CTL) + CW_MOD + (l * 2 + cls) * 6144; }

__device__ __forceinline__ void phase_n1(KArgs Ap, const Frame& F0, int l) {
    const Frame F = fresh(F0);
    const int gw = F.vcu * NWAVES + F.wave, NGW = F.G * NWAVES, lane = F.lane;
    bf16_t* XN = (bf16_t*)(Ap->ws + WS_XN); const bf16_t* Y = (const bf16_t*)(Ap->ws + WS_Y);
    bf16_t* HR = (bf16_t*)(Ap->ws + WS_HRES);
    f32x4 xc[4], xn[4]; u32x2 hc[4], y0c[4], y1c[4], hn_[4], y0n[4], y1n[4];
#define N1_LOAD(row_, X, H, Y0, Y1) do { const int r_ = (row_); if (l == 0) { const float* src_ = (r_ >= NTOK) ? Ap->ctx + (size_t)(r_ - NTOK) * DM : Ap->x + (size_t)r_ * DM; \
        _Pragma("unroll") for (int j_ = 0; j_ < 4; ++j_) X[j_] = *(const f32x4*)(src_ + lane * 4 + 256 * j_); } else { \
        _Pragma("unroll") for (int j_ = 0; j_ < 4; ++j_) { H[j_] = *(const u32x2*)(HR + (size_t)r_ * DM + lane * 4 + 256 * j_); Y0[j_] = *(const u32x2*)(Y + (size_t)(2 * r_) * DM + lane * 4 + 256 * j_); Y1[j_] = *(const u32x2*)(Y + (size_t)(2 * r_ + 1) * DM + lane * 4 + 256 * j_); } } } while (0)
    if (gw < MROWS) N1_LOAD(gw, xc, hc, y0c, y1c);
#pragma unroll 1
    for (int row = gw; row < MROWS; row += NGW) {
        const int cls = row >= NTOK;
        const bool hnx = row + NGW < MROWS;
        if (hnx) N1_LOAD(row + NGW, xn, hn_, y0n, y1n);
        f32x4 v[4]; float ss = 0.f;
        if (l == 0) {
#pragma unroll
            for (int j = 0; j < 4; ++j) v[j] = xc[j];
        } else {
            bf16_t* hr = HR + (size_t)row * DM;
#pragma unroll
            for (int j = 0; j < 4; ++j) {
                v[j] = BF2X4(hc[j]) + BF2X4(y0c[j]) + BF2X4(y1c[j]);
                u32x2 w; w.x = cvt_pk_bf16(v[j].x, v[j].y); w.y = cvt_pk_bf16(v[j].z, v[j].w);
                *(u32x2*)(hr + lane * 4 + 256 * j) = w;
                v[j] = BF2X4(w);
            }
        }
#pragma unroll
        for (int j = 0; j < 4; ++j) ss += (v[j].x * v[j].x + v[j].y * v[j].y) + (v[j].z * v[j].z + v[j].w * v[j].w);
        const float r = 1.0f / sqrtf(wave_sum(ss) * (1.0f / DM) + EPS);
        const float* md = modp(Ap, l, cls);
#pragma unroll
        for (int j = 0; j < 4; ++j) {
            const int k = lane * 4 + 256 * j;
            const f32x4 nw = *(const f32x4*)(Ap->norm1 + l * DM + k), sh = *(const f32x4*)(md + k), sc = *(const f32x4*)(md + 1024 + k);
            const f32x4 hn = v[j] * r * nw * (sc + 1.0f) + sh;
            u32x2 w; w.x = cvt_pk_bf16(hn.x, hn.y); w.y = cvt_pk_bf16(hn.z, hn.w);
            *(u32x2*)(XN + (size_t)row * DM + k) = w;
        }
#pragma unroll
        for (int j = 0; j < 4; ++j) { xc[j] = xn[j]; hc[j] = hn_[j]; y0c[j] = y0n[j]; y1c[j] = y1n[j]; }
    }
#undef N1_LOAD
}
__device__ __forceinline__ void phase_final(KArgs Ap, const Frame& F0) {
    const Frame F = fresh(F0);
    const int gw = F.vcu * NWAVES + F.wave, NGW = F.G * NWAVES, lane = F.lane;
    const bf16_t* Y = (const bf16_t*)(Ap->ws + WS_Y);
    const bf16_t* HR = (const bf16_t*)(Ap->ws + WS_HRES);
    u32x2 hc[4], y0c[4], y1c[4], hn_[4], y0n[4], y1n[4];
#define FN_LOAD(row_, H, Y0, Y1) do { const int r_ = (row_); _Pragma("unroll") for (int j_ = 0; j_ < 4; ++j_) { H[j_] = *(const u32x2*)(HR + (size_t)r_ * DM + lane * 4 + 256 * j_); \
        Y0[j_] = *(const u32x2*)(Y + (size_t)(2 * r_) * DM + lane * 4 + 256 * j_); Y1[j_] = *(const u32x2*)(Y + (size_t)(2 * r_ + 1) * DM + lane * 4 + 256 * j_); } } while (0)
    if (gw < NTOK) FN_LOAD(gw, hc, y0c, y1c);
#pragma unroll 1
    for (int row = gw; row < NTOK; row += NGW) {
        if (row + NGW < NTOK) FN_LOAD(row + NGW, hn_, y0n, y1n);
        float* dst = Ap->out + (size_t)row * DM;
#pragma unroll
        for (int j = 0; j < 4; ++j) *(f32x4*)(dst + lane * 4 + 256 * j) = BF2X4(hc[j]) + BF2X4(y0c[j]) + BF2X4(y1c[j]);
#pragma unroll
        for (int j = 0; j < 4; ++j) { hc[j] = hn_[j]; y0c[j] = y0n[j]; y1c[j] = y1n[j]; }
    }
#undef FN_LOAD
}

__device__ __forceinline__ void route_row(float (&lg)[16], const int row, const int lane, const float* brt, LAS int* cntL, LAS int* listL, float* gwt) {
    const bool hi5 = lane & 32, hi4 = lane & 16, hi3 = lane & 8, hi2 = lane & 4;
    float w8[8], w4[4], w2[2], val;
#pragma unroll
    for (int i = 0; i < 8; ++i) { const float send = hi5 ? lg[i] : lg[i + 8], keep = hi5 ? lg[i + 8] : lg[i]; w8[i] = keep + __shfl_xor(send, 32); }
#pragma unroll
    for (int i = 0; i < 4; ++i) { const float send = hi4 ? w8[i] : w8[i + 4], keep = hi4 ? w8[i + 4] : w8[i]; w4[i] = keep + __shfl_xor(send, 16); }
#pragma unroll
    for (int i = 0; i < 2; ++i) { const float send = hi3 ? w4[i] : w4[i + 2], keep = hi3 ? w4[i + 2] : w4[i]; w2[i] = keep + __shfl_xor(send, 8); }
    { const float send = hi2 ? w2[0] : w2[1], keep = hi2 ? w2[1] : w2[0]; val = keep + __shfl_xor(send, 4); }
    val += __shfl_xor(val, 1); val += __shfl_xor(val, 2);
    const int e = (lane >> 2) & 15, grp = lane >> 4;
    val += brt[e];
    float mx = val; mx = fmaxf(mx, __shfl_xor(mx, 4)); mx = fmaxf(mx, __shfl_xor(mx, 8)); mx = fmaxf(mx, __shfl_xor(mx, 16)); mx = fmaxf(mx, __shfl_xor(mx, 32));
    const float p = __expf(val - mx);
    const float o1 = __shfl_xor(p, 4), o2 = __shfl_xor(p, 8), o3 = __shfl_xor(p, 12);
    const float h1 = fmaxf(p, o1), l1 = fminf(p, o1), h2 = fmaxf(o2, o3), l2 = fminf(o2, o3);
    const float gs = fmaxf(h1, h2) + fmaxf(fminf(h1, h2), fmaxf(l1, l2));
    float bv = gs; int bk = grp;
    { const float ov = __shfl_xor(bv, 16); const int ok = __shfl_xor(bk, 16); if (ov > bv || (ov == bv && ok < bk)) { bv = ov; bk = ok; } }
    { const float ov = __shfl_xor(bv, 32); const int ok = __shfl_xor(bk, 32); if (ov > bv || (ov == bv && ok < bk)) { bv = ov; bk = ok; } }
    const int rank = ((o1 > p || (o1 == p && (e ^ 1) < e)) ? 1 : 0) + ((o2 > p || (o2 == p && (e ^ 2) < e)) ? 1 : 0) + ((o3 > p || (o3 == p && (e ^ 3) < e)) ? 1 : 0);
    if (bk == grp && rank < 2 && (lane & 3) == 0) {
        const int ent = 2 * row + rank;
        const int pos = __hip_atomic_fetch_add(cntL + e, 1, __ATOMIC_RELAXED, __HIP_MEMORY_SCOPE_WORKGROUP);
        listL[e * 136 + pos] = ent; gwt[ent] = p / gs;
    }
}
__device__ __forceinline__ void phase_n2(KArgs Ap, const Frame& F0, int l, bool dry = false) {
    const Frame F = fresh(F0);
    const int lane = F.lane, gw = F.vcu * NWAVES + F.wave, NGW = F.G * NWAVES;
    bf16_t* XN = (bf16_t*)(Ap->ws + WS_XN); const bf16_t* HR = (const bf16_t*)(Ap->ws + WS_HRES);
    LAS float* Wl = (LAS float*)(F.lds);
    LAS int* cntL = (LAS int*)(F.lds + 81920);
    LAS int* baseL = cntL + 16;
    LAS int* listL = cntL + 32;
    int* glist = (int*)(Ap->ws + WS_LIST); float* gwt = (float*)(Ap->ws + WS_GW);
    unsigned* gcnt = (unsigned*)(Ap->ws + WS_CTL) + CW_CNT + l * 16;
    const int nrows = (l == 0) ? MROWS : NTOK;
    if (F.tid < 16) cntL[F.tid] = 0;
    {
        f32x4 wt[8];
#pragma unroll
        for (int i = 0; i < 8; ++i) wt[i] = *(const f32x4*)(Ap->w_router + 4 * (F.tid + NWAVES * 64 * i));
#pragma unroll
        for (int i = 0; i < 8; ++i) { const int idx4 = F.tid + NWAVES * 64 * i, k = idx4 >> 2, e0 = (idx4 & 3) * 4;
            *(LAS f32x4*)(Wl + (((k >> 8) * 4 + (k & 3)) * 64 + ((k & 255) >> 2)) * 20 + e0) = wt[i]; }
    }
    __syncthreads();
    u32x2 rawc[2][4], rawn[2][4];
#define N2_LOAD(R, r0_) do { const int a_ = (r0_), b_ = ((r0_) + NGW < nrows) ? (r0_) + NGW : (r0_); \
        _Pragma("unroll") for (int j_ = 0; j_ < 4; ++j_) { R[0][j_] = *(const u32x2*)(HR + (size_t)a_ * DM + lane * 4 + 256 * j_); R[1][j_] = *(const u32x2*)(HR + (size_t)b_ * DM + lane * 4 + 256 * j_); } } while (0)
    if (gw < nrows) N2_LOAD(rawc, gw);
#pragma unroll 1
    for (int row0 = gw; row0 < nrows; row0 += 2 * NGW) {
        const int row1 = row0 + NGW; const bool has1 = row1 < nrows;
        if (row0 + 2 * NGW < nrows) N2_LOAD(rawn, row0 + 2 * NGW);
        float hn[2][16];
#pragma unroll
        for (int t = 0; t < 2; ++t) {
            const int row = (t == 0 || has1) ? (t == 0 ? row0 : row1) : row0;
            const int rc = row >= NTOK;
            f32x4 v[4]; float ss = 0.f;
#pragma unroll
            for (int j = 0; j < 4; ++j) { v[j] = BF2X4(rawc[t][j]); ss += (v[j].x * v[j].x + v[j].y * v[j].y) + (v[j].z * v[j].z + v[j].w * v[j].w); }
            const float r = 1.0f / sqrtf(wave_sum(ss) * (1.0f / DM) + EPS);
            const GAS float* md = (const GAS float*)modp(Ap, l, rc); const GAS float* n2p = (const GAS float*)(Ap->norm2 + l * DM);
            asm volatile("" : "+s"(md), "+s"(n2p));
#pragma unroll
            for (int j = 0; j < 4; ++j) {
                const int k = lane * 4 + 256 * j;
                const f32x4 nw = *(const GAS f32x4*)(n2p + k), sh = *(const GAS f32x4*)(md + 3072 + k), sc = *(const GAS f32x4*)(md + 4096 + k);
                const f32x4 h4 = v[j] * r * nw * (sc + 1.0f) + sh;
                hn[t][4 * j] = h4.x; hn[t][4 * j + 1] = h4.y; hn[t][4 * j + 2] = h4.z; hn[t][4 * j + 3] = h4.w;
                if (t == 0 || has1) { u32x2 w; w.x = cvt_pk_bf16(h4.x, h4.y); w.y = cvt_pk_bf16(h4.z, h4.w); *(u32x2*)(XN + (size_t)row * DM + k) = w; }
            }
        }
#pragma unroll
        for (int t = 0; t < 2; ++t)
#pragma unroll
            for (int j = 0; j < 4; ++j) rawc[t][j] = rawn[t][j];
        if (dry) continue;
        float lg[2][16];
#pragma unroll
        for (int t = 0; t < 2; ++t)
#pragma unroll
            for (int e = 0; e < 16; ++e) lg[t][e] = 0.f;
        const LAS float* wlane = Wl + lane * 20; asm volatile("" : "+v"(wlane));
        f32x4 wa[4], wb[4];
#define N2_LDW(W_, jc_) do { _Pragma("unroll") for (int p_ = 0; p_ < 4; ++p_) W_[p_] = *(const LAS f32x4*)(wlane + (jc_) * 64 * 20 + 4 * p_); } while (0)
#define N2_FMA(W_, jc_) do { _Pragma("unroll") for (int p_ = 0; p_ < 4; ++p_) _Pragma("unroll") for (int t_ = 0; t_ < 2; ++t_) { const float hv_ = hn[t_][jc_]; \
        lg[t_][4 * p_] += hv_ * W_[p_].x; lg[t_][4 * p_ + 1] += hv_ * W_[p_].y; lg[t_][4 * p_ + 2] += hv_ * W_[p_].z; lg[t_][4 * p_ + 3] += hv_ * W_[p_].w; } \
        asm volatile("" : "+v"(lg[0][0]), "+v"(lg[0][1]), "+v"(lg[0][2]), "+v"(lg[0][3]), "+v"(lg[0][4]), "+v"(lg[0][5]), "+v"(lg[0][6]), "+v"(lg[0][7]), "+v"(lg[0][8]), "+v"(lg[0][9]), "+v"(lg[0][10]), "+v"(lg[0][11]), "+v"(lg[0][12]), "+v"(lg[0][13]), "+v"(lg[0][14]), "+v"(lg[0][15])); \
        asm volatile("" : "+v"(lg[1][0]), "+v"(lg[1][1]), "+v"(lg[1][2]), "+v"(lg[1][3]), "+v"(lg[1][4]), "+v"(lg[1][5]), "+v"(lg[1][6]), "+v"(lg[1][7]), "+v"(lg[1][8]), "+v"(lg[1][9]), "+v"(lg[1][10]), "+v"(lg[1][11]), "+v"(lg[1][12]), "+v"(lg[1][13]), "+v"(lg[1][14]), "+v"(lg[1][15])); } while (0)
        N2_LDW(wa, 0);
#pragma unroll
        for (int jc = 0; jc < 16; jc += 2) {
            N2_LDW(wb, jc + 1); N2_FMA(wa, jc);
            if (jc + 2 < 16) N2_LDW(wa, jc + 2);
            N2_FMA(wb, jc + 1);
        }
#undef N2_LDW
#undef N2_FMA
#pragma unroll 1
        for (int t = 0; t < 2; ++t) {
            if (t == 1) { if (!has1) break;
#pragma unroll
                for (int e = 0; e < 16; ++e) lg[0][e] = lg[1][e]; }
            route_row(lg[0], t == 0 ? row0 : row1, lane, Ap->b_router, cntL, listL, gwt);
        }
    }
    __syncthreads();
    if (dry) return;
    if (F.tid < 16) baseL[F.tid] = (int)__hip_atomic_fetch_add(gcnt + F.tid, (unsigned)cntL[F.tid], __ATOMIC_RELAXED, __HIP_MEMORY_SCOPE_AGENT);
    __syncthreads();
    for (int e = 0; e < 16; ++e) { const int n = cntL[e], b = baseL[e];
        for (int i = F.tid; i < n; i += NWAVES * 64) glist[(size_t)e * LIST_CAP + b + i] = listL[e * 136 + i]; }
    __syncthreads();
}

__device__ __forceinline__ bf16x8 ld8(const bf16_t* p) { return *(const bf16x8*)p; }
__device__ __forceinline__ bf16x8 ld4x2(const bf16_t* p0, const bf16_t* p1) { const bf16x4 a = *(const bf16x4*)p0, b = *(const bf16x4*)p1; return (bf16x8){a[0], a[1], a[2], a[3], b[0], b[1], b[2], b[3]}; }
#define MFMA16(a, b, c) __builtin_amdgcn_mfma_f32_16x16x32_bf16((a), (b), (c), 0, 0, 0)

template <int P, bool LOCAL>
__device__ __forceinline__ void attn_pair(const bf16x8 (&q)[4][2], f32x4 (&O)[4][4], float (&ls)[4], const bf16x8 (&k)[2][2], const bf16x8 (&v)[4],
                                          const LAS float* bl  , const int jsel  , const int fr, const int g, const float B2) {
#pragma unroll
    for (int j = 0; j < 4; ++j) {
        if (LOCAL && ((P == 0 && j == 3) || (P == 1 && j == 0))) continue;
        if (!LOCAL && jsel >= 0 && j != jsel) continue;
        float p[8];
#pragma unroll
        for (int s2 = 0; s2 < 2; ++s2) {
            const int kb = 2 * P + s2, dk = kb - j;
            if (LOCAL && (dk < -1 || dk > 1)) {
#pragma unroll
                for (int i = 0; i < 4; ++i) p[s2 * 4 + i] = 0.f;
                continue;
            }
            const f32x4 cinit = LOCAL ? (f32x4){bl[16 * dk], bl[16 * dk + 1], bl[16 * dk + 2], bl[16 * dk + 3]} : (f32x4){-B2, -B2, -B2, -B2};
            f32x4 S = MFMA16(k[s2][0], q[j][0], cinit);
            S = MFMA16(k[s2][1], q[j][1], S);
#pragma unroll
            for (int i = 0; i < 4; ++i) {
                float pv = __builtin_amdgcn_exp2f(S[i]);
                if (LOCAL) {
                    const int kc = 16 * kb + 4 * g + i;
                    const int cs = (j == 0) ? max(fr - 8, 0) : (j == 3) ? min(40 + fr, 48) : 16 * j + fr - 8;
                    const bool valid = (unsigned)(kc - cs) < 16u;
                    pv = valid ? pv : 0.f; }
                p[s2 * 4 + i] = pv; ls[j] += pv;
            }
        }
        u32x4 pw; pw.x = cvt_pk_bf16_pin(p[0], p[1]); pw.y = cvt_pk_bf16_pin(p[2], p[3]); pw.z = cvt_pk_bf16_pin(p[4], p[5]); pw.w = cvt_pk_bf16_pin(p[6], p[7]);
        const bf16x8 Pf = __builtin_bit_cast(bf16x8, pw);
#pragma unroll
        for (int d = 0; d < 4; ++d) O[j][d] = MFMA16(v[d], Pf, O[j][d]);
    }
}
template <bool LAT>
__device__ __forceinline__ void attn_row(KArgs Ap, const LAS float* biasL, const float B2, int r, int qt0, int h, int lane, int jsel = -1) {
    const char* QF = (const char*)(Ap->ws + WS_QF) + (size_t)h * NBLK16 * 2048; const char* KF = (const char*)(Ap->ws + WS_KF) + (size_t)h * NBLK16 * 2048;
    const char* VF = (const char*)(Ap->ws + WS_VF) + (size_t)h * NGRP32 * 4096; bf16_t* mix = (bf16_t*)(Ap->ws + WS_MIX);
    const int fr = lane & 15, g = lane >> 4;
    const unsigned loff = (unsigned)lane * 16u;
    bf16x8 q[4][2];
#pragma unroll
    for (int j = 0; j < 4; ++j) { const char* qp = QF + (size_t)((qt0 >> 4) + j) * 2048; q[j][0] = *(const bf16x8*)(qp + loff); q[j][1] = *(const bf16x8*)(qp + 1024 + loff); }
    f32x4 O[4][4]; float ls[4];
#pragma unroll
    for (int j = 0; j < 4; ++j) { ls[j] = 0.f;
#pragma unroll
        for (int d = 0; d < 4; ++d) O[j][d] = (f32x4){0.f, 0.f, 0.f, 0.f}; }
#define ATT_LDK(kk, tok) do { const char* kp_ = KF + (size_t)((tok) >> 4) * 2048; kk[0][0] = *(const bf16x8*)(kp_ + loff); kk[0][1] = *(const bf16x8*)(kp_ + 1024 + loff); \
        kk[1][0] = *(const bf16x8*)(kp_ + 2048 + loff); kk[1][1] = *(const bf16x8*)(kp_ + 3072 + loff); } while (0)
#define ATT_LDV(vv, tok) do { const char* vp_ = VF + (size_t)((tok) >> 5) * 4096; _Pragma("unroll") for (int d_ = 0; d_ < 4; ++d_) vv[d_] = *(const bf16x8*)(vp_ + d_ * 1024 + loff); } while (0)
    bf16x8 kA[2][2], kB[2][2], v[4];
    const LAS float* blane = biasL + 16 + 4 * g - fr + 15;
    if (LAT) {
        const int rs = min(max(r - 4, 0), 248);
        ATT_LDK(kA, rs * 64);
#pragma unroll 1
        for (int a = 0; a < 8; ++a) {
            const int tb = (rs + a) * 64;
            const LAS float* bl = blane + (rs + a - r + 7) * 64;
            ATT_LDV(v, tb); ATT_LDK(kB, tb + 32);
            attn_pair<0, true>(q, O, ls, kA, v, bl, 0, fr, g, B2);
            ATT_LDV(v, tb + 32); ATT_LDK(kA, (a < 7) ? tb + 64 : NTOK);
            attn_pair<1, true>(q, O, ls, kB, v, bl, 0, fr, g, B2);
        }
    } else {
        ATT_LDK(kA, NTOK);
    }
#pragma unroll 1
    for (int cp = 0; cp < 8; cp += 2) {
        ATT_LDV(v, NTOK + 32 * cp); ATT_LDK(kB, NTOK + 32 * (cp + 1));
        attn_pair<0, false>(q, O, ls, kA, v, blane, jsel, fr, g, B2);
        ATT_LDV(v, NTOK + 32 * (cp + 1)); ATT_LDK(kA, NTOK + 32 * min(cp + 2, 7));
        attn_pair<0, false>(q, O, ls, kB, v, blane, jsel, fr, g, B2);
    }
#undef ATT_LDK
#undef ATT_LDV
#pragma unroll
    for (int j = 0; j < 4; ++j) {
        if (jsel >= 0 && j != jsel) continue;
        float l_ = ls[j]; l_ += __shfl_xor(l_, 16); l_ += __shfl_xor(l_, 32);
        const float inv = 1.0f / l_;
        bf16_t* op = mix + (size_t)(qt0 + 16 * j + fr) * DM + 256 + h * 64 + 4 * g;
#pragma unroll
        for (int d = 0; d < 4; ++d) { u32x2 w; w.x = cvt_pk_bf16(O[j][d][0] * inv, O[j][d][1] * inv); w.y = cvt_pk_bf16(O[j][d][2] * inv, O[j][d][3] * inv); *(u32x2*)(op + 16 * d) = w; }
    }
}
template <int G4>
__device__ __forceinline__ void pool_item_t(KArgs Ap, int l, int t0, int lane) {
    constexpr int HW = 1 << G4;
    const bf16_t* PU = (const bf16_t*)(Ap->ws + WS_PU); bf16_t* mix = (bf16_t*)(Ap->ws + WS_MIX);
    const bf16_t* WT = (const bf16_t*)(Ap->ws + WS_SMALL + SM_POOLT) + (size_t)(l * 4 + G4) * 4096;
    const int fr = lane & 15, gq = lane >> 4;
    const int t = t0 + fr, base = (t0 >= NTOK) ? NTOK : 0, L = (t0 >= NTOK) ? NCTX : NTOK, tt = t - base;
    const int lo = max(tt - HW, 0), hi = min(tt + HW, L);
    const float invn = 1.0f / (float)(hi - lo);
    bf16x8 Bf[2];
#pragma unroll
    for (int s = 0; s < 2; ++s) {
        const int c0 = G4 * 64 + 32 * s + 8 * gq;
        bf16x8 wv[2 * HW];
#pragma unroll
        for (int d = 0; d < 2 * HW; ++d) { const int u = min(max(tt - HW + d, 0), L - 1); wv[d] = ld8(PU + (size_t)(base + u) * PU_LD + c0); }
        const bf16x8 self = ld8(PU + (size_t)t * PU_LD + c0);
        float acc8[8];
#pragma unroll
        for (int q = 0; q < 8; ++q) acc8[q] = 0.f;
#pragma unroll
        for (int d = 0; d < 2 * HW; ++d) { const int u = tt - HW + d; const float ok = (u >= 0 && u < L) ? 1.0f : 0.0f;
#pragma unroll
            for (int q = 0; q < 8; ++q) acc8[q] += ok * bf2f((unsigned short)wv[d][q]); }
        float dq[8];
#pragma unroll
        for (int q = 0; q < 8; ++q) dq[q] = acc8[q] * invn - bf2f((unsigned short)self[q]);
        u32x4 w; w.x = cvt_pk_bf16(dq[0], dq[1]); w.y = cvt_pk_bf16(dq[2], dq[3]); w.z = cvt_pk_bf16(dq[4], dq[5]); w.w = cvt_pk_bf16(dq[6], dq[7]);
        Bf[s] = __builtin_bit_cast(bf16x8, w);
    }
#pragma unroll
    for (int mb = 0; mb < 4; ++mb) {
        const bf16_t* wp = WT + (size_t)(16 * mb + fr) * 64 + 8 * gq;
        f32x4 o = MFMA16(ld8(wp), Bf[0], ((f32x4){0.f, 0.f, 0.f, 0.f}));
        o = MFMA16(ld8(wp + 32), Bf[1], o);
        const f32x4 ps = *(const f32x4*)(Ap->pool_scale + l * 256 + G4 * 64 + 16 * mb + 4 * gq);
        u32x2 w; w.x = cvt_pk_bf16(o[0] * ps[0], o[1] * ps[1]); w.y = cvt_pk_bf16(o[2] * ps[2], o[3] * ps[3]);
        *(u32x2*)(mix + (size_t)t * DM + G4 * 64 + 16 * mb + 4 * gq) = w;
    }
}
__device__ __forceinline__ void pool_item(KArgs Ap, int l, int t0, int g4, int lane) {
    if (g4 == 0) pool_item_t<0>(Ap, l, t0, lane); else if (g4 == 1) pool_item_t<1>(Ap, l, t0, lane); else if (g4 == 2) pool_item_t<2>(Ap, l, t0, lane); else pool_item_t<3>(Ap, l, t0, lane);
}
__device__ __forceinline__ void sg_item(KArgs Ap, int l, int ch, int h, int pb, int lane) {
    const bf16_t* PU = (const bf16_t*)(Ap->ws + WS_PU); bf16_t* mix = (bf16_t*)(Ap->ws + WS_MIX);
    const char* SGF = (const char*)(Ap->ws + WS_SGF) + (size_t)(h * NCHUNK + ch) * 16384;
    const char* W = (const char*)(Ap->ws + WS_SMALL + SM_SGW) + (size_t)((l * 4 + h) * 8 + pb) * 4096;
    const int fr = lane & 15, gq = lane >> 4;
    const unsigned loff = (unsigned)lane * 16u;
    const int p = 16 * pb + fr, tok = ch * 128 + p;
    f32x4 acc[4];
#pragma unroll
    for (int mb = 0; mb < 4; ++mb) acc[mb] = (f32x4){0.f, 0.f, 0.f, 0.f};
#pragma unroll
    for (int s = 0; s < 4; ++s) {
        const bf16x8 Bf = *(const bf16x8*)(W + s * 1024 + loff);
#pragma unroll
        for (int mb = 0; mb < 4; ++mb) acc[mb] = MFMA16(*(const bf16x8*)(SGF + (s * 4 + mb) * 1024 + loff), Bf, acc[mb]);
    }
    const float bias = Ap->sg_b[(l * 4 + h) * 128 + p];
#pragma unroll
    for (int mb = 0; mb < 4; ++mb) {
        const bf16x4 u4 = *(const bf16x4*)(PU + (size_t)tok * PU_LD + 256 + h * 64 + 16 * mb + 4 * gq);
        u32x2 w; w.x = cvt_pk_bf16(bf2f((unsigned short)u4[0]) * (acc[mb][0] + bias), bf2f((unsigned short)u4[1]) * (acc[mb][1] + bias));
        w.y = cvt_pk_bf16(bf2f((unsigned short)u4[2]) * (acc[mb][2] + bias), bf2f((unsigned short)u4[3]) * (acc[mb][3] + bias));
        *(u32x2*)(mix + (size_t)tok * DM + 768 + h * 64 + 16 * mb + 4 * gq) = w;
    }
}
__device__ __forceinline__ void phase_poolsg(KArgs Ap, const Frame& F0, int l, int rank, int nfill) {
    const Frame F = fresh(F0);
    const int lane = F.lane, w = rank * NWAVES + F.wave, stride = nfill * NWAVES;
    const int nrow_t = (l == 0) ? MROWS : NTOK;
    const int n_pool = (nrow_t / 16) * 4, n_sg = (nrow_t / 128) * 4 * 8;
    for (int it = w, k = 0; it < n_pool + n_sg; it += stride, ++k) {
        if (it < n_pool) pool_item(Ap, l, (it >> 2) * 16, ((it & 3) + k) & 3, lane);
        else { const int r = it - n_pool; sg_item(Ap, l, r >> 5, (r >> 3) & 3, r & 7, lane); }
    }
}
__device__ __forceinline__ void phase_mix(KArgs Ap, const Frame& F0, int l) {
    const Frame F = fresh(F0);
    const int gw = F.vcu * NWAVES + F.wave, NGW = F.G * NWAVES, lane = F.lane;
    LAS float* biasL = (LAS float*)F.lds;
    const float* B2t = (const float*)(Ap->ws + WS_SMALL + SM_B2) + l * 8;
    { const int h_ = F.wave; float bt_[15];
#pragma unroll
        for (int t_ = 0; t_ < 15; ++t_) { const int i_ = lane + 64 * t_, rr_ = i_ >> 6, cc_ = (i_ & 63) - 16;
            bt_[t_] = (cc_ >= 0 && cc_ < 31) ? Ap->rpb[(size_t)(l * 8 + h_) * 465 + rr_ * 31 + cc_] * LOG2E - B2t[h_] : 0.f; }
#pragma unroll
        for (int t_ = 0; t_ < 15; ++t_) biasL[h_ * 960 + lane + 64 * t_] = bt_[t_];
        asm volatile("s_waitcnt lgkmcnt(0)" ::: "memory"); }
    const int n_att = 256 * 8, n_actx = (l == 0) ? 4 * 8 * 4 : 0;
    for (int it = gw; it < n_att + n_actx; it += NGW) {
        const int h = it & 7;
        if (it < n_att) attn_row<true>(Ap, biasL + h * 960, B2t[h], it >> 3, (it >> 3) * 64, h, lane);
        else attn_row<false>(Ap, biasL + h * 960, B2t[h], 0, NTOK + 64 * (((it - n_att) >> 3) & 3), h, lane, (it - n_att) >> 5);
    }
    __syncthreads();
}

using pg8::Unit;
struct SchedInN { const char* A; const char* B; int G, c;
    __device__ __forceinline__ bool next(int i, Unit& u) const { u.e = 0; return pg8::static_unit(i, G, c, 65, 6, u.pm, u.pn); }
    __device__ __forceinline__ const char* a_base(const Unit& u) const { return A + (size_t)u.pm * 256 * DM * 2; }
    __device__ __forceinline__ const char* b_base(const Unit& u) const { return B + (size_t)u.pn * 256 * DM * 2; } };
struct SchedInT { const char* A; const char* B; int j0, stride, jend;
    __device__ __forceinline__ bool next(int i, Unit& u) const { const int j = j0 + i * stride; if (j >= jend) return false; u.e = 0;
        if (j < 65) { u.pm = 2; u.pn = j; } else { const int k = j - 65; u.pm = k / 65; u.pn = k % 65; } return true; }
    __device__ __forceinline__ const char* a_base(const Unit& u) const { return A + (size_t)(1536 + u.pm * 256) * DM * 2; }
    __device__ __forceinline__ const char* b_base(const Unit& u) const { return B + (size_t)u.pn * 256 * DM * 2; } };
struct SchedOut { const char* A; const char* B; int G, c, nM;
    __device__ __forceinline__ bool next(int i, Unit& u) const { u.e = 0; return pg8::static_unit(i, G, c, nM, 4, u.pm, u.pn); }
    __device__ __forceinline__ const char* a_base(const Unit& u) const { return A + (size_t)u.pm * 256 * DM * 2; }
    __device__ __forceinline__ const char* b_base(const Unit& u) const { return B + (size_t)u.pn * 256 * DM * 2; } };
struct SchedMoe { const char* A; const char* B; const LAS int* cnt; int G, c; size_t bstride_e, bstride_pn;
    __device__ __forceinline__ bool next(int i, Unit& u) const {
        int L = i * G + c;
#pragma unroll 1
        for (int e = 0; e < NEXP; ++e) { const int nu = ((cnt[e] + 255) >> 8) * 4; if (L < nu) { u.e = e; u.pm = L >> 2; u.pn = L & 3; return true; } L -= nu; }
        return false; }
    __device__ __forceinline__ const char* a_base(const Unit&) const { return A; }
    __device__ __forceinline__ const char* b_base(const Unit& u) const { return B + (size_t)u.e * bstride_e + (size_t)u.pn * bstride_pn; } };

struct EpiInN {
    bf16_t* PU; bf16_t* QF; const float* qw; const float* kw;
    __device__ __forceinline__ void operator()(f32x4 (&acc)[2][2][4][2], const Unit& u, int, int wr, int wc, int fr, int fq) const {
        const int type = (u.pn == 0) ? 0 : (u.pn <= 2) ? 1 : (u.pn <= 4) ? 2 : 3;
        const int head = (type == 1) ? (u.pn - 1) * 4 + wc : (type == 2) ? (u.pn - 3) * 4 + wc : 0;
        f32x4 wv[2][2];
#pragma unroll
        for (int bj = 0; bj < 2; ++bj)
#pragma unroll
            for (int n = 0; n < 2; ++n) {
                const int d = 32 * bj + 8 * fq + 4 * n;
                wv[bj][n] = (type == 1) ? *(const f32x4*)(qw + head * 64 + d) * (0.125f * LOG2E) : (type == 2) ? *(const f32x4*)(kw + head * 64 + d) : (f32x4){1.f, 1.f, 1.f, 1.f};
            }
        const int row0 = u.pm * 256 + wr * 64 + fr;
#pragma unroll
        for (int ai = 0; ai < 2; ++ai)
#pragma unroll
            for (int m = 0; m < 4; ++m) {
                f32x4 v[2][2];
#pragma unroll
                for (int bj = 0; bj < 2; ++bj)
#pragma unroll
                    for (int n = 0; n < 2; ++n) v[bj][n] = acc[ai][bj][m][n];
                const int row = row0 + ai * 128 + m * 16;
                bf16_t* dst; int dstep;
                if (type == 1 || type == 2) {
                    float ss = 0.f;
#pragma unroll
                    for (int bj = 0; bj < 2; ++bj)
#pragma unroll
                        for (int n = 0; n < 2; ++n) ss += (v[bj][n][0] * v[bj][n][0] + v[bj][n][1] * v[bj][n][1]) + (v[bj][n][2] * v[bj][n][2] + v[bj][n][3] * v[bj][n][3]);
                    ss += __shfl_xor(ss, 16); ss += __shfl_xor(ss, 32);
                    const float r = 1.0f / sqrtf(ss * (1.0f / 64.0f) + EPS);
#pragma unroll
                    for (int bj = 0; bj < 2; ++bj)
#pragma unroll
                        for (int n = 0; n < 2; ++n) v[bj][n] = v[bj][n] * r * wv[bj][n];
                    dst = QF + (type == 2 ? (WS_KF - WS_QF) / 2 : (size_t)0) + ((size_t)(head * NBLK16 + (row >> 4)) * 2 * 64 + ((fq << 4) | fr)) * 8; dstep = 512;
                } else {
                    if (type == 3) {
#pragma unroll
                        for (int bj = 0; bj < 2; ++bj)
#pragma unroll
                            for (int n = 0; n < 2; ++n)
#pragma unroll
                                for (int q = 0; q < 4; ++q) v[bj][n][q] = gelu_tanh(v[bj][n][q]);
                    }
                    dst = PU + (size_t)row * PU_LD + (type == 3 ? 256 : 0) + wc * 64 + 8 * fq; dstep = 32;
                }
#pragma unroll
                for (int bj = 0; bj < 2; ++bj) { u32x4 w; w.x = cvt_pk_bf16(v[bj][0][0], v[bj][0][1]); w.y = cvt_pk_bf16(v[bj][0][2], v[bj][0][3]); w.z = cvt_pk_bf16(v[bj][1][0], v[bj][1][1]); w.w = cvt_pk_bf16(v[bj][1][2], v[bj][1][3]);
                    *(u32x4*)(dst + bj * dstep) = w; }
            }
    }
};
struct EpiInT {
    bf16_t* VF; bf16_t* SGF; const float* sgn;
    __device__ __forceinline__ void operator()(f32x4 (&acc)[2][2][4][2], const Unit& u, int, int wr, int wc, int fr, int fq) const {
#pragma unroll
        for (int ai = 0; ai < 2; ++ai) {
            const int head = 2 * ai + wr;
            if (u.pm == 2) {
                float sw[4];
#pragma unroll
                for (int m = 0; m < 4; ++m) sw[m] = sgn[head * 64 + 16 * m + fr];
#pragma unroll
                for (int bj = 0; bj < 2; ++bj)
#pragma unroll
                    for (int n = 0; n < 2; ++n) {
                        f32x4 ss = (f32x4){0.f, 0.f, 0.f, 0.f};
#pragma unroll
                        for (int m = 0; m < 4; ++m) {
#pragma unroll
                            for (int q = 0; q < 4; ++q) acc[ai][bj][m][n][q] = gelu_tanh(acc[ai][bj][m][n][q]);
                            ss += acc[ai][bj][m][n] * acc[ai][bj][m][n]; }
#pragma unroll
                        for (int q = 0; q < 4; ++q) { float t = ss[q]; t += __shfl_xor(t, 1); t += __shfl_xor(t, 2); t += __shfl_xor(t, 4); t += __shfl_xor(t, 8); ss[q] = 1.0f / sqrtf(t * (1.0f / 64.0f) + EPS); }
#pragma unroll
                        for (int m = 0; m < 4; ++m) acc[ai][bj][m][n] = acc[ai][bj][m][n] * ss * sw[m];
                    }
#pragma unroll
                for (int m = 0; m < 4; ++m)
#pragma unroll
                    for (int bj = 0; bj < 2; ++bj) { const f32x4 v0 = acc[ai][bj][m][0], v1 = acc[ai][bj][m][1];
                        u32x4 w; w.x = cvt_pk_bf16(v0[0], v0[1]); w.y = cvt_pk_bf16(v0[2], v0[3]); w.z = cvt_pk_bf16(v1[0], v1[1]); w.w = cvt_pk_bf16(v1[2], v1[3]);
                        *(u32x4*)(SGF + ((((size_t)(head * NCHUNK + 2 * u.pn + bj) * 4 + wc) * 4 + m) * 64 + ((fq << 4) | fr)) * 8) = w; }
            } else {
#pragma unroll
                for (int m = 0; m < 4; ++m)
#pragma unroll
                    for (int bj = 0; bj < 2; ++bj)
#pragma unroll
                        for (int n = 0; n < 2; ++n) { const f32x4 v0 = acc[ai][bj][m][n];
                            u32x2 w; w.x = cvt_pk_bf16(v0[0], v0[1]); w.y = cvt_pk_bf16(v0[2], v0[3]);
                            *(u32x2*)(VF + ((((size_t)((4 * u.pm + head) * NGRP32 + 8 * u.pn + 4 * bj + wc) * 4 + m) * 64 + (((2 * (fq & 1) + n) << 4) | fr)) * 8 + 4 * (fq >> 1))) = w; }
            }
        }
    }
};
struct EpiOut {
    const float* base_lat; const float* base_ctx; bf16_t* HR; const float* g_lat; const float* g_ctx; int l;
    __device__ __forceinline__ void operator()(f32x4 (&acc)[2][2][4][2], const Unit& u, int, int wr, int wc, int fr, int fq) const {
        const bool cx = u.pm >= 64;
        const float* gt = cx ? g_ctx : g_lat;
        const int row0 = u.pm * 256 + wr * 64 + fr, col0 = u.pn * 256 + wc * 32 + 8 * fq;
        f32x4 gv[2][2];
#pragma unroll
        for (int bj = 0; bj < 2; ++bj)
#pragma unroll
            for (int n = 0; n < 2; ++n) gv[bj][n] = *(const f32x4*)(gt + col0 + bj * 128 + n * 4);
        const float* bp0 = (cx ? base_ctx + (size_t)(row0 - NTOK) * DM : base_lat + (size_t)row0 * DM) + col0;
        bf16_t* hp0 = HR + (size_t)row0 * DM + col0;
#pragma unroll
        for (int ai = 0; ai < 2; ++ai) {
            if (l == 0) {
                f32x4 b[4][2][2];
#pragma unroll
                for (int m = 0; m < 4; ++m)
#pragma unroll
                    for (int bj = 0; bj < 2; ++bj) { const float* bp = bp0 + (size_t)(ai * 128 + m * 16) * DM + bj * 128; b[m][bj][0] = *(const f32x4*)bp; b[m][bj][1] = *(const f32x4*)(bp + 4); }
#pragma unroll
                for (int m = 0; m < 4; ++m)
#pragma unroll
                    for (int bj = 0; bj < 2; ++bj) {
                        const f32x4 o0 = b[m][bj][0] + gv[bj][0] * acc[ai][bj][m][0], o1 = b[m][bj][1] + gv[bj][1] * acc[ai][bj][m][1];
                        u32x4 w; w.x = cvt_pk_bf16(o0[0], o0[1]); w.y = cvt_pk_bf16(o0[2], o0[3]); w.z = cvt_pk_bf16(o1[0], o1[1]); w.w = cvt_pk_bf16(o1[2], o1[3]);
                        *(u32x4*)(hp0 + (size_t)(ai * 128 + m * 16) * DM + bj * 128) = w; }
            } else {
                u32x4 b[4][2];
#pragma unroll
                for (int m = 0; m < 4; ++m)
#pragma unroll
                    for (int bj = 0; bj < 2; ++bj) b[m][bj] = *(const u32x4*)(hp0 + (size_t)(ai * 128 + m * 16) * DM + bj * 128);
                asm volatile("" ::: "memory");
#pragma unroll
                for (int m = 0; m < 4; ++m)
#pragma unroll
                    for (int bj = 0; bj < 2; ++bj) {
                        const u32x2 lo = {b[m][bj].x, b[m][bj].y}, hi = {b[m][bj].z, b[m][bj].w};
                        const f32x4 o0 = BF2X4(lo) + gv[bj][0] * acc[ai][bj][m][0], o1 = BF2X4(hi) + gv[bj][1] * acc[ai][bj][m][1];
                        u32x4 w; w.x = cvt_pk_bf16(o0[0], o0[1]); w.y = cvt_pk_bf16(o0[2], o0[3]); w.z = cvt_pk_bf16(o1[0], o1[1]); w.w = cvt_pk_bf16(o1[2], o1[3]);
                        *(u32x4*)(hp0 + (size_t)(ai * 128 + m * 16) * DM + bj * 128) = w; }
            }
            asm volatile("" ::: "memory");
        }
    }
};
struct EpiG1 {
    bf16_t* H; const LAS int* idxl;
    __device__ __forceinline__ void operator()(f32x4 (&acc)[2][2][4][2], const Unit& u, int ui, int wr, int wc, int fr, int fq) const {
        const int col0 = u.pn * 128 + wc * 32 + 8 * fq;
#pragma unroll
        for (int ai = 0; ai < 2; ++ai)
#pragma unroll
            for (int m = 0; m < 4; ++m) {
                const int ent = idxl[ui * 256 + ai * 128 + wr * 64 + m * 16 + fr];
                float hv[8];
#pragma unroll
                for (int n = 0; n < 2; ++n)
#pragma unroll
                    for (int q = 0; q < 4; ++q) hv[n * 4 + q] = silu_f(acc[ai][0][m][n][q]) * acc[ai][1][m][n][q];
                if (ent >= 0) { u32x4 w; w.x = cvt_pk_bf16(hv[0], hv[1]); w.y = cvt_pk_bf16(hv[2], hv[3]); w.z = cvt_pk_bf16(hv[4], hv[5]); w.w = cvt_pk_bf16(hv[6], hv[7]);
                    *(u32x4*)(H + (size_t)ent * DEXP + col0) = w; }
            }
    }
};
struct EpiG2 {
    bf16_t* Y; const LAS int* idxl; const float* gwt; const float* g_lat; const float* g_ctx;
    __device__ __forceinline__ void operator()(f32x4 (&acc)[2][2][4][2], const Unit& u, int ui, int wr, int wc, int fr, int fq) const {
        const int col0 = u.pn * 256 + wc * 32 + 8 * fq;
        int ent[2][4]; float gwv[2][4];
#pragma unroll
        for (int ai = 0; ai < 2; ++ai)
#pragma unroll
            for (int m = 0; m < 4; ++m) ent[ai][m] = idxl[ui * 256 + ai * 128 + wr * 64 + m * 16 + fr];
#pragma unroll
        for (int ai = 0; ai < 2; ++ai)
#pragma unroll
            for (int m = 0; m < 4; ++m) gwv[ai][m] = gwt[ent[ai][m] & 0x7fffffff];
        f32x4 gl[2][2], gc[2][2];
#pragma unroll
        for (int bj = 0; bj < 2; ++bj)
#pragma unroll
            for (int n = 0; n < 2; ++n) { gl[bj][n] = *(const f32x4*)(g_lat + col0 + bj * 128 + 4 * n); gc[bj][n] = *(const f32x4*)(g_ctx + col0 + bj * 128 + 4 * n); }
        asm volatile("" ::: "memory");
#pragma unroll
        for (int ai = 0; ai < 2; ++ai)
#pragma unroll
            for (int m = 0; m < 4; ++m) {
                const int e_ = ent[ai][m];
                if (e_ >= 0) {
                    const bool cx = e_ >= 2 * NTOK; const float gw_ = gwv[ai][m];
#pragma unroll
                    for (int bj = 0; bj < 2; ++bj) {
                        const f32x4 g0 = cx ? gc[bj][0] : gl[bj][0], g1 = cx ? gc[bj][1] : gl[bj][1];
                        const f32x4 v0 = acc[ai][bj][m][0] * g0 * gw_, v1 = acc[ai][bj][m][1] * g1 * gw_;
                        u32x4 w; w.x = cvt_pk_bf16(v0[0], v0[1]); w.y = cvt_pk_bf16(v0[2], v0[3]); w.z = cvt_pk_bf16(v1[0], v1[1]); w.w = cvt_pk_bf16(v1[2], v1[3]);
                        *(u32x4*)(Y + (size_t)e_ * DM + col0 + bj * 128) = w; }
                }
            }
    }
};

__device__ __forceinline__ void moe_setup(KArgs Ap, const Frame& F0, int l, LAS int* cntL, LAS int* idxl) {
    const Frame F = fresh(F0);
    const unsigned* gcnt = (const unsigned*)(Ap->ws + WS_CTL) + CW_CNT + l * 16;
    const int* glist = (const int*)(Ap->ws + WS_LIST);
    if (F.tid < 16) cntL[F.tid] = (int)gcnt[F.tid];
    __syncthreads();
    SchedMoe S{nullptr, nullptr, cntL, F.G, (int)blockIdx.x, 0, 0};
    Unit u;
    for (int i = 0; i < 8 && S.next(i, u); ++i) {
        const int n = cntL[u.e];
        if (F.tid < 256) { const int pos = u.pm * 256 + F.tid; const int* le = glist + (size_t)u.e * LIST_CAP;
            idxl[i * 256 + F.tid] = (pos < n) ? le[pos] : (int)((unsigned)le[0] | 0x80000000u); }
    }
    __syncthreads();
}

__global__ void __launch_bounds__(NWAVES * 64, 2) fwd_megakernel(Args A_unused) {
    extern __shared__ __attribute__((aligned(16))) unsigned char lds_raw[];
    Frame F;
    F.lds = (LAS unsigned char*)lds_raw;
    F.tid = threadIdx.x; F.lane = F.tid & 63; F.wave = __builtin_amdgcn_readfirstlane(F.tid >> 6);
    F.G = gridDim.x; { const int bx = blockIdx.x; F.vcu = (F.G % 8 == 0) ? (bx % 8) * (F.G / 8) + bx / 8 : bx; }
    volatile LAS unsigned* MISC = (volatile LAS unsigned*)(F.lds + MISC_OFF);
    for (int u = F.tid; u < 64; u += NWAVES * 64) MISC[u] = 0u;
    __syncthreads();
    XcdBarrier bar;
    { KArgs Ap = get_args(); bar = xcd_barrier_post((unsigned*)(Ap->ws + WS_CTL) + CW_BAR, MISC + 16); }
    LAS int* cntL = (LAS int*)(F.lds + MISC_OFF);
    LAS int* idxl = (LAS int*)(F.lds + IDX_OFF);

    int n_ts = 0;
#define STAMP() do { if (TS_A >= 0) { if (blockIdx.x == 0 && threadIdx.x == 0) { KArgs Ap_ = get_args(); ((unsigned long long*)(Ap_->ws + WS_SMALL + SM_TS))[n_ts] = __builtin_amdgcn_s_memrealtime(); } ++n_ts; } } while (0)
    STAMP();
#define REPS(k, cond) (((DUP == (k)) && (cond)) ? 2 : 1)
#pragma unroll 1
    for (int rep = 0; rep < REPS(1, true); ++rep) { { KArgs Ap = get_args(); p0_prologue(Ap, F); } xcd_barrier(bar); STAMP(); }
#pragma unroll 1
    for (int l = 0; l < 2; ++l) {
#pragma unroll 1
        for (int rep = 0; rep < REPS(2, l == 0); ++rep) { { KArgs Ap = get_args(); phase_n1(Ap, F, l); } xcd_barrier(bar); STAMP(); }
        {
            KArgs Ap = get_args(); unsigned char* ws = Ap->ws; const Frame Fp = fresh(F); int bx = (int)blockIdx.x; asm volatile("" : "+s"(bx));
            SchedInN S1{(const char*)(ws + WS_XN), (const char*)(ws + WS_WIN) + (size_t)l * IN_DIM * DM * 2, Fp.G, bx};
            EpiInN E1{(bf16_t*)(ws + WS_PU), (bf16_t*)(ws + WS_QF), Ap->q_norm + l * 512, Ap->k_norm + l * 512};
            pg8::gemm_phase<EpiInN, SchedInN, 2, false, 0>(Fp.lds, idxl, DM, S1, E1);
        }
#pragma unroll 1
        for (int part = 0; part < 2; ++part) {
            if (part == 1) { xcd_barrier(bar); STAMP(); }
            KArgs Ap = get_args(); unsigned char* ws = Ap->ws; const Frame Fp = fresh(F); int bx = (int)blockIdx.x; asm volatile("" : "+s"(bx));
            const bool fast = Fp.G == 256;
            int j0, jend, stride = 1 << 20;
            if (fast) { if (part == 0) { j0 = (bx >= 134) ? bx - 134 : 0; jend = (bx >= 134) ? 122 : 0; } else { j0 = (bx < 73) ? 122 + bx : 0; jend = (bx < 73) ? 195 : 0; } }
            else { j0 = Fp.G - 1 - bx; stride = Fp.G; jend = (part == 0) ? 195 : 0; }
            SchedInT S2{(const char*)(ws + WS_WIN) + (size_t)l * IN_DIM * DM * 2, (const char*)(ws + WS_XN), j0, stride, jend};
            EpiInT E2{(bf16_t*)(ws + WS_VF), (bf16_t*)(ws + WS_SGF), Ap->sg_norm + l * 256};
            pg8::gemm_phase<EpiInT, SchedInT, 1, false, 0>(Fp.lds, idxl, DM, S2, E2);
            if (part == 1) { if (!fast) phase_poolsg(Ap, F, l, bx, Fp.G); else if (bx >= 73) phase_poolsg(Ap, F, l, bx - 73, 183); }
        }
        xcd_barrier(bar); STAMP();
#pragma unroll 1
        for (int rep = 0; rep < REPS(4, true); ++rep) { { KArgs Ap = get_args(); phase_mix(Ap, F, l); } xcd_barrier(bar); STAMP(); }
#pragma unroll 1
        for (int rep = 0; rep < REPS(5, l == 0); ++rep) {
        {
            KArgs Ap = get_args(); unsigned char* ws = Ap->ws; const Frame Fp = fresh(F); int bx = (int)blockIdx.x; asm volatile("" : "+s"(bx));
            SchedOut S{(const char*)(ws + WS_MIX), (const char*)(ws + WS_WOUT) + (size_t)l * DM * DM * 2, Fp.G, bx, (l == 0) ? 65 : 64};
            EpiOut E{Ap->x, Ap->ctx, (bf16_t*)(ws + WS_HRES), modp(Ap, l, 0) + 2048, modp(Ap, l, 1) + 2048, l};
            pg8::gemm_phase<EpiOut, SchedOut, 1, false, 0>(Fp.lds, idxl, DM, S, E);
        }
        if (l == 0) { KArgs Ap = get_args(); int bx = (int)blockIdx.x; asm volatile("" : "+s"(bx)); convert_fill(Ap, F, bx, 65 * 4, CVG_IN0, CVG_OUT0); }
        xcd_barrier(bar); STAMP();
        }
        if (DUP == 8) { { KArgs Ap = get_args(); phase_n2(Ap, F, l, true); } xcd_barrier(bar); STAMP(); }
        { KArgs Ap = get_args(); phase_n2(Ap, F, l); }
        xcd_barrier(bar); STAMP();
        { KArgs Ap = get_args(); moe_setup(Ap, F, l, cntL, idxl); }
#pragma unroll 1
        for (int rep = 0; rep < REPS(6, true); ++rep) {
        {
            KArgs Ap = get_args(); unsigned char* ws = Ap->ws; const Frame Fp = fresh(F); int bx = (int)blockIdx.x; asm volatile("" : "+s"(bx));
            SchedMoe S{(const char*)(ws + WS_XN), (const char*)(ws + WS_WGU) + (size_t)l * NEXP * 1024 * 1024 * 2, cntL, Fp.G, bx, (size_t)1024 * 1024 * 2, (size_t)256 * DM * 2};
            EpiG1 E{(bf16_t*)(ws + WS_H), idxl};
            pg8::gemm_phase<EpiG1, SchedMoe, 1, true, 1>(Fp.lds, idxl, DM, S, E);
        }
        if (l == 0) { KArgs Ap = get_args(); int bx = (int)blockIdx.x; asm volatile("" : "+s"(bx)); int tu = 0;
            for (int e = 0; e < NEXP; ++e) tu += ((cntL[e] + 255) >> 8) * 4;
            convert_fill(Ap, F, bx, tu, CVG_OUT0, CVG_G10); }
        xcd_barrier(bar); STAMP();
        }
#pragma unroll 1
        for (int rep = 0; rep < REPS(7, true); ++rep) {
        {
            KArgs Ap = get_args(); unsigned char* ws = Ap->ws; const Frame Fp = fresh(F); int bx = (int)blockIdx.x; asm volatile("" : "+s"(bx));
            SchedMoe S{(const char*)(ws + WS_H), (const char*)(ws + WS_WDN) + (size_t)l * NEXP * 1024 * 512 * 2, cntL, Fp.G, bx, (size_t)1024 * 512 * 2, (size_t)256 * DEXP * 2};
            EpiG2 E{(bf16_t*)(ws + WS_Y), idxl, (const float*)(ws + WS_GW), modp(Ap, l, 0) + 5120, modp(Ap, l, 1) + 5120};
            pg8::gemm_phase<EpiG2, SchedMoe, 1, true, 0>(Fp.lds, idxl, DEXP, S, E);
        }
        if (l == 0) { KArgs Ap = get_args(); int bx = (int)blockIdx.x; asm volatile("" : "+s"(bx)); int tu = 0;
            for (int e = 0; e < NEXP; ++e) tu += ((cntL[e] + 255) >> 8) * 4;
            convert_fill(Ap, F, bx, tu, CVG_G10, CVG_END); }
        xcd_barrier(bar); STAMP();
        }
    }
    if (DUP == 9) { for (int rep = 0; rep < 16; ++rep) xcd_barrier(bar); STAMP(); }
    { KArgs Ap = get_args(); phase_final(Ap, F); }
    STAMP();
    if (TS_A >= 0) { KArgs Ap = get_args(); if (blockIdx.x == 0 && threadIdx.x == 0) { const unsigned long long* ts = (const unsigned long long*)(Ap->ws + WS_SMALL + SM_TS);
        asm volatile("s_waitcnt vmcnt(0)" ::: "memory"); Ap->out[0] = (float)(ts[TS_B < 0 ? 0 : TS_B] - ts[TS_A < 0 ? 0 : TS_A]) * 0.01f * TS_SCALE; } }
    { KArgs Ap = get_args(); if (blockIdx.x == 0 && threadIdx.x == 0) { const unsigned t = xb_ld((unsigned*)(Ap->ws + WS_CTL) + CW_BAR + XB_TMO); if (t != 0u) { asm volatile("s_waitcnt vmcnt(0)" ::: "memory"); Ap->out[5] = __builtin_nanf(""); } } }
}

extern "C" void kernel_launch(void* const* d_in, const int* in_sizes, int n_in, void* d_out, int out_size, void* d_ws, size_t ws_size, hipStream_t stream) {
    static int grid = 0;
    if (grid == 0) {
        if (n_in != 23 || out_size != NTOK * DM || ws_size < WS_END) { fprintf(stderr, "kernel_launch: unexpected sizes (n_in %d out %d ws %zu)\n", n_in, out_size, ws_size); grid = -1; return; }
        int dev = 0, cus = 0, per_cu = 0;
        if (hipGetDevice(&dev) != hipSuccess || hipDeviceGetAttribute(&cus, hipDeviceAttributeMultiprocessorCount, dev) != hipSuccess) { grid = -1; return; }
        if (hipFuncSetAttribute((const void*)fwd_megakernel, hipFuncAttributeMaxDynamicSharedMemorySize, LDS_BYTES) != hipSuccess) { fprintf(stderr, "kernel_launch: hipFuncSetAttribute failed\n"); grid = -1; return; }
        if (hipOccupancyMaxActiveBlocksPerMultiprocessor(&per_cu, (const void*)fwd_megakernel, NWAVES * 64, LDS_BYTES) != hipSuccess || per_cu < 1) { fprintf(stderr, "kernel_launch: occupancy query says %d\n", per_cu); (void)hipGetLastError(); grid = -1; return; }
        grid = cus;
        if (grid != 256) fprintf(stderr, "kernel_launch: %d CUs (built for 256)\n", grid);
    }
    if (grid < 0) return;
    (void)hipMemsetAsync((char*)d_ws + WS_CTL, 0, CTL_ZERO_BYTES, stream);
    Args a{};
    const float** ap = (const float**)&a;
    for (int i = 0; i < 23; ++i) ap[i] = (const float*)d_in[i];
    a.out = (float*)d_out; a.ws = (unsigned char*)d_ws;
    void* args[] = {&a};
    hipError_t e = hipLaunchCooperativeKernel((const void*)fwd_megakernel, dim3(grid), dim3(NWAVES * 64), args, LDS_BYTES, stream);
    if (e != hipSuccess) fprintf(stderr, "kernel_launch: cooperative launch failed: %s\n", hipGetErrorString(e));
}
```

```cpp
#include <hip/hip_runtime.h>
#include <cstdio>
#include <cstdint>

#ifndef DUP
#define DUP 0
#endif
#define TS_A -1
#define TS_B -1
#define TS_SCALE 1.0f
constexpr int NTOK = 16384, NCTX = 256, MROWS = NTOK + NCTX, DM = 1024, IN_DIM = 2304;
constexpr int NEXP = 16, DEXP = 512;
constexpr int PU_LD = 512;
constexpr int NBLK16 = MROWS / 16, NGRP32 = MROWS / 32, NCHUNK = MROWS / 128;
constexpr float EPS = 1e-6f;
constexpr float LOG2E = 1.4426950408889634f;

#define LAS __attribute__((address_space(3)))
#define GAS __attribute__((address_space(1)))
typedef unsigned short bf16_t;
typedef short bf16x8 __attribute__((ext_vector_type(8)));
typedef short bf16x4 __attribute__((ext_vector_type(4)));
typedef float f32x4 __attribute__((ext_vector_type(4)));
typedef float f32x2 __attribute__((ext_vector_type(2)));
typedef unsigned u32x4 __attribute__((ext_vector_type(4)));
typedef int i32x4 __attribute__((ext_vector_type(4)));
typedef unsigned u32x2 __attribute__((ext_vector_type(2)));

__device__ __forceinline__ unsigned cvt_pk_bf16_pin(float lo, float hi) { unsigned r; asm volatile("v_cvt_pk_bf16_f32 %0, %1, %2" : "=v"(r) : "v"(lo), "v"(hi)); return r; }
typedef __bf16 bf16x2_t __attribute__((ext_vector_type(2)));
__device__ __forceinline__ unsigned cvt_pk_bf16(float lo, float hi) { const f32x2 v = {lo, hi}; return __builtin_bit_cast(unsigned, __builtin_convertvector(v, bf16x2_t)); }
__device__ __forceinline__ float bf2f(unsigned short b) { return __builtin_bit_cast(float, (unsigned)b << 16); }
__device__ __forceinline__ f32x4 ld4bf(const bf16_t* p) { const bf16x4 a = *(const bf16x4*)p; return (f32x4){bf2f((unsigned short)a[0]), bf2f((unsigned short)a[1]), bf2f((unsigned short)a[2]), bf2f((unsigned short)a[3])}; }
#define BF2X4(w_) ((f32x4){__builtin_bit_cast(float, (w_).x << 16), __builtin_bit_cast(float, (w_).x & 0xffff0000u), __builtin_bit_cast(float, (w_).y << 16), __builtin_bit_cast(float, (w_).y & 0xffff0000u)})
__device__ __forceinline__ float gelu_tanh(float x) {
    const float y = x * (1.0f + 0.044715f * x * x);
    return x * __builtin_amdgcn_rcpf(1.0f + __builtin_amdgcn_exp2f(-2.3022082f * y));
}
__device__ __forceinline__ float silu_f(float x) { return x * __builtin_amdgcn_rcpf(1.0f + __builtin_amdgcn_exp2f(-LOG2E * x)); }
__device__ __forceinline__ float wave_sum(float v) {
#pragma unroll
    for (int o = 1; o < 64; o <<= 1) v += __shfl_xor(v, o);
    return v;
}

namespace pg8 {
constexpr int BM = 256, BK = 64, HALF = 128, HTB = HALF * BK * 2, STAGE_BYTES = 8 * HTB, NXCD = 8, WGM = 8;
__host__ __device__ __forceinline__ int lds_byte(int r, int c) { const int st = (r >> 4) * 2 + (c >> 5), rr = r & 15, cc = c & 31, ob = rr * 64 + cc * 2; return st * 1024 + (ob ^ (((ob >> 9) & 1) << 5)); }
__host__ __device__ __forceinline__ void stage_rc(int b, int& R, int& C) { const int st = b / 1024, sb = b % 1024, swz = sb ^ (((sb >> 9) & 1) << 5); R = (st >> 1) * 16 + swz / 64; C = (st & 1) * 32 + (swz % 64) / 2; }
__host__ __device__ __forceinline__ int perm32(int rho) { const int n = rho >> 4, i = rho & 15; return 8 * (i >> 2) + 4 * n + (i & 3); }

struct Unit { int pm, pn, e; };

__device__ __forceinline__ bool static_unit(int i, int G, int c, int nM, int nN, int& pm, int& pn) {
    const int nwg = nM * nN; const long L = (long)i * G + c; if (L >= nwg) return false;
    int wgid = (int)L; { const int q = nwg / NXCD, r = nwg % NXCD, xcd = wgid % NXCD, off = wgid / NXCD; wgid = (xcd < r ? xcd * (q + 1) : r * (q + 1) + (xcd - r) * q) + off; }
    const int nig = WGM * nN, gid = wgid / nig, fm = gid * WGM, gsz = (nM - fm) < WGM ? (nM - fm) : WGM;
    pm = fm + ((wgid % nig) % gsz); pn = (wgid % nig) / gsz; return true;
}

template <class Epi, class Sched, int BPERM, bool GATHER, int GSH, bool I8 = false>
__device__ __forceinline__ void gemm_phase(LAS unsigned char* lds, const LAS int* idxl, const int rbA, const int rbB, const int kbytes, const Sched& S, const Epi& E) {
    int tid_ = threadIdx.x; asm volatile("" : "+v"(tid_));
    const int tid = tid_, wid = __builtin_amdgcn_readfirstlane(tid >> 6), lane = tid & 63, wr = wid >> 2, wc = wid & 3, fr = lane & 15, fq = lane >> 4;
    const int nt = kbytes / 128;
    int R_[2], C_[2];
    unsigned voffA[2][2], voffB[2][2];
    const size_t hstepA = (size_t)HALF * (size_t)rbA, hstepB = (size_t)HALF * (size_t)rbB;
#pragma unroll
    for (int i = 0; i < 2; ++i) {
        stage_rc(tid * 16 + i * 8192, R_[i], C_[i]);
        const int R = R_[i], C = C_[i];
        voffA[0][i] = (unsigned)(R * rbA + C * 2); voffA[1][i] = 0u;
        if (BPERM == 2) {
#pragma unroll
            for (int bj = 0; bj < 2; ++bj) voffB[bj][i] = (unsigned)((64 * (R >> 5) + 32 * bj + perm32(R & 31)) * rbB + C * 2);
        } else {
            const int Rb = (BPERM == 1) ? ((R & ~31) + perm32(R & 31)) : R;
            voffB[0][i] = (unsigned)(Rb * rbB + C * 2); voffB[1][i] = 0u;
        }
    }
    const size_t kstep = (size_t)(BK * 2);
    const unsigned ldsw = (unsigned)wid * 1024u;
    const int aoff = lds_byte(wr * 64 + fr, fq * 8), boff = lds_byte(wc * 32 + fr, fq * 8);
#define PG8_SA(b, h) (((b) * 2 + (h)) * HTB)
#define PG8_SB(b, h) ((4 + (b) * 2 + (h)) * HTB)
#define PG8_STAGE(bufoff, gbase, voff) do { _Pragma("unroll") for (int _i = 0; _i < 2; ++_i) \
        __builtin_amdgcn_global_load_lds((const unsigned*)((const char*)(gbase) + (voff)[_i]), (LAS unsigned*)(lds + (bufoff) + ldsw + _i * 8192), 16, 0, 0); } while (0)
#define PG8_STA(bufoff, gbase, h) do { if (GATHER) PG8_STAGE(bufoff, gbase, voffA[h]); else PG8_STAGE(bufoff, (gbase) + (h) * hstepA, voffA[0]); } while (0)
#define PG8_STB(bufoff, gbase, h) do { if (BPERM == 2) PG8_STAGE(bufoff, gbase, voffB[h]); else PG8_STAGE(bufoff, (gbase) + (h) * hstepB, voffB[0]); } while (0)
#define PG8_GLOAD(u_) do { if (GATHER) { _Pragma("unroll") for (int _h = 0; _h < 2; ++_h) _Pragma("unroll") for (int _i = 0; _i < 2; ++_i) \
        voffA[_h][_i] = (unsigned)((((unsigned)idxl[(u_) * 256 + _h * 128 + R_[_i]] & 0x7fffffffu) >> GSH) * (unsigned)rbA + (unsigned)C_[_i] * 2u); } } while (0)
#define PG8_LDA(dst, b, h) do { _Pragma("unroll") for (int m = 0; m < 4; ++m) _Pragma("unroll") for (int k = 0; k < 2; ++k) dst[m][k] = *(const LAS bf16x8*)(lds + PG8_SA(b, h) + aoff + m * 2048 + k * 1024); } while (0)
#define PG8_LDB(dst, b, h) do { _Pragma("unroll") for (int n = 0; n < 2; ++n) _Pragma("unroll") for (int k = 0; k < 2; ++k) dst[n][k] = *(const LAS bf16x8*)(lds + PG8_SB(b, h) + boff + n * 2048 + k * 1024); } while (0)
#define PG8_MMA(ai, bj, At, Bt) do { __builtin_amdgcn_s_setprio(1); _Pragma("unroll") for (int m = 0; m < 4; ++m) _Pragma("unroll") for (int n = 0; n < 2; ++n) _Pragma("unroll") for (int k = 0; k < 2; ++k) { \
        if (I8) acc[ai][bj][m][n] = __builtin_bit_cast(f32x4, __builtin_amdgcn_mfma_i32_16x16x64_i8(__builtin_bit_cast(i32x4, Bt[n][k]), __builtin_bit_cast(i32x4, At[m][k]), __builtin_bit_cast(i32x4, acc[ai][bj][m][n]), 0, 0, 0)); \
        else acc[ai][bj][m][n] = __builtin_amdgcn_mfma_f32_16x16x32_bf16(Bt[n][k], At[m][k], acc[ai][bj][m][n], 0, 0, 0); } __builtin_amdgcn_s_setprio(0); } while (0)
#define PG8_WAIT_V(n) asm volatile("s_waitcnt vmcnt(" #n ")" ::: "memory")
#define PG8_WAIT_L(n) asm volatile("s_waitcnt lgkmcnt(" #n ")" ::: "memory")
#define PG8_BAR __builtin_amdgcn_s_barrier()
#define PG8_SCHED __builtin_amdgcn_sched_barrier(0)
    Unit cur, nxt; int ui = 0;
    if (!S.next(0, cur)) return;
    f32x4 acc[2][2][4][2];
#pragma unroll
    for (int a = 0; a < 2; ++a)
#pragma unroll
        for (int b = 0; b < 2; ++b)
#pragma unroll
            for (int m = 0; m < 4; ++m)
#pragma unroll
                for (int n = 0; n < 2; ++n) acc[a][b][m][n] = (f32x4){0.f, 0.f, 0.f, 0.f};
    bf16x8 At[4][2], B0[2][2], B1[2][2];
    const char* cA = S.a_base(cur); const char* cB = S.b_base(cur);
    PG8_GLOAD(0);
    PG8_STB(PG8_SB(0, 0), cB, 0); PG8_STB(PG8_SB(0, 1), cB, 1); PG8_STA(PG8_SA(0, 0), cA, 0); PG8_STA(PG8_SA(0, 1), cA, 1);
    if (wr == 1) PG8_BAR;
    PG8_WAIT_V(2); PG8_BAR;
    PG8_STB(PG8_SB(1, 0), cB + kstep, 0); PG8_STA(PG8_SA(1, 0), cA + kstep, 0); PG8_STB(PG8_SB(1, 1), cB + kstep, 1);
    PG8_WAIT_V(6); PG8_BAR;
    for (;;) {
        const bool has_next = S.next(ui + 1, nxt);
        const char* nA = has_next ? S.a_base(nxt) : cA; const char* nB = has_next ? S.b_base(nxt) : cB;
        for (int t = 0; t < nt; t += 2) {
            const bool last = (t == nt - 2);
            const char* a1 = cA + (size_t)(t + 1) * kstep;
            const char* a2 = last ? nA : cA + (size_t)(t + 2) * kstep; const char* b2 = last ? nB : cB + (size_t)(t + 2) * kstep;
            const char* a3 = a2 + kstep; const char* b3 = b2 + kstep;
            PG8_LDB(B0, 0, 0); PG8_LDB(B1, 0, 1); PG8_SCHED; PG8_LDA(At, 0, 0); PG8_STA(PG8_SA(1, 1), a1, 1);
            if (GATHER) { if (last && has_next) PG8_GLOAD(ui + 1); }
            PG8_WAIT_V(8); PG8_WAIT_L(0); PG8_BAR; PG8_MMA(0, 0, At, B0); PG8_MMA(0, 1, At, B1); PG8_BAR; PG8_SCHED;
            PG8_LDA(At, 0, 1); PG8_STB(PG8_SB(0, 0), b2, 0); PG8_STB(PG8_SB(0, 1), b2, 1); PG8_STA(PG8_SA(0, 0), a2, 0);
            PG8_WAIT_V(8); PG8_WAIT_L(0); PG8_BAR; PG8_MMA(1, 0, At, B0); PG8_MMA(1, 1, At, B1); PG8_BAR; PG8_SCHED;
            PG8_LDB(B0, 1, 0); PG8_LDB(B1, 1, 1); PG8_SCHED; PG8_LDA(At, 1, 0); PG8_STA(PG8_SA(0, 1), a2, 1);
            PG8_WAIT_V(8); PG8_WAIT_L(0); PG8_BAR; PG8_MMA(0, 0, At, B0); PG8_MMA(0, 1, At, B1); PG8_BAR; PG8_SCHED;
            PG8_LDA(At, 1, 1); PG8_STB(PG8_SB(1, 0), b3, 0); PG8_STB(PG8_SB(1, 1), b3, 1); PG8_STA(PG8_SA(1, 0), a3, 0);
            PG8_WAIT_V(8); PG8_WAIT_L(0); PG8_BAR; PG8_MMA(1, 0, At, B0); PG8_MMA(1, 1, At, B1); PG8_BAR; PG8_SCHED;
        }
        if (wr == 0) PG8_BAR;
        E(acc, cur, ui, wr, wc, fr, fq);
        if (!has_next) break;
#pragma unroll
        for (int a = 0; a < 2; ++a)
#pragma unroll
            for (int b = 0; b < 2; ++b)
#pragma unroll
                for (int m = 0; m < 4; ++m)
#pragma unroll
                    for (int n = 0; n < 2; ++n) acc[a][b][m][n] = (f32x4){0.f, 0.f, 0.f, 0.f};
        cur = nxt; cA = nA; cB = nB; ++ui;
        if (wr == 1) PG8_BAR;
    }
    PG8_WAIT_V(0);
    PG8_BAR;
#undef PG8_SA
#undef PG8_SB
#undef PG8_STAGE
#undef PG8_GLOAD
#undef PG8_STA
#undef PG8_STB
#undef PG8_LDA
#undef PG8_LDB
#undef PG8_MMA
#undef PG8_WAIT_V
#undef PG8_WAIT_L
#undef PG8_BAR
#undef PG8_SCHED
}
}

constexpr size_t MiB = 1u << 20;
constexpr size_t WS_CTL = 0, CTL_ZERO_BYTES = 65536;
constexpr size_t WS_SMALL = 1 * MiB;
constexpr size_t WS_LIST = 4 * MiB;
constexpr size_t WS_GW = 7 * MiB;
constexpr size_t WS_HCTX = 8 * MiB;
constexpr size_t WS_WIN = 10 * MiB;
constexpr size_t WS_WOUT = 19 * MiB;
constexpr size_t WS_WGU = 24 * MiB;
constexpr size_t WS_WDN = 88 * MiB;
constexpr size_t WS_XN = 120 * MiB;
constexpr size_t WS_PU = 153 * MiB;
constexpr size_t WS_QF = 170 * MiB, WS_KF = 187 * MiB, WS_VF = 204 * MiB;
constexpr size_t WS_SGF = 221 * MiB;
constexpr size_t WS_Y = WS_PU;
constexpr size_t WS_MIX = 230 * MiB;
constexpr size_t WS_H = WS_MIX;
constexpr size_t WS_HRES = 263 * MiB;
constexpr size_t WS_WGUQ = 296 * MiB;
constexpr size_t WS_END = 328 * MiB;
static_assert(WS_PU + (size_t)MROWS * PU_LD * 2 <= WS_QF && WS_QF + (size_t)MROWS * 512 * 2 <= WS_KF && WS_KF + (size_t)MROWS * 512 * 2 <= WS_VF && WS_VF + (size_t)MROWS * 512 * 2 <= WS_SGF && WS_SGF + (size_t)MROWS * 256 * 2 <= WS_MIX, "ws map");
static_assert(WS_Y + (size_t)2 * MROWS * DM * 2 <= WS_MIX && WS_MIX + (size_t)MROWS * DM * 2 <= WS_HRES && WS_HRES + (size_t)MROWS * DM * 2 <= WS_END && WS_XN + (size_t)MROWS * DM * 2 <= WS_PU && WS_WDN + (size_t)2 * 16 * 1024 * 512 * 2 <= WS_XN && WS_WGU + (size_t)2 * 16 * 1024 * 1024 * 2 <= WS_WDN, "ws map 2");
constexpr int CW_BAR = 4096;
constexpr int CW_CNT = 8192;
constexpr int CW_MOD = 16384;
static_assert(CW_MOD * 4 >= (int)CTL_ZERO_BYTES && (CW_CNT + 32) * 4 <= (int)CTL_ZERO_BYTES && (CW_MOD + 4 * 6144) * 4 <= (int)(1 * MiB), "ctl");
constexpr size_t SM_SGW = 0;
constexpr size_t SM_POOLT = 256 * 1024;
constexpr size_t SM_B2 = 320 * 1024;
constexpr size_t SM_TS = 324 * 1024;
constexpr size_t SM_C0 = 328 * 1024;
constexpr size_t SM_TMAXGU = 512 * 1024;
constexpr size_t SM_WSGU = 2688 * 1024;
constexpr size_t SM_XS = 2944 * 1024;
constexpr int LIST_CAP = 2 * MROWS;

constexpr int RING_BYTES = 131072;
constexpr int IDX_OFF = RING_BYTES;
constexpr int MISC_OFF = IDX_OFF + 8192;
constexpr int LDS_BYTES = 147456;
constexpr int NWAVES = 8;

#define XB_TMO      128
#define XB_XCNT(j)  (256  + 64 * (j))
#define XB_XSUB(j)  (1280 + 64 * (j))
#define XB_XGEN(j)  (2304 + 64 * (j))
#define XB_TOP      3328
#define XB_TOPGEN   3392
#define XCD_BAR_WORDS 3456
#define XB_SPIN_CAP (1u << 18)
__device__ __forceinline__ unsigned xb_ld(unsigned* p)              { return __hip_atomic_load(p, __ATOMIC_RELAXED, __HIP_MEMORY_SCOPE_AGENT); }
__device__ __forceinline__ unsigned xb_add(unsigned* p, unsigned v) { return __hip_atomic_fetch_add(p, v, __ATOMIC_RELAXED, __HIP_MEMORY_SCOPE_AGENT); }
__device__ __forceinline__ unsigned xb_xcc_id() { return (unsigned)__builtin_amdgcn_s_getreg((3 << 11) | 20) & 0xFu; }
#define XB_SPIN(cond, bar) do { unsigned _sp = 0; while (cond) { __builtin_amdgcn_s_sleep(1); \
    if ((++_sp & 255u) == 0u) { if (xb_ld(&(bar)[XB_TMO])) break; if (_sp > XB_SPIN_CAP) { atomicAdd(&(bar)[XB_TMO], 1u); break; } } } } while (0)
struct XcdBarrier { unsigned* bar; unsigned x; volatile LAS unsigned* st; };
__device__ __forceinline__ XcdBarrier xcd_barrier_post(unsigned* bar, volatile LAS unsigned* st) {
    XcdBarrier b; b.bar = bar; b.x = xb_xcc_id(); b.st = st;
    if (threadIdx.x == 0) (void)xb_add(&bar[XB_XCNT(b.x)], 1u);
    return b;
}
__device__ __forceinline__ void xcd_barrier_complete(unsigned* bar, unsigned x, unsigned& nloc, unsigned& nx) {
    const unsigned G = gridDim.x * gridDim.y * gridDim.z;
    unsigned sum, cnt, mine, sp = 0u;
    for (;;) {
        sum = 0u; cnt = 0u; mine = 0u;
#pragma unroll
        for (unsigned j = 0; j < 16; ++j) { const unsigned c = xb_ld(&bar[XB_XCNT(j)]); sum += c; cnt += (c > 0u) ? 1u : 0u; mine = (j == x) ? c : mine; }
        if (sum == G) break;
        __builtin_amdgcn_s_sleep(1);
        if ((++sp & 255u) == 0u) { if (xb_ld(&bar[XB_TMO])) break; if (sp > XB_SPIN_CAP) { atomicAdd(&bar[XB_TMO], 1u); break; } }
    }
    nloc = mine > 0u ? mine : 1u; nx = cnt > 0u ? cnt : 1u;
}
__device__ __forceinline__ void xcd_barrier(const XcdBarrier& b) {
    asm volatile("s_waitcnt vmcnt(0)" ::: "memory");
    __syncthreads();
    if (threadIdx.x == 0) {
        unsigned* bar = b.bar;
        __builtin_amdgcn_s_waitcnt(0);
        unsigned nloc = b.st[0], nx = b.st[1];
        if (nloc == 0u) { xcd_barrier_complete(bar, b.x, nloc, nx); b.st[0] = nloc; b.st[1] = nx; }
        const unsigned old = xb_add(&bar[XB_XSUB(b.x)], 1u);
        const unsigned gen = old / nloc;
        if (old + 1u == (gen + 1u) * nloc) {
            __builtin_amdgcn_fence(__ATOMIC_RELEASE, "agent");
            asm volatile("s_waitcnt vmcnt(0)" ::: "memory");
            const unsigned og = xb_add(&bar[XB_TOP], 1u);
            const unsigned tg = og / nx;
            if (og + 1u == (tg + 1u) * nx) xb_add(&bar[XB_TOPGEN], 1u);
            else XB_SPIN(xb_ld(&bar[XB_TOPGEN]) == tg, bar);
            __builtin_amdgcn_fence(__ATOMIC_ACQUIRE, "agent");
            xb_add(&bar[XB_XGEN(b.x)], 1u);
            asm volatile("s_waitcnt vmcnt(0)" ::: "memory");
        } else {
            XB_SPIN(xb_ld(&bar[XB_XGEN(b.x)]) == gen, bar);
            __builtin_amdgcn_fence(__ATOMIC_ACQUIRE, "agent");
            asm volatile("s_waitcnt vmcnt(0)" ::: "memory");
        }
    }
    __syncthreads();
}

struct Args {
    const float *x, *c, *ctx, *c_ctx, *w_ada, *b_ada, *norm1, *w_in, *pool_w, *pool_scale, *q_norm, *k_norm, *rpb, *sg_w, *sg_b, *sg_norm, *w_out, *norm2, *w_router, *b_router, *w_gate, *w_up, *w_down;
    float* out; unsigned char* ws;
};
struct Frame {
    LAS unsigned char* lds;
    int tid, lane, wave, vcu, G;
};
__device__ __forceinline__ Frame fresh(const Frame& F0) { Frame F = F0; asm volatile("" : "+v"(F.tid), "+v"(F.lane), "+s"(F.wave), "+s"(F.vcu), "+s"(F.G)); return F; }
typedef const __attribute__((address_space(4))) Args* KArgs;
__device__ __forceinline__ KArgs get_args() { KArgs p = (KArgs)__builtin_amdgcn_kernarg_segment_ptr(); asm volatile("" : "+s"(p)); return p; }

__device__ __forceinline__ unsigned f2bf(float f) { unsigned u = __builtin_bit_cast(unsigned, f); return (u + 0x7fffu + ((u >> 16) & 1u)) >> 16; }
__device__ __forceinline__ unsigned pk2(float lo, float hi) { return f2bf(lo) | (f2bf(hi) << 16); }
struct CvItem { const float* src; bf16_t* dst; int N, Kd; float* tmax; };
__device__ __forceinline__ void cv_load(const CvItem& c, float (&tv)[32], int lane) {
#pragma unroll
    for (int i = 0; i < 32; ++i) tv[i] = c.src[(size_t)(2 * i + (lane >> 5)) * c.N + (lane & 31)];
}
__device__ __forceinline__ void cv_finish(const CvItem& c, const float (&tv)[32], LAS float* scr, int lane) {
    if (c.tmax) { float m = 0.f;
#pragma unroll
        for (int i = 0; i < 32; ++i) m = fmaxf(m, fabsf(tv[i]));
        m = fmaxf(m, __shfl_xor(m, 32));
        if (lane < 32) c.tmax[lane * 16] = m; }
#pragma unroll
    for (int i = 0; i < 32; ++i) scr[(2 * i + (lane >> 5)) * 33 + (lane & 31)] = tv[i];
    asm volatile("s_waitcnt lgkmcnt(0)" ::: "memory");
    const int cc = lane & 7;
#pragma unroll
    for (int j = 0; j < 4; ++j) { const int n = (lane >> 3) + 8 * j; const LAS float* sp = scr + (8 * cc) * 33 + n;
        u32x4 o; o.x = pk2(sp[0 * 33], sp[1 * 33]); o.y = pk2(sp[2 * 33], sp[3 * 33]); o.z = pk2(sp[4 * 33], sp[5 * 33]); o.w = pk2(sp[6 * 33], sp[7 * 33]);
        *(u32x4*)(c.dst + (size_t)n * c.Kd + 8 * cc) = o; }
    asm volatile("s_waitcnt lgkmcnt(0)" ::: "memory");
}
__device__ __forceinline__ int win_dst_row(int n) { return n < 1280 ? n : (n < 1792 ? 1536 + (n - 1280) : (n < 2048 ? 1280 + (n - 1792) : n)); }

constexpr int CV_I_IN = 16 * 72, CV_I_OUT = 16 * 32, CV_I_G = 16 * 16, CV_I_D = 8 * 32;
constexpr int CV_IO = CV_I_IN + CV_I_OUT, CV_PER_L = CV_IO + 16 * (2 * CV_I_G + CV_I_D);
__device__ __forceinline__ CvItem cv_decode(KArgs Ap, int l, int r) {
    unsigned char* ws = Ap->ws; CvItem c; c.tmax = nullptr;
    if (r < CV_I_IN) { const int kb = r / 72, nb = r % 72;
        c.src = Ap->w_in + (size_t)l * DM * IN_DIM + (size_t)(kb * 64) * IN_DIM + nb * 32; c.N = IN_DIM; c.Kd = DM;
        c.dst = (bf16_t*)(ws + WS_WIN) + (size_t)l * IN_DIM * DM + (size_t)win_dst_row(nb * 32) * DM + kb * 64; return c; }
    r -= CV_I_IN;
    if (r < CV_I_OUT) { const int kb = r / 32, nb = r % 32;
        c.src = Ap->w_out + (size_t)l * DM * DM + (size_t)(kb * 64) * DM + nb * 32; c.N = DM; c.Kd = DM;
        c.dst = (bf16_t*)(ws + WS_WOUT) + (size_t)l * DM * DM + (size_t)(nb * 32) * DM + kb * 64; return c; }
    r -= CV_I_OUT;
    const int e = r / (2 * CV_I_G + CV_I_D); r = r % (2 * CV_I_G + CV_I_D);
    if (r < 2 * CV_I_G) { const int up = r / CV_I_G; r = r % CV_I_G; const int kb = r / 16, nb = r % 16; const int j0 = nb * 32;
        c.src = (up ? Ap->w_up : Ap->w_gate) + ((size_t)l * NEXP + e) * DM * DEXP + (size_t)(kb * 64) * DEXP + j0; c.N = DEXP; c.Kd = DM;
        const int drow0 = (j0 >> 7) * 256 + (j0 & 127) + (up ? 128 : 0);
        c.dst = (bf16_t*)(ws + WS_WGU) + ((size_t)l * NEXP + e) * 1024 * 1024 + (size_t)drow0 * DM + kb * 64;
        c.tmax = (float*)(ws + WS_SMALL + SM_TMAXGU) + (((size_t)l * NEXP + e) * 1024 + drow0) * 16 + kb; return c; }
    r -= 2 * CV_I_G;
    { const int kb = r / 32, nb = r % 32;
        c.src = Ap->w_down + ((size_t)l * NEXP + e) * DEXP * DM + (size_t)(kb * 64) * DM + nb * 32; c.N = DM; c.Kd = DEXP;
        c.dst = (bf16_t*)(ws + WS_WDN) + ((size_t)l * NEXP + e) * 1024 * 512 + (size_t)(nb * 32) * DEXP + kb * 64; return c; }
}
__device__ __forceinline__ CvItem cv_decode_g(KArgs Ap, int g) { const int l = (g >= CV_PER_L) ? 1 : 0; return cv_decode(Ap, l, g - l * CV_PER_L); }
__device__ __forceinline__ void convert_stream(KArgs Ap, int first, int step, int end, LAS float* scr, int lane) {
    if (first >= end) return;
    float tvA[32], tvB[32];
    CvItem ca = cv_decode_g(Ap, first), cb = ca;
    cv_load(ca, tvA, lane);
    for (int it = first; it < end; it += 2 * step) {
        const bool hb = it + step < end;
        if (hb) { cb = cv_decode_g(Ap, it + step); cv_load(cb, tvB, lane); }
        cv_finish(ca, tvA, scr, lane);
        if (!hb) break;
        const bool ha = it + 2 * step < end;
        if (ha) { ca = cv_decode_g(Ap, it + 2 * step); cv_load(ca, tvA, lane); }
        cv_finish(cb, tvB, scr, lane);
    }
}
constexpr int CVG_P0 = CV_IO;
constexpr int CVG_IN0 = CVG_P0 + 4700;
constexpr int CVG_OUT0 = 2 * CV_PER_L;
constexpr int CVG_G10 = 2 * CV_PER_L;
constexpr int CVG_END = 2 * CV_PER_L;
__device__ __forceinline__ void convert_fill_rank(KArgs Ap, const Frame& F0, int rank, int nfill, int lo, int hi) {
    const Frame F = fresh(F0);
    LAS float* scr = (LAS float*)(F.lds + F.wave * 16384);
    convert_stream(Ap, lo + rank * NWAVES + F.wave, nfill * NWAVES, hi, scr, F.lane);
}
__device__ __forceinline__ void convert_fill(KArgs Ap, const Frame& F0, int bx, int total_units, int lo, int hi) {
    const int G = F0.G, maxu = (total_units + G - 1) / G, nbig = total_units - (maxu - 1) * G;
    if (G - nbig >= G / 2) { if (bx >= nbig) convert_fill_rank(Ap, F0, bx - nbig, G - nbig, lo, hi); }
    else convert_fill_rank(Ap, F0, bx, G, lo, hi);
}
__device__ __forceinline__ void p0_prologue(KArgs Ap, const Frame& F0) {
    const Frame F = fresh(F0);
    unsigned char* ws = Ap->ws;
    LAS float* scr = (LAS float*)(F.lds + F.wave * 16384);
    const int gw = F.vcu * NWAVES + F.wave, NGW = F.G * NWAVES;
    const int lane = F.lane;
    float* mod = (float*)(ws + WS_CTL) + CW_MOD;
    for (int it = F.wave * F.G + F.vcu; it < 2 * 24 * 8; it += NGW) {
        const int l = it / (24 * 8), r = it % (24 * 8), nb = r / 8, sb = r % 8;
        const int kq = lane >> 3, c4 = (lane & 7) * 4;
        const float* W = Ap->w_ada + (size_t)l * DM * 6144 + nb * 256 + sb * 32 + c4;
        f32x4 a0 = (f32x4){0.f, 0.f, 0.f, 0.f}, a1 = a0;
#pragma unroll 1
        for (int k0 = kq; k0 < DM; k0 += 8 * 16) {
            f32x4 w[16];
#pragma unroll
            for (int u = 0; u < 16; ++u) w[u] = *(const f32x4*)(W + (size_t)(k0 + 8 * u) * 6144);
#pragma unroll
            for (int u = 0; u < 16; ++u) { const float c0 = silu_f(Ap->c[k0 + 8 * u]), c1 = silu_f(Ap->c_ctx[k0 + 8 * u]); a0 += w[u] * c0; a1 += w[u] * c1; }
        }
#pragma unroll
        for (int j = 0; j < 4; ++j) { float x0 = a0[j], x1 = a1[j];
            x0 += __shfl_xor(x0, 8); x0 += __shfl_xor(x0, 16); x0 += __shfl_xor(x0, 32); x1 += __shfl_xor(x1, 8); x1 += __shfl_xor(x1, 16); x1 += __shfl_xor(x1, 32); a0[j] = x0; a1[j] = x1; }
        if (kq == 0) { const f32x4 b = *(const f32x4*)(Ap->b_ada + l * 6144 + nb * 256 + sb * 32 + c4);
            *(f32x4*)(mod + (l * 2 + 0) * 6144 + nb * 256 + sb * 32 + c4) = a0 + b; *(f32x4*)(mod + (l * 2 + 1) * 6144 + nb * 256 + sb * 32 + c4) = a1 + b; }
    }
    convert_stream(Ap, gw, NGW, CVG_P0, scr, lane);
    const int gt = F.vcu * NWAVES * 64 + F.tid, NGT = F.G * NWAVES * 64;
    bf16_t* sgw = (bf16_t*)(ws + WS_SMALL + SM_SGW);
    for (int i = gt; i < 2 * 4 * 128 * 128; i += NGT) { const int j8 = i & 7, ln = (i >> 3) & 63, ss = (i >> 9) & 3, pb = (i >> 11) & 7, lh = i >> 14;
        sgw[i] = (bf16_t)f2bf(Ap->sg_w[(size_t)lh * 16384 + (16 * pb + (ln & 15)) * 128 + 32 * ss + 8 * (ln >> 4) + j8]); }
    bf16_t* poolt = (bf16_t*)(ws + WS_SMALL + SM_POOLT);
    for (int i = gt; i < 2 * 4 * 64 * 64; i += NGT) { const int lg = i >> 12, d = (i >> 6) & 63, c = i & 63; poolt[i] = (bf16_t)f2bf(Ap->pool_w[(lg << 12) + c * 64 + d]); }
    if (gw < 16) {
        const int l = gw >> 3, h = gw & 7;
        float mq = fabsf(Ap->q_norm[(l * 8 + h) * 64 + lane]), mk = fabsf(Ap->k_norm[(l * 8 + h) * 64 + lane]), mb = 0.f;
        for (int i = lane; i < 15 * 31; i += 64) mb = fmaxf(mb, fabsf(Ap->rpb[(l * 8 + h) * 465 + i]));
#pragma unroll
        for (int o = 1; o < 64; o <<= 1) { mq = fmaxf(mq, __shfl_xor(mq, o)); mk = fmaxf(mk, __shfl_xor(mk, o)); mb = fmaxf(mb, __shfl_xor(mb, o)); }
        if (lane == 0) ((float*)(ws + WS_SMALL + SM_B2))[gw] = LOG2E * (8.0f * mq * mk + mb);
    }
}

__device__ __forceinline__ void requant_gu(KArgs Ap, const Frame& F0) {
    const Frame F = fresh(F0);
    const int gw = F.vcu * NWAVES + F.wave, NGW = F.G * NWAVES, lane = F.lane;
    unsigned char* W = Ap->ws + WS_WGU; const float* tm = (const float*)(Ap->ws + WS_SMALL + SM_TMAXGU); float* wsc = (float*)(Ap->ws + WS_SMALL + SM_WSGU);
    for (int R = gw; R < 2 * NEXP * 1024; R += NGW) {
        const u32x4 a = *(const u32x4*)(W + (size_t)R * 2048 + lane * 32), b = *(const u32x4*)(W + (size_t)R * 2048 + lane * 32 + 16);
        float m = (lane < 16) ? tm[(size_t)R * 16 + lane] : 0.f;
#pragma unroll
        for (int o = 1; o < 16; o <<= 1) m = fmaxf(m, __shfl_xor(m, o));
        m = __shfl(m, 0);
        const float inv = (m > 0.f) ? 127.0f / m : 0.f;
        const unsigned w16[8] = {a.x, a.y, a.z, a.w, b.x, b.y, b.z, b.w}; u32x4 o4; unsigned* op = (unsigned*)&o4;
#pragma unroll
        for (int q = 0; q < 4; ++q) { unsigned pk = 0;
#pragma unroll
            for (int e2 = 0; e2 < 2; ++e2) { const unsigned w = w16[2 * q + e2];
                const int q0 = max(-127, min(127, (int)rintf(__builtin_bit_cast(float, w << 16) * inv))), q1 = max(-127, min(127, (int)rintf(__builtin_bit_cast(float, w & 0xffff0000u) * inv)));
                pk |= ((unsigned)(q0 & 255) << (16 * e2)) | ((unsigned)(q1 & 255) << (16 * e2 + 8)); }
            op[q] = pk; }
        *(u32x4*)(Ap->ws + WS_WGUQ + (size_t)R * 1024 + lane * 16) = o4;
        if (lane == 0) wsc[R] = m * (1.0f / 127.0f);
    }
}
__device__ __forceinline__ const float* modp(KArgs Ap, int l, int cls) { return (const float*)(Ap->ws + WS_CTL) + CW_MOD + (l * 2 + cls) * 6144; }

__device__ __forceinline__ void phase_n1(KArgs Ap, const Frame& F0, int l) {
    const Frame F = fresh(F0);
    const int gw = F.vcu * NWAVES + F.wave, NGW = F.G * NWAVES, lane = F.lane;
    bf16_t* XN = (bf16_t*)(Ap->ws + WS_XN); const bf16_t* Y = (const bf16_t*)(Ap->ws + WS_Y);
    bf16_t* HR = (bf16_t*)(Ap->ws + WS_HRES);
    f32x4 xc[4], xn[4]; u32x2 hc[4], y0c[4], y1c[4], hn_[4], y0n[4], y1n[4];
#define N1_LOAD(row_, X, H, Y0, Y1) do { const int r_ = (row_); if (l == 0) { const float* src_ = (r_ >= NTOK) ? Ap->ctx + (size_t)(r_ - NTOK) * DM : Ap->x + (size_t)r_ * DM; \
        _Pragma("unroll") for (int j_ = 0; j_ < 4; ++j_) X[j_] = *(const f32x4*)(src_ + lane * 4 + 256 * j_); } else { \
        _Pragma("unroll") for (int j_ = 0; j_ < 4; ++j_) { H[j_] = *(const u32x2*)(HR + (size_t)r_ * DM + lane * 4 + 256 * j_); Y0[j_] = *(const u32x2*)(Y + (size_t)(2 * r_) * DM + lane * 4 + 256 * j_); Y1[j_] = *(const u32x2*)(Y + (size_t)(2 * r_ + 1) * DM + lane * 4 + 256 * j_); } } } while (0)
    if (gw < MROWS) N1_LOAD(gw, xc, hc, y0c, y1c);
#pragma unroll 1
    for (int row = gw; row < MROWS; row += NGW) {
        const int cls = row >= NTOK;
        const bool hnx = row + NGW < MROWS;
        if (hnx) N1_LOAD(row + NGW, xn, hn_, y0n, y1n);
        f32x4 v[4]; float ss = 0.f;
        if (l == 0) {
#pragma unroll
            for (int j = 0; j < 4; ++j) v[j] = xc[j];
        } else {
            bf16_t* hr = HR + (size_t)row * DM;
#pragma unroll
            for (int j = 0; j < 4; ++j) {
                v[j] = BF2X4(hc[j]) + BF2X4(y0c[j]) + BF2X4(y1c[j]);
                u32x2 w; w.x = cvt_pk_bf16(v[j].x, v[j].y); w.y = cvt_pk_bf16(v[j].z, v[j].w);
                *(u32x2*)(hr + lane * 4 + 256 * j) = w;
                v[j] = BF2X4(w);
            }
        }
#pragma unroll
        for (int j = 0; j < 4; ++j) ss += (v[j].x * v[j].x + v[j].y * v[j].y) + (v[j].z * v[j].z + v[j].w * v[j].w);
        const float r = 1.0f / sqrtf(wave_sum(ss) * (1.0f / DM) + EPS);
        const float* md = modp(Ap, l, cls);
#pragma unroll
        for (int j = 0; j < 4; ++j) {
            const int k = lane * 4 + 256 * j;
            const f32x4 nw = *(const f32x4*)(Ap->norm1 + l * DM + k), sh = *(const f32x4*)(md + k), sc = *(const f32x4*)(md + 1024 + k);
            const f32x4 hn = v[j] * r * nw * (sc + 1.0f) + sh;
            u32x2 w; w.x = cvt_pk_bf16(hn.x, hn.y); w.y = cvt_pk_bf16(hn.z, hn.w);
            *(u32x2*)(XN + (size_t)row * DM + k) = w;
        }
#pragma unroll
        for (int j = 0; j < 4; ++j) { xc[j] = xn[j]; hc[j] = hn_[j]; y0c[j] = y0n[j]; y1c[j] = y1n[j]; }
    }
#undef N1_LOAD
}
__device__ __forceinline__ void phase_final(KArgs Ap, const Frame& F0) {
    const Frame F = fresh(F0);
    const int gw = F.vcu * NWAVES + F.wave, NGW = F.G * NWAVES, lane = F.lane;
    const bf16_t* Y = (const bf16_t*)(Ap->ws + WS_Y);
    const bf16_t* HR = (const bf16_t*)(Ap->ws + WS_HRES);
    u32x2 hc[4], y0c[4], y1c[4], hn_[4], y0n[4], y1n[4];
#define FN_LOAD(row_, H, Y0, Y1) do { const int r_ = (row_); _Pragma("unroll") for (int j_ = 0; j_ < 4; ++j_) { H[j_] = *(const u32x2*)(HR + (size_t)r_ * DM + lane * 4 + 256 * j_); \
        Y0[j_] = *(const u32x2*)(Y + (size_t)(2 * r_) * DM + lane * 4 + 256 * j_); Y1[j_] = *(const u32x2*)(Y + (size_t)(2 * r_ + 1) * DM + lane * 4 + 256 * j_); } } while (0)
    if (gw < NTOK) FN_LOAD(gw, hc, y0c, y1c);
#pragma unroll 1
    for (int row = gw; row < NTOK; row += NGW) {
        if (row + NGW < NTOK) FN_LOAD(row + NGW, hn_, y0n, y1n);
        float* dst = Ap->out + (size_t)row * DM;
#pragma unroll
        for (int j = 0; j < 4; ++j) *(f32x4*)(dst + lane * 4 + 256 * j) = BF2X4(hc[j]) + BF2X4(y0c[j]) + BF2X4(y1c[j]);
#pragma unroll
        for (int j = 0; j < 4; ++j) { hc[j] = hn_[j]; y0c[j] = y0n[j]; y1c[j] = y1n[j]; }
    }
#undef FN_LOAD
}

__device__ __forceinline__ void route_row(float (&lg)[16], const int row, const int lane, const float* brt, LAS int* cntL, LAS int* listL, float* gwt) {
    const bool hi5 = lane & 32, hi4 = lane & 16, hi3 = lane & 8, hi2 = lane & 4;
    float w8[8], w4[4], w2[2], val;
#pragma unroll
    for (int i = 0; i < 8; ++i) { const float send = hi5 ? lg[i] : lg[i + 8], keep = hi5 ? lg[i + 8] : lg[i]; w8[i] = keep + __shfl_xor(send, 32); }
#pragma unroll
    for (int i = 0; i < 4; ++i) { const float send = hi4 ? w8[i] : w8[i + 4], keep = hi4 ? w8[i + 4] : w8[i]; w4[i] = keep + __shfl_xor(send, 16); }
#pragma unroll
    for (int i = 0; i < 2; ++i) { const float send = hi3 ? w4[i] : w4[i + 2], keep = hi3 ? w4[i + 2] : w4[i]; w2[i] = keep + __shfl_xor(send, 8); }
    { const float send = hi2 ? w2[0] : w2[1], keep = hi2 ? w2[1] : w2[0]; val = keep + __shfl_xor(send, 4); }
    val += __shfl_xor(val, 1); val += __shfl_xor(val, 2);
    const int e = (lane >> 2) & 15, grp = lane >> 4;
    val += brt[e];
    float mx = val; mx = fmaxf(mx, __shfl_xor(mx, 4)); mx = fmaxf(mx, __shfl_xor(mx, 8)); mx = fmaxf(mx, __shfl_xor(mx, 16)); mx = fmaxf(mx, __shfl_xor(mx, 32));
    const float p = __expf(val - mx);
    const float o1 = __shfl_xor(p, 4), o2 = __shfl_xor(p, 8), o3 = __shfl_xor(p, 12);
    const float h1 = fmaxf(p, o1), l1 = fminf(p, o1), h2 = fmaxf(o2, o3), l2 = fminf(o2, o3);
    const float gs = fmaxf(h1, h2) + fmaxf(fminf(h1, h2), fmaxf(l1, l2));
    float bv = gs; int bk = grp;
    { const float ov = __shfl_xor(bv, 16); const int ok = __shfl_xor(bk, 16); if (ov > bv || (ov == bv && ok < bk)) { bv = ov; bk = ok; } }
    { const float ov = __shfl_xor(bv, 32); const int ok = __shfl_xor(bk, 32); if (ov > bv || (ov == bv && ok < bk)) { bv = ov; bk = ok; } }
    const int rank = ((o1 > p || (o1 == p && (e ^ 1) < e)) ? 1 : 0) + ((o2 > p || (o2 == p && (e ^ 2) < e)) ? 1 : 0) + ((o3 > p || (o3 == p && (e ^ 3) < e)) ? 1 : 0);
    if (bk == grp && rank < 2 && (lane & 3) == 0) {
        const int ent = 2 * row + rank;
        const int pos = __hip_atomic_fetch_add(cntL + e, 1, __ATOMIC_RELAXED, __HIP_MEMORY_SCOPE_WORKGROUP);
        listL[e * 136 + pos] = ent; gwt[ent] = p / gs;
    }
}
__device__ __forceinline__ void phase_n2(KArgs Ap, const Frame& F0, int l, bool dry = false) {
    const Frame F = fresh(F0);
    const int lane = F.lane, gw = F.vcu * NWAVES + F.wave, NGW = F.G * NWAVES;
    bf16_t* XN = (bf16_t*)(Ap->ws + WS_XN); const bf16_t* HR = (const bf16_t*)(Ap->ws + WS_HRES);
    LAS float* Wl = (LAS float*)(F.lds);
    LAS int* cntL = (LAS int*)(F.lds + 81920);
    LAS int* baseL = cntL + 16;
    LAS int* listL = cntL + 32;
    int* glist = (int*)(Ap->ws + WS_LIST); float* gwt = (float*)(Ap->ws + WS_GW);
    unsigned* gcnt = (unsigned*)(Ap->ws + WS_CTL) + CW_CNT + l * 16;
    const int nrows = (l == 0) ? MROWS : NTOK;
    if (F.tid < 16) cntL[F.tid] = 0;
    {
        f32x4 wt[8];
#pragma unroll
        for (int i = 0; i < 8; ++i) wt[i] = *(const f32x4*)(Ap->w_router + 4 * (F.tid + NWAVES * 64 * i));
#pragma unroll
        for (int i = 0; i < 8; ++i) { const int idx4 = F.tid + NWAVES * 64 * i, k = idx4 >> 2, e0 = (idx4 & 3) * 4;
            *(LAS f32x4*)(Wl + (((k >> 8) * 4 + (k & 3)) * 64 + ((k & 255) >> 2)) * 20 + e0) = wt[i]; }
    }
    __syncthreads();
    u32x2 rawc[2][4], rawn[2][4];
#define N2_LOAD(R, r0_) do { const int a_ = (r0_), b_ = ((r0_) + NGW < nrows) ? (r0_) + NGW : (r0_); \
        _Pragma("unroll") for (int j_ = 0; j_ < 4; ++j_) { R[0][j_] = *(const u32x2*)(HR + (size_t)a_ * DM + lane * 4 + 256 * j_); R[1][j_] = *(const u32x2*)(HR + (size_t)b_ * DM + lane * 4 + 256 * j_); } } while (0)
    if (gw < nrows) N2_LOAD(rawc, gw);
#pragma unroll 1
    for (int row0 = gw; row0 < nrows; row0 += 2 * NGW) {
        const int row1 = row0 + NGW; const bool has1 = row1 < nrows;
        if (row0 + 2 * NGW < nrows) N2_LOAD(rawn, row0 + 2 * NGW);
        float hn[2][16];
#pragma unroll
        for (int t = 0; t < 2; ++t) {
            const int row = (t == 0 || has1) ? (t == 0 ? row0 : row1) : row0;
            const int rc = row >= NTOK;
            f32x4 v[4]; float ss = 0.f;
#pragma unroll
            for (int j = 0; j < 4; ++j) { v[j] = BF2X4(rawc[t][j]); ss += (v[j].x * v[j].x + v[j].y * v[j].y) + (v[j].z * v[j].z + v[j].w * v[j].w); }
            const float r = 1.0f / sqrtf(wave_sum(ss) * (1.0f / DM) + EPS);
            const GAS float* md = (const GAS float*)modp(Ap, l, rc); const GAS float* n2p = (const GAS float*)(Ap->norm2 + l * DM);
            asm volatile("" : "+s"(md), "+s"(n2p));
#pragma unroll
            for (int j = 0; j < 4; ++j) {
                const int k = lane * 4 + 256 * j;
                const f32x4 nw = *(const GAS f32x4*)(n2p + k), sh = *(const GAS f32x4*)(md + 3072 + k), sc = *(const GAS f32x4*)(md + 4096 + k);
                const f32x4 h4 = v[j] * r * nw * (sc + 1.0f) + sh;
                hn[t][4 * j] = h4.x; hn[t][4 * j + 1] = h4.y; hn[t][4 * j + 2] = h4.z; hn[t][4 * j + 3] = h4.w;
            }
            {
                float mx = 0.f;
#pragma unroll
                for (int i = 0; i < 16; ++i) mx = fmaxf(mx, fabsf(hn[t][i]));
#pragma unroll
                for (int o = 1; o < 64; o <<= 1) mx = fmaxf(mx, __shfl_xor(mx, o));
                const float inv = (mx > 0.f) ? 127.0f / mx : 0.f;
                if (t == 0 || has1) {
#pragma unroll
                    for (int j = 0; j < 4; ++j) { unsigned pk = 0;
#pragma unroll
                        for (int q = 0; q < 4; ++q) pk |= (unsigned)(max(-127, min(127, (int)rintf(hn[t][4 * j + q] * inv))) & 255) << (8 * q);
                        *(unsigned*)((unsigned char*)XN + (size_t)row * DM + lane * 4 + 256 * j) = pk; }
                    if (lane == 0) ((float*)(Ap->ws + WS_SMALL + SM_XS))[row] = mx * (1.0f / 127.0f);
                }
            }
        }
#pragma unroll
        for (int t = 0; t < 2; ++t)
#pragma unroll
            for (int j = 0; j < 4; ++j) rawc[t][j] = rawn[t][j];
        if (dry) continue;
        float lg[2][16];
#pragma unroll
        for (int t = 0; t < 2; ++t)
#pragma unroll
            for (int e = 0; e < 16; ++e) lg[t][e] = 0.f;
        const LAS float* wlane = Wl + lane * 20; asm volatile("" : "+v"(wlane));
        f32x4 wa[4], wb[4];
#define N2_LDW(W_, jc_) do { _Pragma("unroll") for (int p_ = 0; p_ < 4; ++p_) W_[p_] = *(const LAS f32x4*)(wlane + (jc_) * 64 * 20 + 4 * p_); } while (0)
#define N2_FMA(W_, jc_) do { _Pragma("unroll") for (int p_ = 0; p_ < 4; ++p_) _Pragma("unroll") for (int t_ = 0; t_ < 2; ++t_) { const float hv_ = hn[t_][jc_]; \
        lg[t_][4 * p_] += hv_ * W_[p_].x; lg[t_][4 * p_ + 1] += hv_ * W_[p_].y; lg[t_][4 * p_ + 2] += hv_ * W_[p_].z; lg[t_][4 * p_ + 3] += hv_ * W_[p_].w; } \
        asm volatile("" : "+v"(lg[0][0]), "+v"(lg[0][1]), "+v"(lg[0][2]), "+v"(lg[0][3]), "+v"(lg[0][4]), "+v"(lg[0][5]), "+v"(lg[0][6]), "+v"(lg[0][7]), "+v"(lg[0][8]), "+v"(lg[0][9]), "+v"(lg[0][10]), "+v"(lg[0][11]), "+v"(lg[0][12]), "+v"(lg[0][13]), "+v"(lg[0][14]), "+v"(lg[0][15])); \
        asm volatile("" : "+v"(lg[1][0]), "+v"(lg[1][1]), "+v"(lg[1][2]), "+v"(lg[1][3]), "+v"(lg[1][4]), "+v"(lg[1][5]), "+v"(lg[1][6]), "+v"(lg[1][7]), "+v"(lg[1][8]), "+v"(lg[1][9]), "+v"(lg[1][10]), "+v"(lg[1][11]), "+v"(lg[1][12]), "+v"(lg[1][13]), "+v"(lg[1][14]), "+v"(lg[1][15])); } while (0)
        N2_LDW(wa, 0);
#pragma unroll
        for (int jc = 0; jc < 16; jc += 2) {
            N2_LDW(wb, jc + 1); N2_FMA(wa, jc);
            if (jc + 2 < 16) N2_LDW(wa, jc + 2);
            N2_FMA(wb, jc + 1);
        }
#undef N2_LDW
#undef N2_FMA
#pragma unroll 1
        for (int t = 0; t < 2; ++t) {
            if (t == 1) { if (!has1) break;
#pragma unroll
                for (int e = 0; e < 16; ++e) lg[0][e] = lg[1][e]; }
            route_row(lg[0], t == 0 ? row0 : row1, lane, Ap->b_router, cntL, listL, gwt);
        }
    }
    __syncthreads();
    if (dry) return;
    if (F.tid < 16) baseL[F.tid] = (int)__hip_atomic_fetch_add(gcnt + F.tid, (unsigned)cntL[F.tid], __ATOMIC_RELAXED, __HIP_MEMORY_SCOPE_AGENT);
    __syncthreads();
    for (int e = 0; e < 16; ++e) { const int n = cntL[e], b = baseL[e];
        for (int i = F.tid; i < n; i += NWAVES * 64) glist[(size_t)e * LIST_CAP + b + i] = listL[e * 136 + i]; }
    __syncthreads();
}

__device__ __forceinline__ bf16x8 ld8(const bf16_t* p) { return *(const bf16x8*)p; }
__device__ __forceinline__ bf16x8 ld4x2(const bf16_t* p0, const bf16_t* p1) { const bf16x4 a = *(const bf16x4*)p0, b = *(const bf16x4*)p1; return (bf16x8){a[0], a[1], a[2], a[3], b[0], b[1], b[2], b[3]}; }
#define MFMA16(a, b, c) __builtin_amdgcn_mfma_f32_16x16x32_bf16((a), (b), (c), 0, 0, 0)

template <int P, bool LOCAL>
__device__ __forceinline__ void attn_pair(const bf16x8 (&q)[4][2], f32x4 (&O)[4][4], float (&ls)[4], const bf16x8 (&k)[2][2], const bf16x8 (&v)[4],
                                          const LAS float* bl  , const int jsel  , const int fr, const int g, const float B2) {
#pragma unroll
    for (int j = 0; j < 4; ++j) {
        if (LOCAL && ((P == 0 && j == 3) || (P == 1 && j == 0))) continue;
        if (!LOCAL && jsel >= 0 && j != jsel) continue;
        float p[8];
#pragma unroll
        for (int s2 = 0; s2 < 2; ++s2) {
            const int kb = 2 * P + s2, dk = kb - j;
            if (LOCAL && (dk < -1 || dk > 1)) {
#pragma unroll
                for (int i = 0; i < 4; ++i) p[s2 * 4 + i] = 0.f;
                continue;
            }
            const f32x4 cinit = LOCAL ? (f32x4){bl[16 * dk], bl[16 * dk + 1], bl[16 * dk + 2], bl[16 * dk + 3]} : (f32x4){-B2, -B2, -B2, -B2};
            f32x4 S = MFMA16(k[s2][0], q[j][0], cinit);
            S = MFMA16(k[s2][1], q[j][1], S);
#pragma unroll
            for (int i = 0; i < 4; ++i) {
                float pv = __builtin_amdgcn_exp2f(S[i]);
                if (LOCAL) {
                    const int kc = 16 * kb + 4 * g + i;
                    const int cs = (j == 0) ? max(fr - 8, 0) : (j == 3) ? min(40 + fr, 48) : 16 * j + fr - 8;
                    const bool valid = (unsigned)(kc - cs) < 16u;
                    pv = valid ? pv : 0.f; }
                p[s2 * 4 + i] = pv; ls[j] += pv;
            }
        }
        u32x4 pw; pw.x = cvt_pk_bf16_pin(p[0], p[1]); pw.y = cvt_pk_bf16_pin(p[2], p[3]); pw.z = cvt_pk_bf16_pin(p[4], p[5]); pw.w = cvt_pk_bf16_pin(p[6], p[7]);
        const bf16x8 Pf = __builtin_bit_cast(bf16x8, pw);
#pragma unroll
        for (int d = 0; d < 4; ++d) O[j][d] = MFMA16(v[d], Pf, O[j][d]);
    }
}
template <bool LAT>
__device__ __forceinline__ void attn_row(KArgs Ap, const LAS float* biasL, const float B2, int r, int qt0, int h, int lane, int jsel = -1) {
    const char* QF = (const char*)(Ap->ws + WS_QF) + (size_t)h * NBLK16 * 2048; const char* KF = (const char*)(Ap->ws + WS_KF) + (size_t)h * NBLK16 * 2048;
    const char* VF = (const char*)(Ap->ws + WS_VF) + (size_t)h * NGRP32 * 4096; bf16_t* mix = (bf16_t*)(Ap->ws + WS_MIX);
    const int fr = lane & 15, g = lane >> 4;
    const unsigned loff = (unsigned)lane * 16u;
    bf16x8 q[4][2];
#pragma unroll
    for (int j = 0; j < 4; ++j) { const char* qp = QF + (size_t)((qt0 >> 4) + j) * 2048; q[j][0] = *(const bf16x8*)(qp + loff); q[j][1] = *(const bf16x8*)(qp + 1024 + loff); }
    f32x4 O[4][4]; float ls[4];
#pragma unroll
    for (int j = 0; j < 4; ++j) { ls[j] = 0.f;
#pragma unroll
        for (int d = 0; d < 4; ++d) O[j][d] = (f32x4){0.f, 0.f, 0.f, 0.f}; }
#define ATT_LDK(kk, tok) do { const char* kp_ = KF + (size_t)((tok) >> 4) * 2048; kk[0][0] = *(const bf16x8*)(kp_ + loff); kk[0][1] = *(const bf16x8*)(kp_ + 1024 + loff); \
        kk[1][0] = *(const bf16x8*)(kp_ + 2048 + loff); kk[1][1] = *(const bf16x8*)(kp_ + 3072 + loff); } while (0)
#define ATT_LDV(vv, tok) do { const char* vp_ = VF + (size_t)((tok) >> 5) * 4096; _Pragma("unroll") for (int d_ = 0; d_ < 4; ++d_) vv[d_] = *(const bf16x8*)(vp_ + d_ * 1024 + loff); } while (0)
    bf16x8 kA[2][2], kB[2][2], v[4];
    const LAS float* blane = biasL + 16 + 4 * g - fr + 15;
    if (LAT) {
        const int rs = min(max(r - 4, 0), 248);
        ATT_LDK(kA, rs * 64);
#pragma unroll 1
        for (int a = 0; a < 8; ++a) {
            const int tb = (rs + a) * 64;
            const LAS float* bl = blane + (rs + a - r + 7) * 64;
            ATT_LDV(v, tb); ATT_LDK(kB, tb + 32);
            attn_pair<0, true>(q, O, ls, kA, v, bl, 0, fr, g, B2);
            ATT_LDV(v, tb + 32); ATT_LDK(kA, (a < 7) ? tb + 64 : NTOK);
            attn_pair<1, true>(q, O, ls, kB, v, bl, 0, fr, g, B2);
        }
    } else {
        ATT_LDK(kA, NTOK);
    }
#pragma unroll 1
    for (int cp = 0; cp < 8; cp += 2) {
        ATT_LDV(v, NTOK + 32 * cp); ATT_LDK(kB, NTOK + 32 * (cp + 1));
        attn_pair<0, false>(q, O, ls, kA, v, blane, jsel, fr, g, B2);
        ATT_LDV(v, NTOK + 32 * (cp + 1)); ATT_LDK(kA, NTOK + 32 * min(cp + 2, 7));
        attn_pair<0, false>(q, O, ls, kB, v, blane, jsel, fr, g, B2);
    }
#undef ATT_LDK
#undef ATT_LDV
#pragma unroll
    for (int j = 0; j < 4; ++j) {
        if (jsel >= 0 && j != jsel) continue;
        float l_ = ls[j]; l_ += __shfl_xor(l_, 16); l_ += __shfl_xor(l_, 32);
        const float inv = 1.0f / l_;
        bf16_t* op = mix + (size_t)(qt0 + 16 * j + fr) * DM + 256 + h * 64 + 4 * g;
#pragma unroll
        for (int d = 0; d < 4; ++d) { u32x2 w; w.x = cvt_pk_bf16(O[j][d][0] * inv, O[j][d][1] * inv); w.y = cvt_pk_bf16(O[j][d][2] * inv, O[j][d][3] * inv); *(u32x2*)(op + 16 * d) = w; }
    }
}
template <int G4>
__device__ __forceinline__ void pool_item_t(KArgs Ap, int l, int t0, int lane) {
    constexpr int HW = 1 << G4;
    const bf16_t* PU = (const bf16_t*)(Ap->ws + WS_PU); bf16_t* mix = (bf16_t*)(Ap->ws + WS_MIX);
    const bf16_t* WT = (const bf16_t*)(Ap->ws + WS_SMALL + SM_POOLT) + (size_t)(l * 4 + G4) * 4096;
    const int fr = lane & 15, gq = lane >> 4;
    const int t = t0 + fr, base = (t0 >= NTOK) ? NTOK : 0, L = (t0 >= NTOK) ? NCTX : NTOK, tt = t - base;
    const int lo = max(tt - HW, 0), hi = min(tt + HW, L);
    const float invn = 1.0f / (float)(hi - lo);
    bf16x8 Bf[2];
#pragma unroll
    for (int s = 0; s < 2; ++s) {
        const int c0 = G4 * 64 + 32 * s + 8 * gq;
        bf16x8 wv[2 * HW];
#pragma unroll
        for (int d = 0; d < 2 * HW; ++d) { const int u = min(max(tt - HW + d, 0), L - 1); wv[d] = ld8(PU + (size_t)(base + u) * PU_LD + c0); }
        const bf16x8 self = ld8(PU + (size_t)t * PU_LD + c0);
        float acc8[8];
#pragma unroll
        for (int q = 0; q < 8; ++q) acc8[q] = 0.f;
#pragma unroll
        for (int d = 0; d < 2 * HW; ++d) { const int u = tt - HW + d; const float ok = (u >= 0 && u < L) ? 1.0f : 0.0f;
#pragma unroll
            for (int q = 0; q < 8; ++q) acc8[q] += ok * bf2f((unsigned short)wv[d][q]); }
        float dq[8];
#pragma unroll
        for (int q = 0; q < 8; ++q) dq[q] = acc8[q] * invn - bf2f((unsigned short)self[q]);
        u32x4 w; w.x = cvt_pk_bf16(dq[0], dq[1]); w.y = cvt_pk_bf16(dq[2], dq[3]); w.z = cvt_pk_bf16(dq[4], dq[5]); w.w = cvt_pk_bf16(dq[6], dq[7]);
        Bf[s] = __builtin_bit_cast(bf16x8, w);
    }
#pragma unroll
    for (int mb = 0; mb < 4; ++mb) {
        const bf16_t* wp = WT + (size_t)(16 * mb + fr) * 64 + 8 * gq;
        f32x4 o = MFMA16(ld8(wp), Bf[0], ((f32x4){0.f, 0.f, 0.f, 0.f}));
        o = MFMA16(ld8(wp + 32), Bf[1], o);
        const f32x4 ps = *(const f32x4*)(Ap->pool_scale + l * 256 + G4 * 64 + 16 * mb + 4 * gq);
        u32x2 w; w.x = cvt_pk_bf16(o[0] * ps[0], o[1] * ps[1]); w.y = cvt_pk_bf16(o[2] * ps[2], o[3] * ps[3]);
        *(u32x2*)(mix + (size_t)t * DM + G4 * 64 + 16 * mb + 4 * gq) = w;
    }
}
__device__ __forceinline__ void pool_item(KArgs Ap, int l, int t0, int g4, int lane) {
    if (g4 == 0) pool_item_t<0>(Ap, l, t0, lane); else if (g4 == 1) pool_item_t<1>(Ap, l, t0, lane); else if (g4 == 2) pool_item_t<2>(Ap, l, t0, lane); else pool_item_t<3>(Ap, l, t0, lane);
}
__device__ __forceinline__ void sg_item(KArgs Ap, int l, int ch, int h, int pb, int lane) {
    const bf16_t* PU = (const bf16_t*)(Ap->ws + WS_PU); bf16_t* mix = (bf16_t*)(Ap->ws + WS_MIX);
    const char* SGF = (const char*)(Ap->ws + WS_SGF) + (size_t)(h * NCHUNK + ch) * 16384;
    const char* W = (const char*)(Ap->ws + WS_SMALL + SM_SGW) + (size_t)((l * 4 + h) * 8 + pb) * 4096;
    const int fr = lane & 15, gq = lane >> 4;
    const unsigned loff = (unsigned)lane * 16u;
    const int p = 16 * pb + fr, tok = ch * 128 + p;
    f32x4 acc[4];
#pragma unroll
    for (int mb = 0; mb < 4; ++mb) acc[mb] = (f32x4){0.f, 0.f, 0.f, 0.f};
#pragma unroll
    for (int s = 0; s < 4; ++s) {
        const bf16x8 Bf = *(const bf16x8*)(W + s * 1024 + loff);
#pragma unroll
        for (int mb = 0; mb < 4; ++mb) acc[mb] = MFMA16(*(const bf16x8*)(SGF + (s * 4 + mb) * 1024 + loff), Bf, acc[mb]);
    }
    const float bias = Ap->sg_b[(l * 4 + h) * 128 + p];
#pragma unroll
    for (int mb = 0; mb < 4; ++mb) {
        const bf16x4 u4 = *(const bf16x4*)(PU + (size_t)tok * PU_LD + 256 + h * 64 + 16 * mb + 4 * gq);
        u32x2 w; w.x = cvt_pk_bf16(bf2f((unsigned short)u4[0]) * (acc[mb][0] + bias), bf2f((unsigned short)u4[1]) * (acc[mb][1] + bias));
        w.y = cvt_pk_bf16(bf2f((unsigned short)u4[2]) * (acc[mb][2] + bias), bf2f((unsigned short)u4[3]) * (acc[mb][3] + bias));
        *(u32x2*)(mix + (size_t)tok * DM + 768 + h * 64 + 16 * mb + 4 * gq) = w;
    }
}
__device__ __forceinline__ void phase_mix(KArgs Ap, const Frame& F0, int l) {
    const Frame F = fresh(F0);
    const int gw = F.vcu * NWAVES + F.wave, NGW = F.G * NWAVES, lane = F.lane;
    LAS float* biasL = (LAS float*)F.lds;
    const float* B2t = (const float*)(Ap->ws + WS_SMALL + SM_B2) + l * 8;
#define MIX_BIAS_FILL() do { const int h_ = F.wave; float bt_[15]; _Pragma("unroll") for (int t_ = 0; t_ < 15; ++t_) { const int i_ = lane + 64 * t_, rr_ = i_ >> 6, cc_ = (i_ & 63) - 16; \
            bt_[t_] = (cc_ >= 0 && cc_ < 31) ? Ap->rpb[(size_t)(l * 8 + h_) * 465 + rr_ * 31 + cc_] * LOG2E - B2t[h_] : 0.f; } \
        _Pragma("unroll") for (int t_ = 0; t_ < 15; ++t_) biasL[h_ * 960 + lane + 64 * t_] = bt_[t_]; \
        asm volatile("s_waitcnt lgkmcnt(0)" ::: "memory"); } while (0)
    const int n_att = 256 * 8, n_actx = (l == 0) ? 4 * 8 * 4 : 0;
    const int nrow_t = (l == 0) ? MROWS : NTOK;
    const int n_pool = (nrow_t / 16) * 4, n_sg = (nrow_t / 128) * 4 * 8;
#define MIX_POOLSG() do { pool_item(Ap, l, (gw >> 2) * 16, gw & 3, lane); pool_item(Ap, l, ((gw + NGW) >> 2) * 16, 3 - (gw & 3), lane);     \
        for (int it = gw; it < min(n_sg, 2 * NGW); it += NGW) sg_item(Ap, l, it >> 5, (it >> 3) & 3, it & 7, lane); \
        { const int itp = 2 * NGW + (gw - NGW / 2); if (gw >= NGW / 2 && itp < n_pool) pool_item(Ap, l, (itp >> 2) * 16, itp & 3, lane); \
          const int its = 2 * NGW + (gw - 3 * NGW / 4); if (gw >= 3 * NGW / 4 && its < n_sg) sg_item(Ap, l, its >> 5, (its >> 3) & 3, its & 7, lane); } } while (0)
    if (F.wave >= 4) MIX_POOLSG();
    MIX_BIAS_FILL();
    for (int it = gw; it < n_att + n_actx; it += NGW) {
        const int h = it & 7;
        if (it < n_att) attn_row<true>(Ap, biasL + h * 960, B2t[h], it >> 3, (it >> 3) * 64, h, lane);
        else attn_row<false>(Ap, biasL + h * 960, B2t[h], 0, NTOK + 64 * (((it - n_att) >> 3) & 3), h, lane, (it - n_att) >> 5);
    }
    if (F.wave < 4) MIX_POOLSG();
#undef MIX_POOLSG
#undef MIX_BIAS_FILL
    __syncthreads();
}

using pg8::Unit;
struct SchedInN { const char* A; const char* B; int G, c;
    __device__ __forceinline__ bool next(int i, Unit& u) const { u.e = 0; return pg8::static_unit(i, G, c, 65, 6, u.pm, u.pn); }
    __device__ __forceinline__ const char* a_base(const Unit& u) const { return A + (size_t)u.pm * 256 * DM * 2; }
    __device__ __forceinline__ const char* b_base(const Unit& u) const { return B + (size_t)u.pn * 256 * DM * 2; } };
struct SchedInT { const char* A; const char* B; int G, c;
    __device__ __forceinline__ bool next(int i, Unit& u) const { u.e = 0; return pg8::static_unit(i, G, c, 3, 65, u.pm, u.pn); }
    __device__ __forceinline__ const char* a_base(const Unit& u) const { return A + (size_t)(1536 + u.pm * 256) * DM * 2; }
    __device__ __forceinline__ const char* b_base(const Unit& u) const { return B + (size_t)u.pn * 256 * DM * 2; } };
struct SchedOut { const char* A; const char* B; int G, c, nM;
    __device__ __forceinline__ bool next(int i, Unit& u) const { u.e = 0; return pg8::static_unit(i, G, c, nM, 4, u.pm, u.pn); }
    __device__ __forceinline__ const char* a_base(const Unit& u) const { return A + (size_t)u.pm * 256 * DM * 2; }
    __device__ __forceinline__ const char* b_base(const Unit& u) const { return B + (size_t)u.pn * 256 * DM * 2; } };
struct SchedMoe { const char* A; const char* B; const LAS int* cnt; int G, c; size_t bstride_e, bstride_pn;
    __device__ __forceinline__ bool next(int i, Unit& u) const {
        int L = i * G + c;
#pragma unroll 1
        for (int e = 0; e < NEXP; ++e) { const int nu = ((cnt[e] + 255) >> 8) * 4; if (L < nu) { u.e = e; u.pm = L >> 2; u.pn = L & 3; return true; } L -= nu; }
        return false; }
    __device__ __forceinline__ const char* a_base(const Unit&) const { return A; }
    __device__ __forceinline__ const char* b_base(const Unit& u) const { return B + (size_t)u.e * bstride_e + (size_t)u.pn * bstride_pn; } };

struct EpiInN {
    bf16_t* PU; bf16_t* QF; const float* qw; const float* kw;
    __device__ __forceinline__ void operator()(f32x4 (&acc)[2][2][4][2], const Unit& u, int, int wr, int wc, int fr, int fq) const {
        const int type = (u.pn == 0) ? 0 : (u.pn <= 2) ? 1 : (u.pn <= 4) ? 2 : 3;
        const int head = (type == 1) ? (u.pn - 1) * 4 + wc : (type == 2) ? (u.pn - 3) * 4 + wc : 0;
        f32x4 wv[2][2];
#pragma unroll
        for (int bj = 0; bj < 2; ++bj)
#pragma unroll
            for (int n = 0; n < 2; ++n) {
                const int d = 32 * bj + 8 * fq + 4 * n;
                wv[bj][n] = (type == 1) ? *(const f32x4*)(qw + head * 64 + d) * (0.125f * LOG2E) : (type == 2) ? *(const f32x4*)(kw + head * 64 + d) : (f32x4){1.f, 1.f, 1.f, 1.f};
            }
        const int row0 = u.pm * 256 + wr * 64 + fr;
#pragma unroll
        for (int ai = 0; ai < 2; ++ai)
#pragma unroll
            for (int m = 0; m < 4; ++m) {
                f32x4 v[2][2];
#pragma unroll
                for (int bj = 0; bj < 2; ++bj)
#pragma unroll
                    for (int n = 0; n < 2; ++n) v[bj][n] = acc[ai][bj][m][n];
                const int row = row0 + ai * 128 + m * 16;
                bf16_t* dst; int dstep;
                if (type == 1 || type == 2) {
                    float ss = 0.f;
#pragma unroll
                    for (int bj = 0; bj < 2; ++bj)
#pragma unroll
                        for (int n = 0; n < 2; ++n) ss += (v[bj][n][0] * v[bj][n][0] + v[bj][n][1] * v[bj][n][1]) + (v[bj][n][2] * v[bj][n][2] + v[bj][n][3] * v[bj][n][3]);
                    ss += __shfl_xor(ss, 16); ss += __shfl_xor(ss, 32);
                    const float r = 1.0f / sqrtf(ss * (1.0f / 64.0f) + EPS);
#pragma unroll
                    for (int bj = 0; bj < 2; ++bj)
#pragma unroll
                        for (int n = 0; n < 2; ++n) v[bj][n] = v[bj][n] * r * wv[bj][n];
                    dst = QF + (type == 2 ? (WS_KF - WS_QF) / 2 : (size_t)0) + ((size_t)(head * NBLK16 + (row >> 4)) * 2 * 64 + ((fq << 4) | fr)) * 8; dstep = 512;
                } else {
                    if (type == 3) {
#pragma unroll
                        for (int bj = 0; bj < 2; ++bj)
#pragma unroll
                            for (int n = 0; n < 2; ++n)
#pragma unroll
                                for (int q = 0; q < 4; ++q) v[bj][n][q] = gelu_tanh(v[bj][n][q]);
                    }
                    dst = PU + (size_t)row * PU_LD + (type == 3 ? 256 : 0) + wc * 64 + 8 * fq; dstep = 32;
                }
#pragma unroll
                for (int bj = 0; bj < 2; ++bj) { u32x4 w; w.x = cvt_pk_bf16(v[bj][0][0], v[bj][0][1]); w.y = cvt_pk_bf16(v[bj][0][2], v[bj][0][3]); w.z = cvt_pk_bf16(v[bj][1][0], v[bj][1][1]); w.w = cvt_pk_bf16(v[bj][1][2], v[bj][1][3]);
                    *(u32x4*)(dst + bj * dstep) = w; }
            }
    }
};
struct EpiInT {
    bf16_t* VF; bf16_t* SGF; const float* sgn;
    __device__ __forceinline__ void operator()(f32x4 (&acc)[2][2][4][2], const Unit& u, int, int wr, int wc, int fr, int fq) const {
#pragma unroll
        for (int ai = 0; ai < 2; ++ai) {
            const int head = 2 * ai + wr;
            if (u.pm == 2) {
                float sw[4];
#pragma unroll
                for (int m = 0; m < 4; ++m) sw[m] = sgn[head * 64 + 16 * m + fr];
#pragma unroll
                for (int bj = 0; bj < 2; ++bj)
#pragma unroll
                    for (int n = 0; n < 2; ++n) {
                        f32x4 ss = (f32x4){0.f, 0.f, 0.f, 0.f};
#pragma unroll
                        for (int m = 0; m < 4; ++m) {
#pragma unroll
                            for (int q = 0; q < 4; ++q) acc[ai][bj][m][n][q] = gelu_tanh(acc[ai][bj][m][n][q]);
                            ss += acc[ai][bj][m][n] * acc[ai][bj][m][n]; }
#pragma unroll
                        for (int q = 0; q < 4; ++q) { float t = ss[q]; t += __shfl_xor(t, 1); t += __shfl_xor(t, 2); t += __shfl_xor(t, 4); t += __shfl_xor(t, 8); ss[q] = 1.0f / sqrtf(t * (1.0f / 64.0f) + EPS); }
#pragma unroll
                        for (int m = 0; m < 4; ++m) acc[ai][bj][m][n] = acc[ai][bj][m][n] * ss * sw[m];
                    }
#pragma unroll
                for (int m = 0; m < 4; ++m)
#pragma unroll
                    for (int bj = 0; bj < 2; ++bj) { const f32x4 v0 = acc[ai][bj][m][0], v1 = acc[ai][bj][m][1];
                        u32x4 w; w.x = cvt_pk_bf16(v0[0], v0[1]); w.y = cvt_pk_bf16(v0[2], v0[3]); w.z = cvt_pk_bf16(v1[0], v1[1]); w.w = cvt_pk_bf16(v1[2], v1[3]);
                        *(u32x4*)(SGF + ((((size_t)(head * NCHUNK + 2 * u.pn + bj) * 4 + wc) * 4 + m) * 64 + ((fq << 4) | fr)) * 8) = w; }
            } else {
#pragma unroll
                for (int m = 0; m < 4; ++m)
#pragma unroll
                    for (int bj = 0; bj < 2; ++bj)
#pragma unroll
                        for (int n = 0; n < 2; ++n) { const f32x4 v0 = acc[ai][bj][m][n];
                            u32x2 w; w.x = cvt_pk_bf16(v0[0], v0[1]); w.y = cvt_pk_bf16(v0[2], v0[3]);
                            *(u32x2*)(VF + ((((size_t)((4 * u.pm + head) * NGRP32 + 8 * u.pn + 4 * bj + wc) * 4 + m) * 64 + (((2 * (fq & 1) + n) << 4) | fr)) * 8 + 4 * (fq >> 1))) = w; }
            }
        }
    }
};
struct EpiOut {
    const float* base_lat; const float* base_ctx; bf16_t* HR; const float* g_lat; const float* g_ctx; int l;
    __device__ __forceinline__ void operator()(f32x4 (&acc)[2][2][4][2], const Unit& u, int, int wr, int wc, int fr, int fq) const {
        const bool cx = u.pm >= 64;
        const float* gt = cx ? g_ctx : g_lat;
        const int row0 = u.pm * 256 + wr * 64 + fr, col0 = u.pn * 256 + wc * 32 + 8 * fq;
        f32x4 gv[2][2];
#pragma unroll
        for (int bj = 0; bj < 2; ++bj)
#pragma unroll
            for (int n = 0; n < 2; ++n) gv[bj][n] = *(const f32x4*)(gt + col0 + bj * 128 + n * 4);
        const float* bp0 = (cx ? base_ctx + (size_t)(row0 - NTOK) * DM : base_lat + (size_t)row0 * DM) + col0;
        bf16_t* hp0 = HR + (size_t)row0 * DM + col0;
#pragma unroll
        for (int ai = 0; ai < 2; ++ai) {
            if (l == 0) {
                f32x4 b[4][2][2];
#pragma unroll
                for (int m = 0; m < 4; ++m)
#pragma unroll
                    for (int bj = 0; bj < 2; ++bj) { const float* bp = bp0 + (size_t)(ai * 128 + m * 16) * DM + bj * 128; b[m][bj][0] = *(const f32x4*)bp; b[m][bj][1] = *(const f32x4*)(bp + 4); }
#pragma unroll
                for (int m = 0; m < 4; ++m)
#pragma unroll
                    for (int bj = 0; bj < 2; ++bj) {
                        const f32x4 o0 = b[m][bj][0] + gv[bj][0] * acc[ai][bj][m][0], o1 = b[m][bj][1] + gv[bj][1] * acc[ai][bj][m][1];
                        u32x4 w; w.x = cvt_pk_bf16(o0[0], o0[1]); w.y = cvt_pk_bf16(o0[2], o0[3]); w.z = cvt_pk_bf16(o1[0], o1[1]); w.w = cvt_pk_bf16(o1[2], o1[3]);
                        *(u32x4*)(hp0 + (size_t)(ai * 128 + m * 16) * DM + bj * 128) = w; }
            } else {
                u32x4 b[4][2];
#pragma unroll
                for (int m = 0; m < 4; ++m)
#pragma unroll
                    for (int bj = 0; bj < 2; ++bj) b[m][bj] = *(const u32x4*)(hp0 + (size_t)(ai * 128 + m * 16) * DM + bj * 128);
                asm volatile("" ::: "memory");
#pragma unroll
                for (int m = 0; m < 4; ++m)
#pragma unroll
                    for (int bj = 0; bj < 2; ++bj) {
                        const u32x2 lo = {b[m][bj].x, b[m][bj].y}, hi = {b[m][bj].z, b[m][bj].w};
                        const f32x4 o0 = BF2X4(lo) + gv[bj][0] * acc[ai][bj][m][0], o1 = BF2X4(hi) + gv[bj][1] * acc[ai][bj][m][1];
                        u32x4 w; w.x = cvt_pk_bf16(o0[0], o0[1]); w.y = cvt_pk_bf16(o0[2], o0[3]); w.z = cvt_pk_bf16(o1[0], o1[1]); w.w = cvt_pk_bf16(o1[2], o1[3]);
                        *(u32x4*)(hp0 + (size_t)(ai * 128 + m * 16) * DM + bj * 128) = w; }
            }
            asm volatile("" ::: "memory");
        }
    }
};
struct EpiG1 {
    bf16_t* H; const LAS int* idxl; const float* xs; const float* wsc;
    __device__ __forceinline__ void operator()(f32x4 (&acc)[2][2][4][2], const Unit& u, int ui, int wr, int wc, int fr, int fq) const {
        const int col0 = u.pn * 128 + wc * 32 + 8 * fq;
        const float* wrow = wsc + u.e * 1024 + u.pn * 256 + wc * 32 + 8 * fq;
        f32x4 wg[2], wu[2];
#pragma unroll
        for (int n = 0; n < 2; ++n) { wg[n] = *(const f32x4*)(wrow + 4 * n); wu[n] = *(const f32x4*)(wrow + 128 + 4 * n); }
        int ent[2][4]; float xsc[2][4];
#pragma unroll
        for (int ai = 0; ai < 2; ++ai)
#pragma unroll
            for (int m = 0; m < 4; ++m) ent[ai][m] = idxl[ui * 256 + ai * 128 + wr * 64 + m * 16 + fr];
#pragma unroll
        for (int ai = 0; ai < 2; ++ai)
#pragma unroll
            for (int m = 0; m < 4; ++m) xsc[ai][m] = xs[(ent[ai][m] & 0x7fffffff) >> 1];
#pragma unroll
        for (int ai = 0; ai < 2; ++ai)
#pragma unroll
            for (int m = 0; m < 4; ++m) {
                float hv[8];
#pragma unroll
                for (int n = 0; n < 2; ++n)
                {   const i32x4 ig = __builtin_bit_cast(i32x4, acc[ai][0][m][n]), iu = __builtin_bit_cast(i32x4, acc[ai][1][m][n]);
#pragma unroll
                    for (int q = 0; q < 4; ++q) {
                        const float g = (float)ig[q] * (xsc[ai][m] * wg[n][q]);
                        const float up = (float)iu[q] * (xsc[ai][m] * wu[n][q]);
                        hv[n * 4 + q] = silu_f(g) * up; } }
                if (ent[ai][m] >= 0) { u32x4 w; w.x = cvt_pk_bf16(hv[0], hv[1]); w.y = cvt_pk_bf16(hv[2], hv[3]); w.z = cvt_pk_bf16(hv[4], hv[5]); w.w = cvt_pk_bf16(hv[6], hv[7]);
                    *(u32x4*)(H + (size_t)ent[ai][m] * DEXP + col0) = w; }
            }
    }
};
struct EpiG2 {
    bf16_t* Y; const LAS int* idxl; const float* gwt; const float* g_lat; const float* g_ctx;
    __device__ __forceinline__ void operator()(f32x4 (&acc)[2][2][4][2], const Unit& u, int ui, int wr, int wc, int fr, int fq) const {
        const int col0 = u.pn * 256 + wc * 32 + 8 * fq;
        int ent[2][4]; float gwv[2][4];
#pragma unroll
        for (int ai = 0; ai < 2; ++ai)
#pragma unroll
            for (int m = 0; m < 4; ++m) ent[ai][m] = idxl[ui * 256 + ai * 128 + wr * 64 + m * 16 + fr];
#pragma unroll
        for (int ai = 0; ai < 2; ++ai)
#pragma unroll
            for (int m = 0; m < 4; ++m) gwv[ai][m] = gwt[ent[ai][m] & 0x7fffffff];
        f32x4 gl[2][2], gc[2][2];
#pragma unroll
        for (int bj = 0; bj < 2; ++bj)
#pragma unroll
            for (int n = 0; n < 2; ++n) { gl[bj][n] = *(const f32x4*)(g_lat + col0 + bj * 128 + 4 * n); gc[bj][n] = *(const f32x4*)(g_ctx + col0 + bj * 128 + 4 * n); }
        asm volatile("" ::: "memory");
#pragma unroll
        for (int ai = 0; ai < 2; ++ai)
#pragma unroll
            for (int m = 0; m < 4; ++m) {
                const int e_ = ent[ai][m];
                if (e_ >= 0) {
                    const bool cx = e_ >= 2 * NTOK; const float gw_ = gwv[ai][m];
#pragma unroll
                    for (int bj = 0; bj < 2; ++bj) {
                        const f32x4 g0 = cx ? gc[bj][0] : gl[bj][0], g1 = cx ? gc[bj][1] : gl[bj][1];
                        const f32x4 v0 = acc[ai][bj][m][0] * g0 * gw_, v1 = acc[ai][bj][m][1] * g1 * gw_;
                        u32x4 w; w.x = cvt_pk_bf16(v0[0], v0[1]); w.y = cvt_pk_bf16(v0[2], v0[3]); w.z = cvt_pk_bf16(v1[0], v1[1]); w.w = cvt_pk_bf16(v1[2], v1[3]);
                        *(u32x4*)(Y + (size_t)e_ * DM + col0 + bj * 128) = w; }
                }
            }
    }
};

__device__ __forceinline__ void moe_setup(KArgs Ap, const Frame& F0, int l, LAS int* cntL, LAS int* idxl) {
    const Frame F = fresh(F0);
    const unsigned* gcnt = (const unsigned*)(Ap->ws + WS_CTL) + CW_CNT + l * 16;
    const int* glist = (const int*)(Ap->ws + WS_LIST);
    if (F.tid < 16) cntL[F.tid] = (int)gcnt[F.tid];
    __syncthreads();
    SchedMoe S{nullptr, nullptr, cntL, F.G, (int)blockIdx.x, 0, 0};
    Unit u;
    for (int i = 0; i < 8 && S.next(i, u); ++i) {
        const int n = cntL[u.e];
        if (F.tid < 256) { const int pos = u.pm * 256 + F.tid; const int* le = glist + (size_t)u.e * LIST_CAP;
            idxl[i * 256 + F.tid] = (pos < n) ? le[pos] : (int)((unsigned)le[0] | 0x80000000u); }
    }
    __syncthreads();
}

__global__ void __launch_bounds__(NWAVES * 64, 2) fwd_megakernel(Args A_unused) {
    extern __shared__ __attribute__((aligned(16))) unsigned char lds_raw[];
    Frame F;
    F.lds = (LAS unsigned char*)lds_raw;
    F.tid = threadIdx.x; F.lane = F.tid & 63; F.wave = __builtin_amdgcn_readfirstlane(F.tid >> 6);
    F.G = gridDim.x; { const int bx = blockIdx.x; F.vcu = (F.G % 8 == 0) ? (bx % 8) * (F.G / 8) + bx / 8 : bx; }
    volatile LAS unsigned* MISC = (volatile LAS unsigned*)(F.lds + MISC_OFF);
    for (int u = F.tid; u < 64; u += NWAVES * 64) MISC[u] = 0u;
    __syncthreads();
    XcdBarrier bar;
    { KArgs Ap = get_args(); bar = xcd_barrier_post((unsigned*)(Ap->ws + WS_CTL) + CW_BAR, MISC + 16); }
    LAS int* cntL = (LAS int*)(F.lds + MISC_OFF);
    LAS int* idxl = (LAS int*)(F.lds + IDX_OFF);

    int n_ts = 0;
#define STAMP() do { if (TS_A >= 0) { if (blockIdx.x == 0 && threadIdx.x == 0) { KArgs Ap_ = get_args(); ((unsigned long long*)(Ap_->ws + WS_SMALL + SM_TS))[n_ts] = __builtin_amdgcn_s_memrealtime(); } ++n_ts; } } while (0)
    STAMP();
#define REPS(k, cond) (((DUP == (k)) && (cond)) ? 2 : 1)
#pragma unroll 1
    for (int rep = 0; rep < REPS(1, true); ++rep) { { KArgs Ap = get_args(); p0_prologue(Ap, F); } xcd_barrier(bar); STAMP(); }
#pragma unroll 1
    for (int l = 0; l < 2; ++l) {
#pragma unroll 1
        for (int rep = 0; rep < REPS(2, l == 0); ++rep) { { KArgs Ap = get_args(); phase_n1(Ap, F, l); } xcd_barrier(bar); STAMP(); }
#pragma unroll 1
        for (int rep = 0; rep < REPS(3, true); ++rep) {
        {
            KArgs Ap = get_args(); unsigned char* ws = Ap->ws; const Frame Fp = fresh(F); int bx = (int)blockIdx.x; asm volatile("" : "+s"(bx));
            SchedInN S1{(const char*)(ws + WS_XN), (const char*)(ws + WS_WIN) + (size_t)l * IN_DIM * DM * 2, Fp.G, bx};
            EpiInN E1{(bf16_t*)(ws + WS_PU), (bf16_t*)(ws + WS_QF), Ap->q_norm + l * 512, Ap->k_norm + l * 512};
            pg8::gemm_phase<EpiInN, SchedInN, 2, false, 0>(Fp.lds, idxl, DM * 2, DM * 2, DM * 2, S1, E1);
        }
        {
            KArgs Ap = get_args(); unsigned char* ws = Ap->ws; const Frame Fp = fresh(F); int bx = (int)blockIdx.x; asm volatile("" : "+s"(bx));
            SchedInT S2{(const char*)(ws + WS_WIN) + (size_t)l * IN_DIM * DM * 2, (const char*)(ws + WS_XN), Fp.G, Fp.G - 1 - bx};
            EpiInT E2{(bf16_t*)(ws + WS_VF), (bf16_t*)(ws + WS_SGF), Ap->sg_norm + l * 256};
            pg8::gemm_phase<EpiInT, SchedInT, 1, false, 0>(Fp.lds, idxl, DM * 2, DM * 2, DM * 2, S2, E2);
        }
        if (l == 0) { KArgs Ap = get_args(); int bx = (int)blockIdx.x; asm volatile("" : "+s"(bx));
            if (F.G == 256 && !(bx >= 61 && bx < 134)) convert_fill_rank(Ap, F, bx < 61 ? bx : bx - 73, 183, CVG_P0, CVG_IN0);
            else if (F.G != 256) convert_fill_rank(Ap, F, bx, F.G, CVG_P0, CVG_IN0); }
        xcd_barrier(bar); STAMP();
        }
#pragma unroll 1
        for (int rep = 0; rep < REPS(4, true); ++rep) { { KArgs Ap = get_args(); phase_mix(Ap, F, l); } xcd_barrier(bar); STAMP(); }
#pragma unroll 1
        for (int rep = 0; rep < REPS(5, l == 0); ++rep) {
        {
            KArgs Ap = get_args(); unsigned char* ws = Ap->ws; const Frame Fp = fresh(F); int bx = (int)blockIdx.x; asm volatile("" : "+s"(bx));
            SchedOut S{(const char*)(ws + WS_MIX), (const char*)(ws + WS_WOUT) + (size_t)l * DM * DM * 2, Fp.G, bx, (l == 0) ? 65 : 64};
            EpiOut E{Ap->x, Ap->ctx, (bf16_t*)(ws + WS_HRES), modp(Ap, l, 0) + 2048, modp(Ap, l, 1) + 2048, l};
            pg8::gemm_phase<EpiOut, SchedOut, 1, false, 0>(Fp.lds, idxl, DM * 2, DM * 2, DM * 2, S, E);
        }
        if (l == 0) { KArgs Ap = get_args(); int bx = (int)blockIdx.x; asm volatile("" : "+s"(bx)); convert_fill(Ap, F, bx, 65 * 4, CVG_IN0, CVG_OUT0); }
        xcd_barrier(bar); STAMP();
        }
        if (DUP == 8) { { KArgs Ap = get_args(); phase_n2(Ap, F, l, true); } xcd_barrier(bar); STAMP(); }
        if (l == 0) { KArgs Ap = get_args(); requant_gu(Ap, F); }
        { KArgs Ap = get_args(); phase_n2(Ap, F, l); }
        xcd_barrier(bar); STAMP();
        { KArgs Ap = get_args(); moe_setup(Ap, F, l, cntL, idxl); }
#pragma unroll 1
        for (int rep = 0; rep < REPS(6, true); ++rep) {
        {
            KArgs Ap = get_args(); unsigned char* ws = Ap->ws; const Frame Fp = fresh(F); int bx = (int)blockIdx.x; asm volatile("" : "+s"(bx));
            SchedMoe S{(const char*)(ws + WS_XN), (const char*)(ws + WS_WGUQ) + (size_t)l * NEXP * 1024 * 1024, cntL, Fp.G, bx, (size_t)1024 * 1024, (size_t)256 * DM};
            EpiG1 E{(bf16_t*)(ws + WS_H), idxl, (const float*)(ws + WS_SMALL + SM_XS), (const float*)(ws + WS_SMALL + SM_WSGU) + (size_t)l * NEXP * 1024};
            pg8::gemm_phase<EpiG1, SchedMoe, 1, true, 1, true>(Fp.lds, idxl, DM, DM, DM, S, E);
        }
        if (l == 0) { KArgs Ap = get_args(); int bx = (int)blockIdx.x; asm volatile("" : "+s"(bx)); int tu = 0;
            for (int e = 0; e < NEXP; ++e) tu += ((cntL[e] + 255) >> 8) * 4;
            convert_fill(Ap, F, bx, tu, CVG_OUT0, CVG_G10); }
        xcd_barrier(bar); STAMP();
        }
#pragma unroll 1
        for (int rep = 0; rep < REPS(7, true); ++rep) {
        {
            KArgs Ap = get_args(); unsigned char* ws = Ap->ws; const Frame Fp = fresh(F); int bx = (int)blockIdx.x; asm volatile("" : "+s"(bx));
            SchedMoe S{(const char*)(ws + WS_H), (const char*)(ws + WS_WDN) + (size_t)l * NEXP * 1024 * 512 * 2, cntL, Fp.G, bx, (size_t)1024 * 512 * 2, (size_t)256 * DEXP * 2};
            EpiG2 E{(bf16_t*)(ws + WS_Y), idxl, (const float*)(ws + WS_GW), modp(Ap, l, 0) + 5120, modp(Ap, l, 1) + 5120};
            pg8::gemm_phase<EpiG2, SchedMoe, 1, true, 0>(Fp.lds, idxl, DEXP * 2, DEXP * 2, DEXP * 2, S, E);
        }
        if (l == 0) { KArgs Ap = get_args(); int bx = (int)blockIdx.x; asm volatile("" : "+s"(bx)); int tu = 0;
            for (int e = 0; e < NEXP; ++e) tu += ((cntL[e] + 255) >> 8) * 4;
            convert_fill(Ap, F, bx, tu, CVG_G10, CVG_END); }
        xcd_barrier(bar); STAMP();
        }
    }
    if (DUP == 9) { for (int rep = 0; rep < 16; ++rep) xcd_barrier(bar); STAMP(); }
    { KArgs Ap = get_args(); phase_final(Ap, F); }
    STAMP();
    if (TS_A >= 0) { KArgs Ap = get_args(); if (blockIdx.x == 0 && threadIdx.x == 0) { const unsigned long long* ts = (const unsigned long long*)(Ap->ws + WS_SMALL + SM_TS);
        asm volatile("s_waitcnt vmcnt(0)" ::: "memory"); Ap->out[0] = (float)(ts[TS_B < 0 ? 0 : TS_B] - ts[TS_A < 0 ? 0 : TS_A]) * 0.01f * TS_SCALE; } }
    { KArgs Ap = get_args(); if (blockIdx.x == 0 && threadIdx.x == 0) { const unsigned t = xb_ld((unsigned*)(Ap->ws + WS_CTL) + CW_BAR + XB_TMO); if (t != 0u) { asm volatile("s_waitcnt vmcnt(0)" ::: "memory"); Ap->out[5] = __builtin_nanf(""); } } }
}

extern "C" void kernel_launch(void* const* d_in, const int* in_sizes, int n_in, void* d_out, int out_size, void* d_ws, size_t ws_size, hipStream_t stream) {
    static int grid = 0;
    if (grid == 0) {
        if (n_in != 23 || out_size != NTOK * DM || ws_size < WS_END) { fprintf(stderr, "kernel_launch: unexpected sizes (n_in %d out %d ws %zu)\n", n_in, out_size, ws_size); grid = -1; return; }
        int dev = 0, cus = 0, per_cu = 0;
        if (hipGetDevice(&dev) != hipSuccess || hipDeviceGetAttribute(&cus, hipDeviceAttributeMultiprocessorCount, dev) != hipSuccess) { grid = -1; return; }
        if (hipFuncSetAttribute((const void*)fwd_megakernel, hipFuncAttributeMaxDynamicSharedMemorySize, LDS_BYTES) != hipSuccess) { fprintf(stderr, "kernel_launch: hipFuncSetAttribute failed\n"); grid = -1; return; }
        if (hipOccupancyMaxActiveBlocksPerMultiprocessor(&per_cu, (const void*)fwd_megakernel, NWAVES * 64, LDS_BYTES) != hipSuccess || per_cu < 1) { fprintf(stderr, "kernel_launch: occupancy query says %d\n", per_cu); (void)hipGetLastError(); grid = -1; return; }
        grid = cus;
        if (grid != 256) fprintf(stderr, "kernel_launch: %d CUs (built for 256)\n", grid);
    }
    if (grid < 0) return;
    (void)hipMemsetAsync((char*)d_ws + WS_CTL, 0, CTL_ZERO_BYTES, stream);
    Args a{};
    const float** ap = (const float**)&a;
    for (int i = 0; i < 23; ++i) ap[i] = (const float*)d_in[i];
    a.out = (float*)d_out; a.ws = (unsigned char*)d_ws;
    void* args[] = {&a};
    hipError_t e = hipLaunchCooperativeKernel((const void*)fwd_megakernel, dim3(grid), dim3(NWAVES * 64), args, LDS_BYTES, stream);
    if (e != hipSuccess) fprintf(stderr, "kernel_launch: cooperative launch failed: %s\n", hipGetErrorString(e));
}
```

```cpp
#include <hip/hip_runtime.h>
#include <cstdio>
#include <cstdint>

#ifndef DUP
#define DUP 0
#endif
#define TS_A -1
#define TS_B -1
#define TS_SCALE 1.0f
constexpr int NTOK = 16384, NCTX = 256, MROWS = NTOK + NCTX, DM = 1024, IN_DIM = 2304;
constexpr int NEXP = 16, DEXP = 512;
constexpr int PU_LD = 512;
constexpr int NBLK16 = MROWS / 16, NGRP32 = MROWS / 32, NCHUNK = MROWS / 128;
constexpr float EPS = 1e-6f;
constexpr float LOG2E = 1.4426950408889634f;

#define LAS __attribute__((address_space(3)))
#define GAS __attribute__((address_space(1)))
typedef unsigned short bf16_t;
typedef short bf16x8 __attribute__((ext_vector_type(8)));
typedef short bf16x4 __attribute__((ext_vector_type(4)));
typedef float f32x4 __attribute__((ext_vector_type(4)));
typedef float f32x2 __attribute__((ext_vector_type(2)));
typedef unsigned u32x4 __attribute__((ext_vector_type(4)));
typedef int i32x4 __attribute__((ext_vector_type(4)));
typedef unsigned u32x2 __attribute__((ext_vector_type(2)));

__device__ __forceinline__ unsigned cvt_pk_bf16_pin(float lo, float hi) { unsigned r; asm volatile("v_cvt_pk_bf16_f32 %0, %1, %2" : "=v"(r) : "v"(lo), "v"(hi)); return r; }
typedef __bf16 bf16x2_t __attribute__((ext_vector_type(2)));
__device__ __forceinline__ unsigned cvt_pk_bf16(float lo, float hi) { const f32x2 v = {lo, hi}; return __builtin_bit_cast(unsigned, __builtin_convertvector(v, bf16x2_t)); }
__device__ __forceinline__ float bf2f(unsigned short b) { return __builtin_bit_cast(float, (unsigned)b << 16); }
__device__ __forceinline__ f32x4 ld4bf(const bf16_t* p) { const bf16x4 a = *(const bf16x4*)p; return (f32x4){bf2f((unsigned short)a[0]), bf2f((unsigned short)a[1]), bf2f((unsigned short)a[2]), bf2f((unsigned short)a[3])}; }
#define BF2X4(w_) ((f32x4){__builtin_bit_cast(float, (w_).x << 16), __builtin_bit_cast(float, (w_).x & 0xffff0000u), __builtin_bit_cast(float, (w_).y << 16), __builtin_bit_cast(float, (w_).y & 0xffff0000u)})
__device__ __forceinline__ float gelu_tanh(float x) {
    const float y = x * (1.0f + 0.044715f * x * x);
    return x * __builtin_amdgcn_rcpf(1.0f + __builtin_amdgcn_exp2f(-2.3022082f * y));
}
__device__ __forceinline__ float silu_f(float x) { return x * __builtin_amdgcn_rcpf(1.0f + __builtin_amdgcn_exp2f(-LOG2E * x)); }
__device__ __forceinline__ float wave_sum(float v) {
#pragma unroll
    for (int o = 1; o < 64; o <<= 1) v += __shfl_xor(v, o);
    return v;
}

namespace pg8 {
constexpr int BM = 256, BK = 64, HALF = 128, HTB = HALF * BK * 2, STAGE_BYTES = 8 * HTB, NXCD = 8, WGM = 8;
__host__ __device__ __forceinline__ int lds_byte(int r, int c) { const int st = (r >> 4) * 2 + (c >> 5), rr = r & 15, cc = c & 31, ob = rr * 64 + cc * 2; return st * 1024 + (ob ^ (((ob >> 9) & 1) << 5)); }
__host__ __device__ __forceinline__ void stage_rc(int b, int& R, int& C) { const int st = b / 1024, sb = b % 1024, swz = sb ^ (((sb >> 9) & 1) << 5); R = (st >> 1) * 16 + swz / 64; C = (st & 1) * 32 + (swz % 64) / 2; }
__host__ __device__ __forceinline__ int perm32(int rho) { const int n = rho >> 4, i = rho & 15; return 8 * (i >> 2) + 4 * n + (i & 3); }

struct Unit { int pm, pn, e; };

__device__ __forceinline__ bool static_unit(int i, int G, int c, int nM, int nN, int& pm, int& pn) {
    const int nwg = nM * nN; const long L = (long)i * G + c; if (L >= nwg) return false;
    int wgid = (int)L; { const int q = nwg / NXCD, r = nwg % NXCD, xcd = wgid % NXCD, off = wgid / NXCD; wgid = (xcd < r ? xcd * (q + 1) : r * (q + 1) + (xcd - r) * q) + off; }
    const int nig = WGM * nN, gid = wgid / nig, fm = gid * WGM, gsz = (nM - fm) < WGM ? (nM - fm) : WGM;
    pm = fm + ((wgid % nig) % gsz); pn = (wgid % nig) / gsz; return true;
}

template <class Epi, class Sched, int BPERM, bool GATHER, int GSH, bool I8 = false, bool DQ = false>
__device__ __forceinline__ void gemm_phase(LAS unsigned char* lds, const LAS int* idxl, const int rbA, const int rbB, const int kbytes, const Sched& S, const Epi& E) {
    int tid_ = threadIdx.x; asm volatile("" : "+v"(tid_));
    const int tid = tid_, wid = __builtin_amdgcn_readfirstlane(tid >> 6), lane = tid & 63, wr = wid >> 2, wc = wid & 3, fr = lane & 15, fq = lane >> 4;
    const int nt = kbytes / 128;
    int R_[2], C_[2];
    unsigned voffA[2][2], voffB[2][2];
    const size_t hstepA = (size_t)HALF * (size_t)rbA, hstepB = (size_t)HALF * (size_t)rbB;
#pragma unroll
    for (int i = 0; i < 2; ++i) {
        stage_rc(tid * 16 + i * 8192, R_[i], C_[i]);
        const int R = R_[i], C = C_[i];
        voffA[0][i] = (unsigned)(R * rbA + C * 2); voffA[1][i] = 0u;
        if (BPERM == 2) {
#pragma unroll
            for (int bj = 0; bj < 2; ++bj) voffB[bj][i] = (unsigned)((64 * (R >> 5) + 32 * bj + perm32(R & 31)) * rbB + C * 2);
        } else {
            const int Rb = (BPERM == 1) ? ((R & ~31) + perm32(R & 31)) : R;
            voffB[0][i] = (unsigned)(Rb * rbB + C * 2); voffB[1][i] = 0u;
        }
    }
    const size_t kstep = (size_t)(BK * 2);
    const unsigned ldsw = (unsigned)wid * 1024u;
    const int aoff = lds_byte(wr * 64 + fr, fq * 8), boff = lds_byte(wc * 32 + fr, fq * 8);
#define PG8_SA(b, h) (((b) * 2 + (h)) * HTB)
#define PG8_SB(b, h) ((4 + (b) * 2 + (h)) * HTB)
#define PG8_STAGE(bufoff, gbase, voff) do { _Pragma("unroll") for (int _i = 0; _i < 2; ++_i) \
        __builtin_amdgcn_global_load_lds((const unsigned*)((const char*)(gbase) + (voff)[_i]), (LAS unsigned*)(lds + (bufoff) + ldsw + _i * 8192), 16, 0, 0); } while (0)
#define PG8_STA(bufoff, gbase, h) do { if (GATHER) PG8_STAGE(bufoff, gbase, voffA[h]); else PG8_STAGE(bufoff, (gbase) + (h) * hstepA, voffA[0]); } while (0)
#define PG8_STB(bufoff, gbase, h) do { if (BPERM == 2) PG8_STAGE(bufoff, gbase, voffB[h]); else PG8_STAGE(bufoff, (gbase) + (h) * hstepB, voffB[0]); } while (0)
#define PG8_GLOAD(u_) do { if (GATHER) { _Pragma("unroll") for (int _h = 0; _h < 2; ++_h) _Pragma("unroll") for (int _i = 0; _i < 2; ++_i) \
        voffA[_h][_i] = (unsigned)((((unsigned)idxl[(u_) * 256 + _h * 128 + R_[_i]] & 0x7fffffffu) >> GSH) * (unsigned)rbA + (unsigned)C_[_i] * 2u); } } while (0)
#define PG8_LDA(dst, b, h) do { _Pragma("unroll") for (int m = 0; m < 4; ++m) _Pragma("unroll") for (int k = 0; k < 2; ++k) dst[m][k] = *(const LAS bf16x8*)(lds + PG8_SA(b, h) + aoff + m * 2048 + k * 1024); } while (0)
#define PG8_LDB(dst, b, h) do { _Pragma("unroll") for (int n = 0; n < 2; ++n) _Pragma("unroll") for (int k = 0; k < 2; ++k) dst[n][k] = *(const LAS bf16x8*)(lds + PG8_SB(b, h) + boff + n * 2048 + k * 1024); } while (0)
#define PG8_MMA(ai, bj, At, Bt) do { __builtin_amdgcn_s_setprio(1); _Pragma("unroll") for (int m = 0; m < 4; ++m) _Pragma("unroll") for (int n = 0; n < 2; ++n) _Pragma("unroll") for (int k = 0; k < 2; ++k) { \
        if (I8) acc[ai][bj][m][n] = __builtin_bit_cast(f32x4, __builtin_amdgcn_mfma_i32_16x16x64_i8(__builtin_bit_cast(i32x4, Bt[n][k]), __builtin_bit_cast(i32x4, At[m][k]), __builtin_bit_cast(i32x4, acc[ai][bj][m][n]), 0, 0, 0)); \
        else acc[ai][bj][m][n] = __builtin_amdgcn_mfma_f32_16x16x32_bf16(Bt[n][k], At[m][k], acc[ai][bj][m][n], 0, 0, 0); } __builtin_amdgcn_s_setprio(0); } while (0)
#define PG8_WAIT_V(n) asm volatile("s_waitcnt vmcnt(" #n ")" ::: "memory")
#define PG8_WAIT_L(n) asm volatile("s_waitcnt lgkmcnt(" #n ")" ::: "memory")
#define PG8_BAR __builtin_amdgcn_s_barrier()
#define PG8_SCHED __builtin_amdgcn_sched_barrier(0)
    Unit cur, nxt; int ui = 0;
    if (!S.next(0, cur)) return;
    f32x4 acc[2][2][4][2];
#pragma unroll
    for (int a = 0; a < 2; ++a)
#pragma unroll
        for (int b = 0; b < 2; ++b)
#pragma unroll
            for (int m = 0; m < 4; ++m)
#pragma unroll
                for (int n = 0; n < 2; ++n) acc[a][b][m][n] = (f32x4){0.f, 0.f, 0.f, 0.f};
    bf16x8 At[4][2], B0[2][2], B1[2][2];
    const char* cA = S.a_base(cur); const char* cB = S.b_base(cur);
    PG8_GLOAD(0);
    PG8_STB(PG8_SB(0, 0), cB, 0); PG8_STB(PG8_SB(0, 1), cB, 1); PG8_STA(PG8_SA(0, 0), cA, 0); PG8_STA(PG8_SA(0, 1), cA, 1);
    if (wr == 1) PG8_BAR;
    PG8_WAIT_V(2); PG8_BAR;
    PG8_STB(PG8_SB(1, 0), cB + kstep, 0); PG8_STA(PG8_SA(1, 0), cA + kstep, 0); PG8_STB(PG8_SB(1, 1), cB + kstep, 1);
    PG8_WAIT_V(6); PG8_BAR;
    for (;;) {
        const bool has_next = S.next(ui + 1, nxt);
        const char* nA = has_next ? S.a_base(nxt) : cA; const char* nB = has_next ? S.b_base(nxt) : cB;
        for (int t = 0; t < nt; t += 2) {
            const bool last = (t == nt - 2);
            const char* a1 = cA + (size_t)(t + 1) * kstep;
            const char* a2 = last ? nA : cA + (size_t)(t + 2) * kstep; const char* b2 = last ? nB : cB + (size_t)(t + 2) * kstep;
            const char* a3 = a2 + kstep; const char* b3 = b2 + kstep;
            PG8_LDB(B0, 0, 0); PG8_LDB(B1, 0, 1); PG8_SCHED; PG8_LDA(At, 0, 0); PG8_STA(PG8_SA(1, 1), a1, 1);
            if (GATHER) { if (last && has_next) PG8_GLOAD(ui + 1); }
            PG8_WAIT_V(8); PG8_WAIT_L(0); PG8_BAR; PG8_MMA(0, 0, At, B0); PG8_MMA(0, 1, At, B1); PG8_BAR; PG8_SCHED;
            PG8_LDA(At, 0, 1); PG8_STB(PG8_SB(0, 0), b2, 0); PG8_STB(PG8_SB(0, 1), b2, 1); PG8_STA(PG8_SA(0, 0), a2, 0);
            PG8_WAIT_V(8); PG8_WAIT_L(0); PG8_BAR; PG8_MMA(1, 0, At, B0); PG8_MMA(1, 1, At, B1); PG8_BAR; PG8_SCHED;
            PG8_LDB(B0, 1, 0); PG8_LDB(B1, 1, 1); PG8_SCHED; PG8_LDA(At, 1, 0); PG8_STA(PG8_SA(0, 1), a2, 1);
            PG8_WAIT_V(8); PG8_WAIT_L(0); PG8_BAR; PG8_MMA(0, 0, At, B0); PG8_MMA(0, 1, At, B1); PG8_BAR; PG8_SCHED;
            PG8_LDA(At, 1, 1); PG8_STB(PG8_SB(1, 0), b3, 0); PG8_STB(PG8_SB(1, 1), b3, 1); PG8_STA(PG8_SA(1, 0), a3, 0);
            PG8_WAIT_V(8); PG8_WAIT_L(0); PG8_BAR; PG8_MMA(1, 0, At, B0); PG8_MMA(1, 1, At, B1); PG8_BAR; PG8_SCHED;
        }
        if (wr == 0) PG8_BAR;
        if constexpr (DQ) {
            const float* rsp = S.rs_base(cur) + wr * 64 + fr; const float* csp = S.cs_base(cur) + (BPERM == 2 ? 64 * wc : 32 * wc) + 8 * fq;
            f32x4 cs4[2][2];
#pragma unroll
            for (int bj = 0; bj < 2; ++bj)
#pragma unroll
                for (int n = 0; n < 2; ++n) cs4[bj][n] = *(const f32x4*)(csp + (BPERM == 2 ? 32 : 128) * bj + 4 * n);
#pragma unroll
            for (int ai = 0; ai < 2; ++ai)
#pragma unroll
                for (int m = 0; m < 4; ++m) { const float rsc = rsp[ai * 128 + m * 16];
#pragma unroll
                    for (int bj = 0; bj < 2; ++bj)
#pragma unroll
                        for (int n = 0; n < 2; ++n) { const i32x4 iv = __builtin_bit_cast(i32x4, acc[ai][bj][m][n]); acc[ai][bj][m][n] = __builtin_convertvector(iv, f32x4) * (cs4[bj][n] * rsc); } }
        }
        E(acc, cur, ui, wr, wc, fr, fq);
        if (!has_next) break;
#pragma unroll
        for (int a = 0; a < 2; ++a)
#pragma unroll
            for (int b = 0; b < 2; ++b)
#pragma unroll
                for (int m = 0; m < 4; ++m)
#pragma unroll
                    for (int n = 0; n < 2; ++n) acc[a][b][m][n] = (f32x4){0.f, 0.f, 0.f, 0.f};
        cur = nxt; cA = nA; cB = nB; ++ui;
        if (wr == 1) PG8_BAR;
    }
    PG8_WAIT_V(0);
    PG8_BAR;
#undef PG8_SA
#undef PG8_SB
#undef PG8_STAGE
#undef PG8_GLOAD
#undef PG8_STA
#undef PG8_STB
#undef PG8_LDA
#undef PG8_LDB
#undef PG8_MMA
#undef PG8_WAIT_V
#undef PG8_WAIT_L
#undef PG8_BAR
#undef PG8_SCHED
}
}

constexpr size_t MiB = 1u << 20;
constexpr size_t WS_CTL = 0, CTL_ZERO_BYTES = 65536;
constexpr size_t WS_SMALL = 1 * MiB;
constexpr size_t WS_LIST = 4 * MiB;
constexpr size_t WS_GW = 7 * MiB;
constexpr size_t WS_HCTX = 8 * MiB;
constexpr size_t WS_WIN = 10 * MiB;
constexpr size_t WS_WOUT = 19 * MiB;
constexpr size_t WS_WGU = 24 * MiB;
constexpr size_t WS_WDN = 88 * MiB;
constexpr size_t WS_XN = 120 * MiB;
constexpr size_t WS_PU = 153 * MiB;
constexpr size_t WS_QF = 170 * MiB, WS_KF = 187 * MiB, WS_VF = 204 * MiB;
constexpr size_t WS_SGF = 221 * MiB;
constexpr size_t WS_Y = WS_PU;
constexpr size_t WS_MIX = 230 * MiB;
constexpr size_t WS_H = WS_MIX;
constexpr size_t WS_HRES = 263 * MiB;
constexpr size_t WS_WGUQ = 296 * MiB;
constexpr size_t WS_END = 328 * MiB;
static_assert(WS_PU + (size_t)MROWS * PU_LD * 2 <= WS_QF && WS_QF + (size_t)MROWS * 512 * 2 <= WS_KF && WS_KF + (size_t)MROWS * 512 * 2 <= WS_VF && WS_VF + (size_t)MROWS * 512 * 2 <= WS_SGF && WS_SGF + (size_t)MROWS * 256 * 2 <= WS_MIX, "ws map");
static_assert(WS_Y + (size_t)2 * MROWS * DM * 2 <= WS_MIX && WS_MIX + (size_t)MROWS * DM * 2 <= WS_HRES && WS_HRES + (size_t)MROWS * DM * 2 <= WS_END && WS_XN + (size_t)MROWS * DM * 2 <= WS_PU && WS_WDN + (size_t)2 * 16 * 1024 * 512 * 2 <= WS_XN && WS_WGU + (size_t)2 * 16 * 1024 * 1024 * 2 <= WS_WDN, "ws map 2");
constexpr int CW_BAR = 4096;
constexpr int CW_CNT = 8192;
constexpr int CW_MOD = 16384;
static_assert(CW_MOD * 4 >= (int)CTL_ZERO_BYTES && (CW_CNT + 32) * 4 <= (int)CTL_ZERO_BYTES && (CW_MOD + 4 * 6144) * 4 <= (int)(1 * MiB), "ctl");
constexpr size_t SM_SGW = 0;
constexpr size_t SM_POOLT = 256 * 1024;
constexpr size_t SM_B2 = 320 * 1024;
constexpr size_t SM_TS = 324 * 1024;
constexpr size_t SM_C0 = 328 * 1024;
constexpr size_t SM_TMAXGU = 512 * 1024;
constexpr size_t SM_WSGU = 2688 * 1024;
constexpr size_t WS_WINQ = WS_XN + 20 * MiB;
constexpr size_t WS_TMAXIN = WS_HCTX;
constexpr size_t WS_WSIN = WS_HCTX + 512 * 1024;
constexpr size_t SM_XS = 2944 * 1024;
constexpr int LIST_CAP = 2 * MROWS;

constexpr int RING_BYTES = 131072;
constexpr int IDX_OFF = RING_BYTES;
constexpr int MISC_OFF = IDX_OFF + 8192;
constexpr int LDS_BYTES = 147456;
constexpr int NWAVES = 8;

#define XB_TMO      128
#define XB_XCNT(j)  (256  + 64 * (j))
#define XB_XSUB(j)  (1280 + 64 * (j))
#define XB_XGEN(j)  (2304 + 64 * (j))
#define XB_TOP      3328
#define XB_TOPGEN   3392
#define XCD_BAR_WORDS 3456
#define XB_SPIN_CAP (1u << 18)
__device__ __forceinline__ unsigned xb_ld(unsigned* p)              { return __hip_atomic_load(p, __ATOMIC_RELAXED, __HIP_MEMORY_SCOPE_AGENT); }
__device__ __forceinline__ unsigned xb_add(unsigned* p, unsigned v) { return __hip_atomic_fetch_add(p, v, __ATOMIC_RELAXED, __HIP_MEMORY_SCOPE_AGENT); }
__device__ __forceinline__ unsigned xb_xcc_id() { return (unsigned)__builtin_amdgcn_s_getreg((3 << 11) | 20) & 0xFu; }
#define XB_SPIN(cond, bar) do { unsigned _sp = 0; while (cond) { __builtin_amdgcn_s_sleep(1); \
    if ((++_sp & 255u) == 0u) { if (xb_ld(&(bar)[XB_TMO])) break; if (_sp > XB_SPIN_CAP) { atomicAdd(&(bar)[XB_TMO], 1u); break; } } } } while (0)
struct XcdBarrier { unsigned* bar; unsigned x; volatile LAS unsigned* st; };
__device__ __forceinline__ XcdBarrier xcd_barrier_post(unsigned* bar, volatile LAS unsigned* st) {
    XcdBarrier b; b.bar = bar; b.x = xb_xcc_id(); b.st = st;
    if (threadIdx.x == 0) (void)xb_add(&bar[XB_XCNT(b.x)], 1u);
    return b;
}
__device__ __forceinline__ void xcd_barrier_complete(unsigned* bar, unsigned x, unsigned& nloc, unsigned& nx) {
    const unsigned G = gridDim.x * gridDim.y * gridDim.z;
    unsigned sum, cnt, mine, sp = 0u;
    for (;;) {
        sum = 0u; cnt = 0u; mine = 0u;
#pragma unroll
        for (unsigned j = 0; j < 16; ++j) { const unsigned c = xb_ld(&bar[XB_XCNT(j)]); sum += c; cnt += (c > 0u) ? 1u : 0u; mine = (j == x) ? c : mine; }
        if (sum == G) break;
        __builtin_amdgcn_s_sleep(1);
        if ((++sp & 255u) == 0u) { if (xb_ld(&bar[XB_TMO])) break; if (sp > XB_SPIN_CAP) { atomicAdd(&bar[XB_TMO], 1u); break; } }
    }
    nloc = mine > 0u ? mine : 1u; nx = cnt > 0u ? cnt : 1u;
}
__device__ __forceinline__ void xcd_barrier(const XcdBarrier& b) {
    asm volatile("s_waitcnt vmcnt(0)" ::: "memory");
    __syncthreads();
    if (threadIdx.x == 0) {
        unsigned* bar = b.bar;
        __builtin_amdgcn_s_waitcnt(0);
        unsigned nloc = b.st[0], nx = b.st[1];
        if (nloc == 0u) { xcd_barrier_complete(bar, b.x, nloc, nx); b.st[0] = nloc; b.st[1] = nx; }
        const unsigned old = xb_add(&bar[XB_XSUB(b.x)], 1u);
        const unsigned gen = old / nloc;
        if (old + 1u == (gen + 1u) * nloc) {
            __builtin_amdgcn_fence(__ATOMIC_RELEASE, "agent");
            asm volatile("s_waitcnt vmcnt(0)" ::: "memory");
            const unsigned og = xb_add(&bar[XB_TOP], 1u);
            const unsigned tg = og / nx;
            if (og + 1u == (tg + 1u) * nx) xb_add(&bar[XB_TOPGEN], 1u);
            else XB_SPIN(xb_ld(&bar[XB_TOPGEN]) == tg, bar);
            __builtin_amdgcn_fence(__ATOMIC_ACQUIRE, "agent");
            xb_add(&bar[XB_XGEN(b.x)], 1u);
            asm volatile("s_waitcnt vmcnt(0)" ::: "memory");
        } else {
            XB_SPIN(xb_ld(&bar[XB_XGEN(b.x)]) == gen, bar);
            __builtin_amdgcn_fence(__ATOMIC_ACQUIRE, "agent");
            asm volatile("s_waitcnt vmcnt(0)" ::: "memory");
        }
    }
    __syncthreads();
}

struct Args {
    const float *x, *c, *ctx, *c_ctx, *w_ada, *b_ada, *norm1, *w_in, *pool_w, *pool_scale, *q_norm, *k_norm, *rpb, *sg_w, *sg_b, *sg_norm, *w_out, *norm2, *w_router, *b_router, *w_gate, *w_up, *w_down;
    float* out; unsigned char* ws;
};
struct Frame {
    LAS unsigned char* lds;
    int tid, lane, wave, vcu, G;
};
__device__ __forceinline__ Frame fresh(const Frame& F0) { Frame F = F0; asm volatile("" : "+v"(F.tid), "+v"(F.lane), "+s"(F.wave), "+s"(F.vcu), "+s"(F.G)); return F; }
typedef const __attribute__((address_space(4))) Args* KArgs;
__device__ __forceinline__ KArgs get_args() { KArgs p = (KArgs)__builtin_amdgcn_kernarg_segment_ptr(); asm volatile("" : "+s"(p)); return p; }

__device__ __forceinline__ unsigned f2bf(float f) { unsigned u = __builtin_bit_cast(unsigned, f); return (u + 0x7fffu + ((u >> 16) & 1u)) >> 16; }
__device__ __forceinline__ unsigned pk2(float lo, float hi) { return f2bf(lo) | (f2bf(hi) << 16); }
struct CvItem { const float* src; bf16_t* dst; int N, Kd; float* tmax; };
__device__ __forceinline__ void cv_load(const CvItem& c, float (&tv)[32], int lane) {
#pragma unroll
    for (int i = 0; i < 32; ++i) tv[i] = c.src[(size_t)(2 * i + (lane >> 5)) * c.N + (lane & 31)];
}
__device__ __forceinline__ void cv_finish(const CvItem& c, const float (&tv)[32], LAS float* scr, int lane) {
    if (c.tmax) { float m = 0.f;
#pragma unroll
        for (int i = 0; i < 32; ++i) m = fmaxf(m, fabsf(tv[i]));
        m = fmaxf(m, __shfl_xor(m, 32));
        if (lane < 32) c.tmax[lane * 16] = m; }
#pragma unroll
    for (int i = 0; i < 32; ++i) scr[(2 * i + (lane >> 5)) * 33 + (lane & 31)] = tv[i];
    asm volatile("s_waitcnt lgkmcnt(0)" ::: "memory");
    const int cc = lane & 7;
#pragma unroll
    for (int j = 0; j < 4; ++j) { const int n = (lane >> 3) + 8 * j; const LAS float* sp = scr + (8 * cc) * 33 + n;
        u32x4 o; o.x = pk2(sp[0 * 33], sp[1 * 33]); o.y = pk2(sp[2 * 33], sp[3 * 33]); o.z = pk2(sp[4 * 33], sp[5 * 33]); o.w = pk2(sp[6 * 33], sp[7 * 33]);
        *(u32x4*)(c.dst + (size_t)n * c.Kd + 8 * cc) = o; }
    asm volatile("s_waitcnt lgkmcnt(0)" ::: "memory");
}
__device__ __forceinline__ int win_dst_row(int n) { return n < 1280 ? n : (n < 1792 ? 1536 + (n - 1280) : (n < 2048 ? 1280 + (n - 1792) : n)); }

constexpr int CV_I_IN = 16 * 72, CV_I_OUT = 16 * 32, CV_I_G = 16 * 16, CV_I_D = 8 * 32;
constexpr int CV_IO = CV_I_IN + CV_I_OUT, CV_PER_L = CV_IO + 16 * (2 * CV_I_G + CV_I_D);
__device__ __forceinline__ CvItem cv_decode(KArgs Ap, int l, int r) {
    unsigned char* ws = Ap->ws; CvItem c; c.tmax = nullptr;
    if (r < CV_I_IN) { const int kb = r / 72, nb = r % 72;
        c.src = Ap->w_in + (size_t)l * DM * IN_DIM + (size_t)(kb * 64) * IN_DIM + nb * 32; c.N = IN_DIM; c.Kd = DM;
        c.dst = (bf16_t*)(ws + WS_WIN) + (size_t)l * IN_DIM * DM + (size_t)win_dst_row(nb * 32) * DM + kb * 64;
        c.tmax = (float*)(ws + WS_TMAXIN) + ((size_t)l * IN_DIM + win_dst_row(nb * 32)) * 16 + kb; return c; }
    r -= CV_I_IN;
    if (r < CV_I_OUT) { const int kb = r / 32, nb = r % 32;
        c.src = Ap->w_out + (size_t)l * DM * DM + (size_t)(kb * 64) * DM + nb * 32; c.N = DM; c.Kd = DM;
        c.dst = (bf16_t*)(ws + WS_WOUT) + (size_t)l * DM * DM + (size_t)(nb * 32) * DM + kb * 64; return c; }
    r -= CV_I_OUT;
    const int e = r / (2 * CV_I_G + CV_I_D); r = r % (2 * CV_I_G + CV_I_D);
    if (r < 2 * CV_I_G) { const int up = r / CV_I_G; r = r % CV_I_G; const int kb = r / 16, nb = r % 16; const int j0 = nb * 32;
        c.src = (up ? Ap->w_up : Ap->w_gate) + ((size_t)l * NEXP + e) * DM * DEXP + (size_t)(kb * 64) * DEXP + j0; c.N = DEXP; c.Kd = DM;
        const int drow0 = (j0 >> 7) * 256 + (j0 & 127) + (up ? 128 : 0);
        c.dst = (bf16_t*)(ws + WS_WGU) + ((size_t)l * NEXP + e) * 1024 * 1024 + (size_t)drow0 * DM + kb * 64;
        c.tmax = (float*)(ws + WS_SMALL + SM_TMAXGU) + (((size_t)l * NEXP + e) * 1024 + drow0) * 16 + kb; return c; }
    r -= 2 * CV_I_G;
    { const int kb = r / 32, nb = r % 32;
        c.src = Ap->w_down + ((size_t)l * NEXP + e) * DEXP * DM + (size_t)(kb * 64) * DM + nb * 32; c.N = DM; c.Kd = DEXP;
        c.dst = (bf16_t*)(ws + WS_WDN) + ((size_t)l * NEXP + e) * 1024 * 512 + (size_t)(nb * 32) * DEXP + kb * 64; return c; }
}
__device__ __forceinline__ CvItem cv_decode_g(KArgs Ap, int g) { const int l = (g >= CV_PER_L) ? 1 : 0; return cv_decode(Ap, l, g - l * CV_PER_L); }
__device__ __forceinline__ void convert_stream(KArgs Ap, int first, int step, int end, LAS float* scr, int lane) {
    if (first >= end) return;
    float tvA[32], tvB[32];
    CvItem ca = cv_decode_g(Ap, first), cb = ca;
    cv_load(ca, tvA, lane);
    for (int it = first; it < end; it += 2 * step) {
        const bool hb = it + step < end;
        if (hb) { cb = cv_decode_g(Ap, it + step); cv_load(cb, tvB, lane); }
        cv_finish(ca, tvA, scr, lane);
        if (!hb) break;
        const bool ha = it + 2 * step < end;
        if (ha) { ca = cv_decode_g(Ap, it + 2 * step); cv_load(ca, tvA, lane); }
        cv_finish(cb, tvB, scr, lane);
    }
}
constexpr int CVG_P0 = CV_IO;
constexpr int CVG_IN0 = CVG_P0 + 4700;
constexpr int CVG_OUT0 = 2 * CV_PER_L;
constexpr int CVG_G10 = 2 * CV_PER_L;
constexpr int CVG_END = 2 * CV_PER_L;
__device__ __forceinline__ void convert_fill_rank(KArgs Ap, const Frame& F0, int rank, int nfill, int lo, int hi) {
    const Frame F = fresh(F0);
    LAS float* scr = (LAS float*)(F.lds + F.wave * 16384);
    convert_stream(Ap, lo + rank * NWAVES + F.wave, nfill * NWAVES, hi, scr, F.lane);
}
__device__ __forceinline__ void convert_fill(KArgs Ap, const Frame& F0, int bx, int total_units, int lo, int hi) {
    const int G = F0.G, maxu = (total_units + G - 1) / G, nbig = total_units - (maxu - 1) * G;
    if (G - nbig >= G / 2) { if (bx >= nbig) convert_fill_rank(Ap, F0, bx - nbig, G - nbig, lo, hi); }
    else convert_fill_rank(Ap, F0, bx, G, lo, hi);
}
__device__ __forceinline__ void p0_prologue(KArgs Ap, const Frame& F0) {
    const Frame F = fresh(F0);
    unsigned char* ws = Ap->ws;
    LAS float* scr = (LAS float*)(F.lds + F.wave * 16384);
    const int gw = F.vcu * NWAVES + F.wave, NGW = F.G * NWAVES;
    const int lane = F.lane;
    float* mod = (float*)(ws + WS_CTL) + CW_MOD;
    for (int it = F.wave * F.G + F.vcu; it < 2 * 24 * 8; it += NGW) {
        const int l = it / (24 * 8), r = it % (24 * 8), nb = r / 8, sb = r % 8;
        const int kq = lane >> 3, c4 = (lane & 7) * 4;
        const float* W = Ap->w_ada + (size_t)l * DM * 6144 + nb * 256 + sb * 32 + c4;
        f32x4 a0 = (f32x4){0.f, 0.f, 0.f, 0.f}, a1 = a0;
#pragma unroll 1
        for (int k0 = kq; k0 < DM; k0 += 8 * 16) {
            f32x4 w[16];
#pragma unroll
            for (int u = 0; u < 16; ++u) w[u] = *(const f32x4*)(W + (size_t)(k0 + 8 * u) * 6144);
#pragma unroll
            for (int u = 0; u < 16; ++u) { const float c0 = silu_f(Ap->c[k0 + 8 * u]), c1 = silu_f(Ap->c_ctx[k0 + 8 * u]); a0 += w[u] * c0; a1 += w[u] * c1; }
        }
#pragma unroll
        for (int j = 0; j < 4; ++j) { float x0 = a0[j], x1 = a1[j];
            x0 += __shfl_xor(x0, 8); x0 += __shfl_xor(x0, 16); x0 += __shfl_xor(x0, 32); x1 += __shfl_xor(x1, 8); x1 += __shfl_xor(x1, 16); x1 += __shfl_xor(x1, 32); a0[j] = x0; a1[j] = x1; }
        if (kq == 0) { const f32x4 b = *(const f32x4*)(Ap->b_ada + l * 6144 + nb * 256 + sb * 32 + c4);
            *(f32x4*)(mod + (l * 2 + 0) * 6144 + nb * 256 + sb * 32 + c4) = a0 + b; *(f32x4*)(mod + (l * 2 + 1) * 6144 + nb * 256 + sb * 32 + c4) = a1 + b; }
    }
    convert_stream(Ap, gw, NGW, CVG_P0, scr, lane);
    const int gt = F.vcu * NWAVES * 64 + F.tid, NGT = F.G * NWAVES * 64;
    bf16_t* sgw = (bf16_t*)(ws + WS_SMALL + SM_SGW);
    for (int i = gt; i < 2 * 4 * 128 * 128; i += NGT) { const int j8 = i & 7, ln = (i >> 3) & 63, ss = (i >> 9) & 3, pb = (i >> 11) & 7, lh = i >> 14;
        sgw[i] = (bf16_t)f2bf(Ap->sg_w[(size_t)lh * 16384 + (16 * pb + (ln & 15)) * 128 + 32 * ss + 8 * (ln >> 4) + j8]); }
    bf16_t* poolt = (bf16_t*)(ws + WS_SMALL + SM_POOLT);
    for (int i = gt; i < 2 * 4 * 64 * 64; i += NGT) { const int lg = i >> 12, d = (i >> 6) & 63, c = i & 63; poolt[i] = (bf16_t)f2bf(Ap->pool_w[(lg << 12) + c * 64 + d]); }
    if (gw < 16) {
        const int l = gw >> 3, h = gw & 7;
        float mq = fabsf(Ap->q_norm[(l * 8 + h) * 64 + lane]), mk = fabsf(Ap->k_norm[(l * 8 + h) * 64 + lane]), mb = 0.f;
        for (int i = lane; i < 15 * 31; i += 64) mb = fmaxf(mb, fabsf(Ap->rpb[(l * 8 + h) * 465 + i]));
#pragma unroll
        for (int o = 1; o < 64; o <<= 1) { mq = fmaxf(mq, __shfl_xor(mq, o)); mk = fmaxf(mk, __shfl_xor(mk, o)); mb = fmaxf(mb, __shfl_xor(mb, o)); }
        if (lane == 0) ((float*)(ws + WS_SMALL + SM_B2))[gw] = LOG2E * (8.0f * mq * mk + mb);
    }
}

__device__ __forceinline__ void requant_rows(const unsigned char* W, const float* tm, float* wsc, unsigned char* Q, int nrows, int gw, int NGW, int lane) {
    for (int R = gw; R < nrows; R += NGW) {
        const u32x4 a = *(const u32x4*)(W + (size_t)R * 2048 + lane * 32), b = *(const u32x4*)(W + (size_t)R * 2048 + lane * 32 + 16);
        float m = (lane < 16) ? tm[(size_t)R * 16 + lane] : 0.f;
#pragma unroll
        for (int o = 1; o < 16; o <<= 1) m = fmaxf(m, __shfl_xor(m, o));
        m = __shfl(m, 0);
        const float inv = (m > 0.f) ? 127.0f / m : 0.f;
        const unsigned w16[8] = {a.x, a.y, a.z, a.w, b.x, b.y, b.z, b.w}; u32x4 o4; unsigned* op = (unsigned*)&o4;
#pragma unroll
        for (int q = 0; q < 4; ++q) { unsigned pk = 0;
#pragma unroll
            for (int e2 = 0; e2 < 2; ++e2) { const unsigned w = w16[2 * q + e2];
                const int q0 = max(-127, min(127, (int)rintf(__builtin_bit_cast(float, w << 16) * inv))), q1 = max(-127, min(127, (int)rintf(__builtin_bit_cast(float, w & 0xffff0000u) * inv)));
                pk |= ((unsigned)(q0 & 255) << (16 * e2)) | ((unsigned)(q1 & 255) << (16 * e2 + 8)); }
            op[q] = pk; }
        *(u32x4*)(Q + (size_t)R * 1024 + lane * 16) = o4;
        if (lane == 0) wsc[R] = m * (1.0f / 127.0f);
    }
}
__device__ __forceinline__ void requant_gu(KArgs Ap, const Frame& F0) {
    const Frame F = fresh(F0);
    requant_rows(Ap->ws + WS_WGU, (const float*)(Ap->ws + WS_SMALL + SM_TMAXGU), (float*)(Ap->ws + WS_SMALL + SM_WSGU), Ap->ws + WS_WGUQ, 2 * NEXP * 1024, F.vcu * NWAVES + F.wave, F.G * NWAVES, F.lane);
}
__device__ __forceinline__ const float* modp(KArgs Ap, int l, int cls) { return (const float*)(Ap->ws + WS_CTL) + CW_MOD + (l * 2 + cls) * 6144; }

__device__ __forceinline__ void phase_n1(KArgs Ap, const Frame& F0, int l) {
    const Frame F = fresh(F0);
    const int gw = F.vcu * NWAVES + F.wave, NGW = F.G * NWAVES, lane = F.lane;
    unsigned char* XN = Ap->ws + WS_XN; const bf16_t* Y = (const bf16_t*)(Ap->ws + WS_Y);
    bf16_t* HR = (bf16_t*)(Ap->ws + WS_HRES);
    requant_rows(Ap->ws + WS_WIN + (size_t)l * IN_DIM * DM * 2, (const float*)(Ap->ws + WS_TMAXIN) + (size_t)l * IN_DIM * 16, (float*)(Ap->ws + WS_WSIN) + l * IN_DIM,
                 Ap->ws + WS_WINQ + (size_t)l * IN_DIM * DM, IN_DIM, gw, NGW, lane);
    f32x4 xc[4], xn[4]; u32x2 hc[4], y0c[4], y1c[4], hn_[4], y0n[4], y1n[4];
#define N1_LOAD(row_, X, H, Y0, Y1) do { const int r_ = (row_); if (l == 0) { const float* src_ = (r_ >= NTOK) ? Ap->ctx + (size_t)(r_ - NTOK) * DM : Ap->x + (size_t)r_ * DM; \
        _Pragma("unroll") for (int j_ = 0; j_ < 4; ++j_) X[j_] = *(const f32x4*)(src_ + lane * 4 + 256 * j_); } else { \
        _Pragma("unroll") for (int j_ = 0; j_ < 4; ++j_) { H[j_] = *(const u32x2*)(HR + (size_t)r_ * DM + lane * 4 + 256 * j_); Y0[j_] = *(const u32x2*)(Y + (size_t)(2 * r_) * DM + lane * 4 + 256 * j_); Y1[j_] = *(const u32x2*)(Y + (size_t)(2 * r_ + 1) * DM + lane * 4 + 256 * j_); } } } while (0)
    if (gw < MROWS) N1_LOAD(gw, xc, hc, y0c, y1c);
#pragma unroll 1
    for (int row = gw; row < MROWS; row += NGW) {
        const int cls = row >= NTOK;
        const bool hnx = row + NGW < MROWS;
        if (hnx) N1_LOAD(row + NGW, xn, hn_, y0n, y1n);
        f32x4 v[4]; float ss = 0.f;
        if (l == 0) {
#pragma unroll
            for (int j = 0; j < 4; ++j) v[j] = xc[j];
        } else {
            bf16_t* hr = HR + (size_t)row * DM;
#pragma unroll
            for (int j = 0; j < 4; ++j) {
                v[j] = BF2X4(hc[j]) + BF2X4(y0c[j]) + BF2X4(y1c[j]);
                u32x2 w; w.x = cvt_pk_bf16(v[j].x, v[j].y); w.y = cvt_pk_bf16(v[j].z, v[j].w);
                *(u32x2*)(hr + lane * 4 + 256 * j) = w;
                v[j] = BF2X4(w);
            }
        }
#pragma unroll
        for (int j = 0; j < 4; ++j) ss += (v[j].x * v[j].x + v[j].y * v[j].y) + (v[j].z * v[j].z + v[j].w * v[j].w);
        const float r = 1.0f / sqrtf(wave_sum(ss) * (1.0f / DM) + EPS);
        const float* md = modp(Ap, l, cls);
        f32x4 hq[4]; float mx = 0.f;
#pragma unroll
        for (int j = 0; j < 4; ++j) {
            const int k = lane * 4 + 256 * j;
            const f32x4 nw = *(const f32x4*)(Ap->norm1 + l * DM + k), sh = *(const f32x4*)(md + k), sc = *(const f32x4*)(md + 1024 + k);
            hq[j] = v[j] * r * nw * (sc + 1.0f) + sh;
            mx = fmaxf(fmaxf(mx, fmaxf(fabsf(hq[j].x), fabsf(hq[j].y))), fmaxf(fabsf(hq[j].z), fabsf(hq[j].w)));
        }
        {
#pragma unroll
            for (int o = 1; o < 64; o <<= 1) mx = fmaxf(mx, __shfl_xor(mx, o));
            const float inv = (mx > 0.f) ? 127.0f / mx : 0.f;
#pragma unroll
            for (int j = 0; j < 4; ++j) { unsigned pk = 0;
#pragma unroll
                for (int q = 0; q < 4; ++q) pk |= (unsigned)(max(-127, min(127, (int)rintf(hq[j][q] * inv))) & 255) << (8 * q);
                *(unsigned*)(XN + (size_t)row * DM + lane * 4 + 256 * j) = pk; }
            if (lane == 0) ((float*)(Ap->ws + WS_SMALL + SM_XS))[row] = mx * (1.0f / 127.0f);
        }
#pragma unroll
        for (int j = 0; j < 4; ++j) { xc[j] = xn[j]; hc[j] = hn_[j]; y0c[j] = y0n[j]; y1c[j] = y1n[j]; }
    }
#undef N1_LOAD
}
__device__ __forceinline__ void phase_final(KArgs Ap, const Frame& F0) {
    const Frame F = fresh(F0);
    const int gw = F.vcu * NWAVES + F.wave, NGW = F.G * NWAVES, lane = F.lane;
    const bf16_t* Y = (const bf16_t*)(Ap->ws + WS_Y);
    const bf16_t* HR = (const bf16_t*)(Ap->ws + WS_HRES);
    u32x2 hc[4], y0c[4], y1c[4], hn_[4], y0n[4], y1n[4];
#define FN_LOAD(row_, H, Y0, Y1) do { const int r_ = (row_); _Pragma("unroll") for (int j_ = 0; j_ < 4; ++j_) { H[j_] = *(const u32x2*)(HR + (size_t)r_ * DM + lane * 4 + 256 * j_); \
        Y0[j_] = *(const u32x2*)(Y + (size_t)(2 * r_) * DM + lane * 4 + 256 * j_); Y1[j_] = *(const u32x2*)(Y + (size_t)(2 * r_ + 1) * DM + lane * 4 + 256 * j_); } } while (0)
    if (gw < NTOK) FN_LOAD(gw, hc, y0c, y1c);
#pragma unroll 1
    for (int row = gw; row < NTOK; row += NGW) {
        if (row + NGW < NTOK) FN_LOAD(row + NGW, hn_, y0n, y1n);
        float* dst = Ap->out + (size_t)row * DM;
#pragma unroll
        for (int j = 0; j < 4; ++j) *(f32x4*)(dst + lane * 4 + 256 * j) = BF2X4(hc[j]) + BF2X4(y0c[j]) + BF2X4(y1c[j]);
#pragma unroll
        for (int j = 0; j < 4; ++j) { hc[j] = hn_[j]; y0c[j] = y0n[j]; y1c[j] = y1n[j]; }
    }
#undef FN_LOAD
}

__device__ __forceinline__ void route_row(float (&lg)[16], const int row, const int lane, const float* brt, LAS int* cntL, LAS int* listL, float* gwt) {
    const bool hi5 = lane & 32, hi4 = lane & 16, hi3 = lane & 8, hi2 = lane & 4;
    float w8[8], w4[4], w2[2], val;
#pragma unroll
    for (int i = 0; i < 8; ++i) { const float send = hi5 ? lg[i] : lg[i + 8], keep = hi5 ? lg[i + 8] : lg[i]; w8[i] = keep + __shfl_xor(send, 32); }
#pragma unroll
    for (int i = 0; i < 4; ++i) { const float send = hi4 ? w8[i] : w8[i + 4], keep = hi4 ? w8[i + 4] : w8[i]; w4[i] = keep + __shfl_xor(send, 16); }
#pragma unroll
    for (int i = 0; i < 2; ++i) { const float send = hi3 ? w4[i] : w4[i + 2], keep = hi3 ? w4[i + 2] : w4[i]; w2[i] = keep + __shfl_xor(send, 8); }
    { const float send = hi2 ? w2[0] : w2[1], keep = hi2 ? w2[1] : w2[0]; val = keep + __shfl_xor(send, 4); }
    val += __shfl_xor(val, 1); val += __shfl_xor(val, 2);
    const int e = (lane >> 2) & 15, grp = lane >> 4;
    val += brt[e];
    float mx = val; mx = fmaxf(mx, __shfl_xor(mx, 4)); mx = fmaxf(mx, __shfl_xor(mx, 8)); mx = fmaxf(mx, __shfl_xor(mx, 16)); mx = fmaxf(mx, __shfl_xor(mx, 32));
    const float p = __expf(val - mx);
    const float o1 = __shfl_xor(p, 4), o2 = __shfl_xor(p, 8), o3 = __shfl_xor(p, 12);
    const float h1 = fmaxf(p, o1), l1 = fminf(p, o1), h2 = fmaxf(o2, o3), l2 = fminf(o2, o3);
    const float gs = fmaxf(h1, h2) + fmaxf(fminf(h1, h2), fmaxf(l1, l2));
    float bv = gs; int bk = grp;
    { const float ov = __shfl_xor(bv, 16); const int ok = __shfl_xor(bk, 16); if (ov > bv || (ov == bv && ok < bk)) { bv = ov; bk = ok; } }
    { const float ov = __shfl_xor(bv, 32); const int ok = __shfl_xor(bk, 32); if (ov > bv || (ov == bv && ok < bk)) { bv = ov; bk = ok; } }
    const int rank = ((o1 > p || (o1 == p && (e ^ 1) < e)) ? 1 : 0) + ((o2 > p || (o2 == p && (e ^ 2) < e)) ? 1 : 0) + ((o3 > p || (o3 == p && (e ^ 3) < e)) ? 1 : 0);
    if (bk == grp && rank < 2 && (lane & 3) == 0) {
        const int ent = 2 * row + rank;
        const int pos = __hip_atomic_fetch_add(cntL + e, 1, __ATOMIC_RELAXED, __HIP_MEMORY_SCOPE_WORKGROUP);
        listL[e * 136 + pos] = ent; gwt[ent] = p / gs;
    }
}
__device__ __forceinline__ void phase_n2(KArgs Ap, const Frame& F0, int l, bool dry = false) {
    const Frame F = fresh(F0);
    const int lane = F.lane, gw = F.vcu * NWAVES + F.wave, NGW = F.G * NWAVES;
    bf16_t* XN = (bf16_t*)(Ap->ws + WS_XN); const bf16_t* HR = (const bf16_t*)(Ap->ws + WS_HRES);
    LAS float* Wl = (LAS float*)(F.lds);
    LAS int* cntL = (LAS int*)(F.lds + 81920);
    LAS int* baseL = cntL + 16;
    LAS int* listL = cntL + 32;
    int* glist = (int*)(Ap->ws + WS_LIST); float* gwt = (float*)(Ap->ws + WS_GW);
    unsigned* gcnt = (unsigned*)(Ap->ws + WS_CTL) + CW_CNT + l * 16;
    const int nrows = (l == 0) ? MROWS : NTOK;
    if (F.tid < 16) cntL[F.tid] = 0;
    {
        f32x4 wt[8];
#pragma unroll
        for (int i = 0; i < 8; ++i) wt[i] = *(const f32x4*)(Ap->w_router + 4 * (F.tid + NWAVES * 64 * i));
#pragma unroll
        for (int i = 0; i < 8; ++i) { const int idx4 = F.tid + NWAVES * 64 * i, k = idx4 >> 2, e0 = (idx4 & 3) * 4;
            *(LAS f32x4*)(Wl + (((k >> 8) * 4 + (k & 3)) * 64 + ((k & 255) >> 2)) * 20 + e0) = wt[i]; }
    }
    __syncthreads();
    u32x2 rawc[2][4], rawn[2][4];
#define N2_LOAD(R, r0_) do { const int a_ = (r0_), b_ = ((r0_) + NGW < nrows) ? (r0_) + NGW : (r0_); \
        _Pragma("unroll") for (int j_ = 0; j_ < 4; ++j_) { R[0][j_] = *(const u32x2*)(HR + (size_t)a_ * DM + lane * 4 + 256 * j_); R[1][j_] = *(const u32x2*)(HR + (size_t)b_ * DM + lane * 4 + 256 * j_); } } while (0)
    if (gw < nrows) N2_LOAD(rawc, gw);
#pragma unroll 1
    for (int row0 = gw; row0 < nrows; row0 += 2 * NGW) {
        const int row1 = row0 + NGW; const bool has1 = row1 < nrows;
        if (row0 + 2 * NGW < nrows) N2_LOAD(rawn, row0 + 2 * NGW);
        float hn[2][16];
#pragma unroll
        for (int t = 0; t < 2; ++t) {
            const int row = (t == 0 || has1) ? (t == 0 ? row0 : row1) : row0;
            const int rc = row >= NTOK;
            f32x4 v[4]; float ss = 0.f;
#pragma unroll
            for (int j = 0; j < 4; ++j) { v[j] = BF2X4(rawc[t][j]); ss += (v[j].x * v[j].x + v[j].y * v[j].y) + (v[j].z * v[j].z + v[j].w * v[j].w); }
            const float r = 1.0f / sqrtf(wave_sum(ss) * (1.0f / DM) + EPS);
            const GAS float* md = (const GAS float*)modp(Ap, l, rc); const GAS float* n2p = (const GAS float*)(Ap->norm2 + l * DM);
            asm volatile("" : "+s"(md), "+s"(n2p));
#pragma unroll
            for (int j = 0; j < 4; ++j) {
                const int k = lane * 4 + 256 * j;
                const f32x4 nw = *(const GAS f32x4*)(n2p + k), sh = *(const GAS f32x4*)(md + 3072 + k), sc = *(const GAS f32x4*)(md + 4096 + k);
                const f32x4 h4 = v[j] * r * nw * (sc + 1.0f) + sh;
                hn[t][4 * j] = h4.x; hn[t][4 * j + 1] = h4.y; hn[t][4 * j + 2] = h4.z; hn[t][4 * j + 3] = h4.w;
            }
            {
                float mx = 0.f;
#pragma unroll
                for (int i = 0; i < 16; ++i) mx = fmaxf(mx, fabsf(hn[t][i]));
#pragma unroll
                for (int o = 1; o < 64; o <<= 1) mx = fmaxf(mx, __shfl_xor(mx, o));
                const float inv = (mx > 0.f) ? 127.0f / mx : 0.f;
                if (t == 0 || has1) {
#pragma unroll
                    for (int j = 0; j < 4; ++j) { unsigned pk = 0;
#pragma unroll
                        for (int q = 0; q < 4; ++q) pk |= (unsigned)(max(-127, min(127, (int)rintf(hn[t][4 * j + q] * inv))) & 255) << (8 * q);
                        *(unsigned*)((unsigned char*)XN + (size_t)row * DM + lane * 4 + 256 * j) = pk; }
                    if (lane == 0) ((float*)(Ap->ws + WS_SMALL + SM_XS))[row] = mx * (1.0f / 127.0f);
                }
            }
        }
#pragma unroll
        for (int t = 0; t < 2; ++t)
#pragma unroll
            for (int j = 0; j < 4; ++j) rawc[t][j] = rawn[t][j];
        if (dry) continue;
        float lg[2][16];
#pragma unroll
        for (int t = 0; t < 2; ++t)
#pragma unroll
            for (int e = 0; e < 16; ++e) lg[t][e] = 0.f;
        const LAS float* wlane = Wl + lane * 20; asm volatile("" : "+v"(wlane));
        f32x4 wa[4], wb[4];
#define N2_LDW(W_, jc_) do { _Pragma("unroll") for (int p_ = 0; p_ < 4; ++p_) W_[p_] = *(const LAS f32x4*)(wlane + (jc_) * 64 * 20 + 4 * p_); } while (0)
#define N2_FMA(W_, jc_) do { _Pragma("unroll") for (int p_ = 0; p_ < 4; ++p_) _Pragma("unroll") for (int t_ = 0; t_ < 2; ++t_) { const float hv_ = hn[t_][jc_]; \
        lg[t_][4 * p_] += hv_ * W_[p_].x; lg[t_][4 * p_ + 1] += hv_ * W_[p_].y; lg[t_][4 * p_ + 2] += hv_ * W_[p_].z; lg[t_][4 * p_ + 3] += hv_ * W_[p_].w; } \
        asm volatile("" : "+v"(lg[0][0]), "+v"(lg[0][1]), "+v"(lg[0][2]), "+v"(lg[0][3]), "+v"(lg[0][4]), "+v"(lg[0][5]), "+v"(lg[0][6]), "+v"(lg[0][7]), "+v"(lg[0][8]), "+v"(lg[0][9]), "+v"(lg[0][10]), "+v"(lg[0][11]), "+v"(lg[0][12]), "+v"(lg[0][13]), "+v"(lg[0][14]), "+v"(lg[0][15])); \
        asm volatile("" : "+v"(lg[1][0]), "+v"(lg[1][1]), "+v"(lg[1][2]), "+v"(lg[1][3]), "+v"(lg[1][4]), "+v"(lg[1][5]), "+v"(lg[1][6]), "+v"(lg[1][7]), "+v"(lg[1][8]), "+v"(lg[1][9]), "+v"(lg[1][10]), "+v"(lg[1][11]), "+v"(lg[1][12]), "+v"(lg[1][13]), "+v"(lg[1][14]), "+v"(lg[1][15])); } while (0)
        N2_LDW(wa, 0);
#pragma unroll
        for (int jc = 0; jc < 16; jc += 2) {
            N2_LDW(wb, jc + 1); N2_FMA(wa, jc);
            if (jc + 2 < 16) N2_LDW(wa, jc + 2);
            N2_FMA(wb, jc + 1);
        }
#undef N2_LDW
#undef N2_FMA
#pragma unroll 1
        for (int t = 0; t < 2; ++t) {
            if (t == 1) { if (!has1) break;
#pragma unroll
                for (int e = 0; e < 16; ++e) lg[0][e] = lg[1][e]; }
            route_row(lg[0], t == 0 ? row0 : row1, lane, Ap->b_router, cntL, listL, gwt);
        }
    }
    __syncthreads();
    if (dry) return;
    if (F.tid < 16) baseL[F.tid] = (int)__hip_atomic_fetch_add(gcnt + F.tid, (unsigned)cntL[F.tid], __ATOMIC_RELAXED, __HIP_MEMORY_SCOPE_AGENT);
    __syncthreads();
    for (int e = 0; e < 16; ++e) { const int n = cntL[e], b = baseL[e];
        for (int i = F.tid; i < n; i += NWAVES * 64) glist[(size_t)e * LIST_CAP + b + i] = listL[e * 136 + i]; }
    __syncthreads();
}

__device__ __forceinline__ bf16x8 ld8(const bf16_t* p) { return *(const bf16x8*)p; }
__device__ __forceinline__ bf16x8 ld4x2(const bf16_t* p0, const bf16_t* p1) { const bf16x4 a = *(const bf16x4*)p0, b = *(const bf16x4*)p1; return (bf16x8){a[0], a[1], a[2], a[3], b[0], b[1], b[2], b[3]}; }
#define MFMA16(a, b, c) __builtin_amdgcn_mfma_f32_16x16x32_bf16((a), (b), (c), 0, 0, 0)

template <int P, bool LOCAL>
__device__ __forceinline__ void attn_pair(const bf16x8 (&q)[4][2], f32x4 (&O)[4][4], float (&ls)[4], const bf16x8 (&k)[2][2], const bf16x8 (&v)[4],
                                          const LAS float* bl  , const int jsel  , const int fr, const int g, const float B2) {
#pragma unroll
    for (int j = 0; j < 4; ++j) {
        if (LOCAL && ((P == 0 && j == 3) || (P == 1 && j == 0))) continue;
        if (!LOCAL && jsel >= 0 && j != jsel) continue;
        float p[8];
#pragma unroll
        for (int s2 = 0; s2 < 2; ++s2) {
            const int kb = 2 * P + s2, dk = kb - j;
            if (LOCAL && (dk < -1 || dk > 1)) {
#pragma unroll
                for (int i = 0; i < 4; ++i) p[s2 * 4 + i] = 0.f;
                continue;
            }
            const f32x4 cinit = LOCAL ? (f32x4){bl[16 * dk], bl[16 * dk + 1], bl[16 * dk + 2], bl[16 * dk + 3]} : (f32x4){-B2, -B2, -B2, -B2};
            f32x4 S = MFMA16(k[s2][0], q[j][0], cinit);
            S = MFMA16(k[s2][1], q[j][1], S);
#pragma unroll
            for (int i = 0; i < 4; ++i) {
                float pv = __builtin_amdgcn_exp2f(S[i]);
                if (LOCAL) {
                    const int kc = 16 * kb + 4 * g + i;
                    const int cs = (j == 0) ? max(fr - 8, 0) : (j == 3) ? min(40 + fr, 48) : 16 * j + fr - 8;
                    const bool valid = (unsigned)(kc - cs) < 16u;
                    pv = valid ? pv : 0.f; }
                p[s2 * 4 + i] = pv; ls[j] += pv;
            }
        }
        u32x4 pw; pw.x = cvt_pk_bf16_pin(p[0], p[1]); pw.y = cvt_pk_bf16_pin(p[2], p[3]); pw.z = cvt_pk_bf16_pin(p[4], p[5]); pw.w = cvt_pk_bf16_pin(p[6], p[7]);
        const bf16x8 Pf = __builtin_bit_cast(bf16x8, pw);
#pragma unroll
        for (int d = 0; d < 4; ++d) O[j][d] = MFMA16(v[d], Pf, O[j][d]);
    }
}
template <bool LAT>
__device__ __forceinline__ void attn_row(KArgs Ap, const LAS float* biasL, const float B2, int r, int qt0, int h, int lane, int jsel = -1) {
    const char* QF = (const char*)(Ap->ws + WS_QF) + (size_t)h * NBLK16 * 2048; const char* KF = (const char*)(Ap->ws + WS_KF) + (size_t)h * NBLK16 * 2048;
    const char* VF = (const char*)(Ap->ws + WS_VF) + (size_t)h * NGRP32 * 4096; bf16_t* mix = (bf16_t*)(Ap->ws + WS_MIX);
    const int fr = lane & 15, g = lane >> 4;
    const unsigned loff = (unsigned)lane * 16u;
    bf16x8 q[4][2];
#pragma unroll
    for (int j = 0; j < 4; ++j) { const char* qp = QF + (size_t)((qt0 >> 4) + j) * 2048; q[j][0] = *(const bf16x8*)(qp + loff); q[j][1] = *(const bf16x8*)(qp + 1024 + loff); }
    f32x4 O[4][4]; float ls[4];
#pragma unroll
    for (int j = 0; j < 4; ++j) { ls[j] = 0.f;
#pragma unroll
        for (int d = 0; d < 4; ++d) O[j][d] = (f32x4){0.f, 0.f, 0.f, 0.f}; }
#define ATT_LDK(kk, tok) do { const char* kp_ = KF + (size_t)((tok) >> 4) * 2048; kk[0][0] = *(const bf16x8*)(kp_ + loff); kk[0][1] = *(const bf16x8*)(kp_ + 1024 + loff); \
        kk[1][0] = *(const bf16x8*)(kp_ + 2048 + loff); kk[1][1] = *(const bf16x8*)(kp_ + 3072 + loff); } while (0)
#define ATT_LDV(vv, tok) do { const char* vp_ = VF + (size_t)((tok) >> 5) * 4096; _Pragma("unroll") for (int d_ = 0; d_ < 4; ++d_) vv[d_] = *(const bf16x8*)(vp_ + d_ * 1024 + loff); } while (0)
    bf16x8 kA[2][2], kB[2][2], v[4];
    const LAS float* blane = biasL + 16 + 4 * g - fr + 15;
    if (LAT) {
        const int rs = min(max(r - 4, 0), 248);
        ATT_LDK(kA, rs * 64);
#pragma unroll 1
        for (int a = 0; a < 8; ++a) {
            const int tb = (rs + a) * 64;
            const LAS float* bl = blane + (rs + a - r + 7) * 64;
            ATT_LDV(v, tb); ATT_LDK(kB, tb + 32);
            attn_pair<0, true>(q, O, ls, kA, v, bl, 0, fr, g, B2);
            ATT_LDV(v, tb + 32); ATT_LDK(kA, (a < 7) ? tb + 64 : NTOK);
            attn_pair<1, true>(q, O, ls, kB, v, bl, 0, fr, g, B2);
        }
    } else {
        ATT_LDK(kA, NTOK);
    }
#pragma unroll 1
    for (int cp = 0; cp < 8; cp += 2) {
        ATT_LDV(v, NTOK + 32 * cp); ATT_LDK(kB, NTOK + 32 * (cp + 1));
        attn_pair<0, false>(q, O, ls, kA, v, blane, jsel, fr, g, B2);
        ATT_LDV(v, NTOK + 32 * (cp + 1)); ATT_LDK(kA, NTOK + 32 * min(cp + 2, 7));
        attn_pair<0, false>(q, O, ls, kB, v, blane, jsel, fr, g, B2);
    }
#undef ATT_LDK
#undef ATT_LDV
#pragma unroll
    for (int j = 0; j < 4; ++j) {
        if (jsel >= 0 && j != jsel) continue;
        float l_ = ls[j]; l_ += __shfl_xor(l_, 16); l_ += __shfl_xor(l_, 32);
        const float inv = 1.0f / l_;
        bf16_t* op = mix + (size_t)(qt0 + 16 * j + fr) * DM + 256 + h * 64 + 4 * g;
#pragma unroll
        for (int d = 0; d < 4; ++d) { u32x2 w; w.x = cvt_pk_bf16(O[j][d][0] * inv, O[j][d][1] * inv); w.y = cvt_pk_bf16(O[j][d][2] * inv, O[j][d][3] * inv); *(u32x2*)(op + 16 * d) = w; }
    }
}
template <int G4>
__device__ __forceinline__ void pool_item_t(KArgs Ap, int l, int t0, int lane) {
    constexpr int HW = 1 << G4;
    const bf16_t* PU = (const bf16_t*)(Ap->ws + WS_PU); bf16_t* mix = (bf16_t*)(Ap->ws + WS_MIX);
    const bf16_t* WT = (const bf16_t*)(Ap->ws + WS_SMALL + SM_POOLT) + (size_t)(l * 4 + G4) * 4096;
    const int fr = lane & 15, gq = lane >> 4;
    const int t = t0 + fr, base = (t0 >= NTOK) ? NTOK : 0, L = (t0 >= NTOK) ? NCTX : NTOK, tt = t - base;
    const int lo = max(tt - HW, 0), hi = min(tt + HW, L);
    const float invn = 1.0f / (float)(hi - lo);
    bf16x8 Bf[2];
#pragma unroll
    for (int s = 0; s < 2; ++s) {
        const int c0 = G4 * 64 + 32 * s + 8 * gq;
        bf16x8 wv[2 * HW];
#pragma unroll
        for (int d = 0; d < 2 * HW; ++d) { const int u = min(max(tt - HW + d, 0), L - 1); wv[d] = ld8(PU + (size_t)(base + u) * PU_LD + c0); }
        const bf16x8 self = ld8(PU + (size_t)t * PU_LD + c0);
        float acc8[8];
#pragma unroll
        for (int q = 0; q < 8; ++q) acc8[q] = 0.f;
#pragma unroll
        for (int d = 0; d < 2 * HW; ++d) { const int u = tt - HW + d; const float ok = (u >= 0 && u < L) ? 1.0f : 0.0f;
#pragma unroll
            for (int q = 0; q < 8; ++q) acc8[q] += ok * bf2f((unsigned short)wv[d][q]); }
        float dq[8];
#pragma unroll
        for (int q = 0; q < 8; ++q) dq[q] = acc8[q] * invn - bf2f((unsigned short)self[q]);
        u32x4 w; w.x = cvt_pk_bf16(dq[0], dq[1]); w.y = cvt_pk_bf16(dq[2], dq[3]); w.z = cvt_pk_bf16(dq[4], dq[5]); w.w = cvt_pk_bf16(dq[6], dq[7]);
        Bf[s] = __builtin_bit_cast(bf16x8, w);
    }
#pragma unroll
    for (int mb = 0; mb < 4; ++mb) {
        const bf16_t* wp = WT + (size_t)(16 * mb + fr) * 64 + 8 * gq;
        f32x4 o = MFMA16(ld8(wp), Bf[0], ((f32x4){0.f, 0.f, 0.f, 0.f}));
        o = MFMA16(ld8(wp + 32), Bf[1], o);
        const f32x4 ps = *(const f32x4*)(Ap->pool_scale + l * 256 + G4 * 64 + 16 * mb + 4 * gq);
        u32x2 w; w.x = cvt_pk_bf16(o[0] * ps[0], o[1] * ps[1]); w.y = cvt_pk_bf16(o[2] * ps[2], o[3] * ps[3]);
        *(u32x2*)(mix + (size_t)t * DM + G4 * 64 + 16 * mb + 4 * gq) = w;
    }
}
__device__ __forceinline__ void pool_item(KArgs Ap, int l, int t0, int g4, int lane) {
    if (g4 == 0) pool_item_t<0>(Ap, l, t0, lane); else if (g4 == 1) pool_item_t<1>(Ap, l, t0, lane); else if (g4 == 2) pool_item_t<2>(Ap, l, t0, lane); else pool_item_t<3>(Ap, l, t0, lane);
}
__device__ __forceinline__ void sg_item(KArgs Ap, int l, int ch, int h, int pb, int lane) {
    const bf16_t* PU = (const bf16_t*)(Ap->ws + WS_PU); bf16_t* mix = (bf16_t*)(Ap->ws + WS_MIX);
    const char* SGF = (const char*)(Ap->ws + WS_SGF) + (size_t)(h * NCHUNK + ch) * 16384;
    const char* W = (const char*)(Ap->ws + WS_SMALL + SM_SGW) + (size_t)((l * 4 + h) * 8 + pb) * 4096;
    const int fr = lane & 15, gq = lane >> 4;
    const unsigned loff = (unsigned)lane * 16u;
    const int p = 16 * pb + fr, tok = ch * 128 + p;
    f32x4 acc[4];
#pragma unroll
    for (int mb = 0; mb < 4; ++mb) acc[mb] = (f32x4){0.f, 0.f, 0.f, 0.f};
#pragma unroll
    for (int s = 0; s < 4; ++s) {
        const bf16x8 Bf = *(const bf16x8*)(W + s * 1024 + loff);
#pragma unroll
        for (int mb = 0; mb < 4; ++mb) acc[mb] = MFMA16(*(const bf16x8*)(SGF + (s * 4 + mb) * 1024 + loff), Bf, acc[mb]);
    }
    const float bias = Ap->sg_b[(l * 4 + h) * 128 + p];
#pragma unroll
    for (int mb = 0; mb < 4; ++mb) {
        const bf16x4 u4 = *(const bf16x4*)(PU + (size_t)tok * PU_LD + 256 + h * 64 + 16 * mb + 4 * gq);
        u32x2 w; w.x = cvt_pk_bf16(bf2f((unsigned short)u4[0]) * (acc[mb][0] + bias), bf2f((unsigned short)u4[1]) * (acc[mb][1] + bias));
        w.y = cvt_pk_bf16(bf2f((unsigned short)u4[2]) * (acc[mb][2] + bias), bf2f((unsigned short)u4[3]) * (acc[mb][3] + bias));
        *(u32x2*)(mix + (size_t)tok * DM + 768 + h * 64 + 16 * mb + 4 * gq) = w;
    }
}
__device__ __forceinline__ void phase_mix(KArgs Ap, const Frame& F0, int l) {
    const Frame F = fresh(F0);
    const int gw = F.vcu * NWAVES + F.wave, NGW = F.G * NWAVES, lane = F.lane;
    LAS float* biasL = (LAS float*)F.lds;
    const float* B2t = (const float*)(Ap->ws + WS_SMALL + SM_B2) + l * 8;
#define MIX_BIAS_FILL() do { const int h_ = F.wave; float bt_[15]; _Pragma("unroll") for (int t_ = 0; t_ < 15; ++t_) { const int i_ = lane + 64 * t_, rr_ = i_ >> 6, cc_ = (i_ & 63) - 16; \
            bt_[t_] = (cc_ >= 0 && cc_ < 31) ? Ap->rpb[(size_t)(l * 8 + h_) * 465 + rr_ * 31 + cc_] * LOG2E - B2t[h_] : 0.f; } \
        _Pragma("unroll") for (int t_ = 0; t_ < 15; ++t_) biasL[h_ * 960 + lane + 64 * t_] = bt_[t_]; \
        asm volatile("s_waitcnt lgkmcnt(0)" ::: "memory"); } while (0)
    const int n_att = 256 * 8, n_actx = (l == 0) ? 4 * 8 * 4 : 0;
    const int nrow_t = (l == 0) ? MROWS : NTOK;
    const int n_pool = (nrow_t / 16) * 4, n_sg = (nrow_t / 128) * 4 * 8;
#define MIX_POOLSG() do { pool_item(Ap, l, (gw >> 2) * 16, gw & 3, lane); pool_item(Ap, l, ((gw + NGW) >> 2) * 16, 3 - (gw & 3), lane);     \
        for (int it = gw; it < min(n_sg, 2 * NGW); it += NGW) sg_item(Ap, l, it >> 5, (it >> 3) & 3, it & 7, lane); \
        { const int itp = 2 * NGW + (gw - NGW / 2); if (gw >= NGW / 2 && itp < n_pool) pool_item(Ap, l, (itp >> 2) * 16, itp & 3, lane); \
          const int its = 2 * NGW + (gw - 3 * NGW / 4); if (gw >= 3 * NGW / 4 && its < n_sg) sg_item(Ap, l, its >> 5, (its >> 3) & 3, its & 7, lane); } } while (0)
    if (F.wave >= 4) MIX_POOLSG();
    MIX_BIAS_FILL();
    for (int it = gw; it < n_att + n_actx; it += NGW) {
        const int h = it & 7;
        if (it < n_att) attn_row<true>(Ap, biasL + h * 960, B2t[h], it >> 3, (it >> 3) * 64, h, lane);
        else attn_row<false>(Ap, biasL + h * 960, B2t[h], 0, NTOK + 64 * (((it - n_att) >> 3) & 3), h, lane, (it - n_att) >> 5);
    }
    if (F.wave < 4) MIX_POOLSG();
#undef MIX_POOLSG
#undef MIX_BIAS_FILL
    __syncthreads();
}

using pg8::Unit;
struct SchedInN { const char* A; const char* B; int G, c; const float* xs; const float* wsc;
    __device__ __forceinline__ bool next(int i, Unit& u) const { u.e = 0; return pg8::static_unit(i, G, c, 65, 6, u.pm, u.pn); }
    __device__ __forceinline__ const char* a_base(const Unit& u) const { return A + (size_t)u.pm * 256 * DM; }
    __device__ __forceinline__ const char* b_base(const Unit& u) const { return B + (size_t)u.pn * 256 * DM; }
    __device__ __forceinline__ const float* rs_base(const Unit& u) const { return xs + u.pm * 256; }
    __device__ __forceinline__ const float* cs_base(const Unit& u) const { return wsc + u.pn * 256; } };
struct SchedInT { const char* A; const char* B; int G, c; const float* xs; const float* wsc;
    __device__ __forceinline__ bool next(int i, Unit& u) const { u.e = 0; return pg8::static_unit(i, G, c, 3, 65, u.pm, u.pn); }
    __device__ __forceinline__ const char* a_base(const Unit& u) const { return A + (size_t)(1536 + u.pm * 256) * DM; }
    __device__ __forceinline__ const char* b_base(const Unit& u) const { return B + (size_t)u.pn * 256 * DM; }
    __device__ __forceinline__ const float* rs_base(const Unit& u) const { return wsc + 1536 + u.pm * 256; }
    __device__ __forceinline__ const float* cs_base(const Unit& u) const { return xs + u.pn * 256; } };
struct SchedOut { const char* A; const char* B; int G, c, nM;
    __device__ __forceinline__ bool next(int i, Unit& u) const { u.e = 0; return pg8::static_unit(i, G, c, nM, 4, u.pm, u.pn); }
    __device__ __forceinline__ const char* a_base(const Unit& u) const { return A + (size_t)u.pm * 256 * DM * 2; }
    __device__ __forceinline__ const char* b_base(const Unit& u) const { return B + (size_t)u.pn * 256 * DM * 2; } };
struct SchedMoe { const char* A; const char* B; const LAS int* cnt; int G, c; size_t bstride_e, bstride_pn;
    __device__ __forceinline__ bool next(int i, Unit& u) const {
        int L = i * G + c;
#pragma unroll 1
        for (int e = 0; e < NEXP; ++e) { const int nu = ((cnt[e] + 255) >> 8) * 4; if (L < nu) { u.e = e; u.pm = L >> 2; u.pn = L & 3; return true; } L -= nu; }
        return false; }
    __device__ __forceinline__ const char* a_base(const Unit&) const { return A; }
    __device__ __forceinline__ const char* b_base(const Unit& u) const { return B + (size_t)u.e * bstride_e + (size_t)u.pn * bstride_pn; } };

struct EpiInN {
    bf16_t* PU; bf16_t* QF; const float* qw; const float* kw;
    __device__ __forceinline__ void operator()(f32x4 (&acc)[2][2][4][2], const Unit& u, int, int wr, int wc, int fr, int fq) const {
        const int type = (u.pn == 0) ? 0 : (u.pn <= 2) ? 1 : (u.pn <= 4) ? 2 : 3;
        const int head = (type == 1) ? (u.pn - 1) * 4 + wc : (type == 2) ? (u.pn - 3) * 4 + wc : 0;
        f32x4 wv[2][2];
#pragma unroll
        for (int bj = 0; bj < 2; ++bj)
#pragma unroll
            for (int n = 0; n < 2; ++n) {
                const int d = 32 * bj + 8 * fq + 4 * n;
                wv[bj][n] = (type == 1) ? *(const f32x4*)(qw + head * 64 + d) * (0.125f * LOG2E) : (type == 2) ? *(const f32x4*)(kw + head * 64 + d) : (f32x4){1.f, 1.f, 1.f, 1.f};
            }
        const int row0 = u.pm * 256 + wr * 64 + fr;
#pragma unroll
        for (int ai = 0; ai < 2; ++ai)
#pragma unroll
            for (int m = 0; m < 4; ++m) {
                f32x4 v[2][2];
#pragma unroll
                for (int bj = 0; bj < 2; ++bj)
#pragma unroll
                    for (int n = 0; n < 2; ++n) v[bj][n] = acc[ai][bj][m][n];
                const int row = row0 + ai * 128 + m * 16;
                bf16_t* dst; int dstep;
                if (type == 1 || type == 2) {
                    float ss = 0.f;
#pragma unroll
                    for (int bj = 0; bj < 2; ++bj)
#pragma unroll
                        for (int n = 0; n < 2; ++n) ss += (v[bj][n][0] * v[bj][n][0] + v[bj][n][1] * v[bj][n][1]) + (v[bj][n][2] * v[bj][n][2] + v[bj][n][3] * v[bj][n][3]);
                    ss += __shfl_xor(ss, 16); ss += __shfl_xor(ss, 32);
                    const float r = 1.0f / sqrtf(ss * (1.0f / 64.0f) + EPS);
#pragma unroll
                    for (int bj = 0; bj < 2; ++bj)
#pragma unroll
                        for (int n = 0; n < 2; ++n) v[bj][n] = v[bj][n] * r * wv[bj][n];
                    dst = QF + (type == 2 ? (WS_KF - WS_QF) / 2 : (size_t)0) + ((size_t)(head * NBLK16 + (row >> 4)) * 2 * 64 + ((fq << 4) | fr)) * 8; dstep = 512;
                } else {
                    if (type == 3) {
#pragma unroll
                        for (int bj = 0; bj < 2; ++bj)
#pragma unroll
                            for (int n = 0; n < 2; ++n)
#pragma unroll
                                for (int q = 0; q < 4; ++q) v[bj][n][q] = gelu_tanh(v[bj][n][q]);
                    }
                    dst = PU + (size_t)row * PU_LD + (type == 3 ? 256 : 0) + wc * 64 + 8 * fq; dstep = 32;
                }
#pragma unroll
                for (int bj = 0; bj < 2; ++bj) { u32x4 w; w.x = cvt_pk_bf16(v[bj][0][0], v[bj][0][1]); w.y = cvt_pk_bf16(v[bj][0][2], v[bj][0][3]); w.z = cvt_pk_bf16(v[bj][1][0], v[bj][1][1]); w.w = cvt_pk_bf16(v[bj][1][2], v[bj][1][3]);
                    *(u32x4*)(dst + bj * dstep) = w; }
            }
    }
};
struct EpiInT {
    bf16_t* VF; bf16_t* SGF; const float* sgn;
    __device__ __forceinline__ void operator()(f32x4 (&acc)[2][2][4][2], const Unit& u, int, int wr, int wc, int fr, int fq) const {
#pragma unroll
        for (int ai = 0; ai < 2; ++ai) {
            const int head = 2 * ai + wr;
            if (u.pm == 2) {
                float sw[4];
#pragma unroll
                for (int m = 0; m < 4; ++m) sw[m] = sgn[head * 64 + 16 * m + fr];
#pragma unroll
                for (int bj = 0; bj < 2; ++bj)
#pragma unroll
                    for (int n = 0; n < 2; ++n) {
                        f32x4 ss = (f32x4){0.f, 0.f, 0.f, 0.f};
#pragma unroll
                        for (int m = 0; m < 4; ++m) {
#pragma unroll
                            for (int q = 0; q < 4; ++q) acc[ai][bj][m][n][q] = gelu_tanh(acc[ai][bj][m][n][q]);
                            ss += acc[ai][bj][m][n] * acc[ai][bj][m][n]; }
#pragma unroll
                        for (int q = 0; q < 4; ++q) { float t = ss[q]; t += __shfl_xor(t, 1); t += __shfl_xor(t, 2); t += __shfl_xor(t, 4); t += __shfl_xor(t, 8); ss[q] = 1.0f / sqrtf(t * (1.0f / 64.0f) + EPS); }
#pragma unroll
                        for (int m = 0; m < 4; ++m) acc[ai][bj][m][n] = acc[ai][bj][m][n] * ss * sw[m];
                    }
#pragma unroll
                for (int m = 0; m < 4; ++m)
#pragma unroll
                    for (int bj = 0; bj < 2; ++bj) { const f32x4 v0 = acc[ai][bj][m][0], v1 = acc[ai][bj][m][1];
                        u32x4 w; w.x = cvt_pk_bf16(v0[0], v0[1]); w.y = cvt_pk_bf16(v0[2], v0[3]); w.z = cvt_pk_bf16(v1[0], v1[1]); w.w = cvt_pk_bf16(v1[2], v1[3]);
                        *(u32x4*)(SGF + ((((size_t)(head * NCHUNK + 2 * u.pn + bj) * 4 + wc) * 4 + m) * 64 + ((fq << 4) | fr)) * 8) = w; }
            } else {
#pragma unroll
                for (int m = 0; m < 4; ++m)
#pragma unroll
                    for (int bj = 0; bj < 2; ++bj)
#pragma unroll
                        for (int n = 0; n < 2; ++n) { const f32x4 v0 = acc[ai][bj][m][n];
                            u32x2 w; w.x = cvt_pk_bf16(v0[0], v0[1]); w.y = cvt_pk_bf16(v0[2], v0[3]);
                            *(u32x2*)(VF + ((((size_t)((4 * u.pm + head) * NGRP32 + 8 * u.pn + 4 * bj + wc) * 4 + m) * 64 + (((2 * (fq & 1) + n) << 4) | fr)) * 8 + 4 * (fq >> 1))) = w; }
            }
        }
    }
};
struct EpiOut {
    const float* base_lat; const float* base_ctx; bf16_t* HR; const float* g_lat; const float* g_ctx; int l;
    __device__ __forceinline__ void operator()(f32x4 (&acc)[2][2][4][2], const Unit& u, int, int wr, int wc, int fr, int fq) const {
        const bool cx = u.pm >= 64;
        const float* gt = cx ? g_ctx : g_lat;
        const int row0 = u.pm * 256 + wr * 64 + fr, col0 = u.pn * 256 + wc * 32 + 8 * fq;
        f32x4 gv[2][2];
#pragma unroll
        for (int bj = 0; bj < 2; ++bj)
#pragma unroll
            for (int n = 0; n < 2; ++n) gv[bj][n] = *(const f32x4*)(gt + col0 + bj * 128 + n * 4);
        const float* bp0 = (cx ? base_ctx + (size_t)(row0 - NTOK) * DM : base_lat + (size_t)row0 * DM) + col0;
        bf16_t* hp0 = HR + (size_t)row0 * DM + col0;
#pragma unroll
        for (int ai = 0; ai < 2; ++ai) {
            if (l == 0) {
                f32x4 b[4][2][2];
#pragma unroll
                for (int m = 0; m < 4; ++m)
#pragma unroll
                    for (int bj = 0; bj < 2; ++bj) { const float* bp = bp0 + (size_t)(ai * 128 + m * 16) * DM + bj * 128; b[m][bj][0] = *(const f32x4*)bp; b[m][bj][1] = *(const f32x4*)(bp + 4); }
#pragma unroll
                for (int m = 0; m < 4; ++m)
#pragma unroll
                    for (int bj = 0; bj < 2; ++bj) {
                        const f32x4 o0 = b[m][bj][0] + gv[bj][0] * acc[ai][bj][m][0], o1 = b[m][bj][1] + gv[bj][1] * acc[ai][bj][m][1];
                        u32x4 w; w.x = cvt_pk_bf16(o0[0], o0[1]); w.y = cvt_pk_bf16(o0[2], o0[3]); w.z = cvt_pk_bf16(o1[0], o1[1]); w.w = cvt_pk_bf16(o1[2], o1[3]);
                        *(u32x4*)(hp0 + (size_t)(ai * 128 + m * 16) * DM + bj * 128) = w; }
            } else {
                u32x4 b[4][2];
#pragma unroll
                for (int m = 0; m < 4; ++m)
#pragma unroll
                    for (int bj = 0; bj < 2; ++bj) b[m][bj] = *(const u32x4*)(hp0 + (size_t)(ai * 128 + m * 16) * DM + bj * 128);
                asm volatile("" ::: "memory");
#pragma unroll
                for (int m = 0; m < 4; ++m)
#pragma unroll
                    for (int bj = 0; bj < 2; ++bj) {
                        const u32x2 lo = {b[m][bj].x, b[m][bj].y}, hi = {b[m][bj].z, b[m][bj].w};
                        const f32x4 o0 = BF2X4(lo) + gv[bj][0] * acc[ai][bj][m][0], o1 = BF2X4(hi) + gv[bj][1] * acc[ai][bj][m][1];
                        u32x4 w; w.x = cvt_pk_bf16(o0[0], o0[1]); w.y = cvt_pk_bf16(o0[2], o0[3]); w.z = cvt_pk_bf16(o1[0], o1[1]); w.w = cvt_pk_bf16(o1[2], o1[3]);
                        *(u32x4*)(hp0 + (size_t)(ai * 128 + m * 16) * DM + bj * 128) = w; }
            }
            asm volatile("" ::: "memory");
        }
    }
};
struct EpiG1 {
    bf16_t* H; const LAS int* idxl; const float* xs; const float* wsc;
    __device__ __forceinline__ void operator()(f32x4 (&acc)[2][2][4][2], const Unit& u, int ui, int wr, int wc, int fr, int fq) const {
        const int col0 = u.pn * 128 + wc * 32 + 8 * fq;
        const float* wrow = wsc + u.e * 1024 + u.pn * 256 + wc * 32 + 8 * fq;
        f32x4 wg[2], wu[2];
#pragma unroll
        for (int n = 0; n < 2; ++n) { wg[n] = *(const f32x4*)(wrow + 4 * n); wu[n] = *(const f32x4*)(wrow + 128 + 4 * n); }
        int ent[2][4]; float xsc[2][4];
#pragma unroll
        for (int ai = 0; ai < 2; ++ai)
#pragma unroll
            for (int m = 0; m < 4; ++m) ent[ai][m] = idxl[ui * 256 + ai * 128 + wr * 64 + m * 16 + fr];
#pragma unroll
        for (int ai = 0; ai < 2; ++ai)
#pragma unroll
            for (int m = 0; m < 4; ++m) xsc[ai][m] = xs[(ent[ai][m] & 0x7fffffff) >> 1];
#pragma unroll
        for (int ai = 0; ai < 2; ++ai)
#pragma unroll
            for (int m = 0; m < 4; ++m) {
                float hv[8];
#pragma unroll
                for (int n = 0; n < 2; ++n)
                {   const i32x4 ig = __builtin_bit_cast(i32x4, acc[ai][0][m][n]), iu = __builtin_bit_cast(i32x4, acc[ai][1][m][n]);
#pragma unroll
                    for (int q = 0; q < 4; ++q) {
                        const float g = (float)ig[q] * (xsc[ai][m] * wg[n][q]);
                        const float up = (float)iu[q] * (xsc[ai][m] * wu[n][q]);
                        hv[n * 4 + q] = silu_f(g) * up; } }
                if (ent[ai][m] >= 0) { u32x4 w; w.x = cvt_pk_bf16(hv[0], hv[1]); w.y = cvt_pk_bf16(hv[2], hv[3]); w.z = cvt_pk_bf16(hv[4], hv[5]); w.w = cvt_pk_bf16(hv[6], hv[7]);
                    *(u32x4*)(H + (size_t)ent[ai][m] * DEXP + col0) = w; }
            }
    }
};
struct EpiG2 {
    bf16_t* Y; const LAS int* idxl; const float* gwt; const float* g_lat; const float* g_ctx;
    __device__ __forceinline__ void operator()(f32x4 (&acc)[2][2][4][2], const Unit& u, int ui, int wr, int wc, int fr, int fq) const {
        const int col0 = u.pn * 256 + wc * 32 + 8 * fq;
        int ent[2][4]; float gwv[2][4];
#pragma unroll
        for (int ai = 0; ai < 2; ++ai)
#pragma unroll
            for (int m = 0; m < 4; ++m) ent[ai][m] = idxl[ui * 256 + ai * 128 + wr * 64 + m * 16 + fr];
#pragma unroll
        for (int ai = 0; ai < 2; ++ai)
#pragma unroll
            for (int m = 0; m < 4; ++m) gwv[ai][m] = gwt[ent[ai][m] & 0x7fffffff];
        f32x4 gl[2][2], gc[2][2];
#pragma unroll
        for (int bj = 0; bj < 2; ++bj)
#pragma unroll
            for (int n = 0; n < 2; ++n) { gl[bj][n] = *(const f32x4*)(g_lat + col0 + bj * 128 + 4 * n); gc[bj][n] = *(const f32x4*)(g_ctx + col0 + bj * 128 + 4 * n); }
        asm volatile("" ::: "memory");
#pragma unroll
        for (int ai = 0; ai < 2; ++ai)
#pragma unroll
            for (int m = 0; m < 4; ++m) {
                const int e_ = ent[ai][m];
                if (e_ >= 0) {
                    const bool cx = e_ >= 2 * NTOK; const float gw_ = gwv[ai][m];
#pragma unroll
                    for (int bj = 0; bj < 2; ++bj) {
                        const f32x4 g0 = cx ? gc[bj][0] : gl[bj][0], g1 = cx ? gc[bj][1] : gl[bj][1];
                        const f32x4 v0 = acc[ai][bj][m][0] * g0 * gw_, v1 = acc[ai][bj][m][1] * g1 * gw_;
                        u32x4 w; w.x = cvt_pk_bf16(v0[0], v0[1]); w.y = cvt_pk_bf16(v0[2], v0[3]); w.z = cvt_pk_bf16(v1[0], v1[1]); w.w = cvt_pk_bf16(v1[2], v1[3]);
                        *(u32x4*)(Y + (size_t)e_ * DM + col0 + bj * 128) = w; }
                }
            }
    }
};

__device__ __forceinline__ void moe_setup(KArgs Ap, const Frame& F0, int l, LAS int* cntL, LAS int* idxl) {
    const Frame F = fresh(F0);
    const unsigned* gcnt = (const unsigned*)(Ap->ws + WS_CTL) + CW_CNT + l * 16;
    const int* glist = (const int*)(Ap->ws + WS_LIST);
    if (F.tid < 16) cntL[F.tid] = (int)gcnt[F.tid];
    __syncthreads();
    SchedMoe S{nullptr, nullptr, cntL, F.G, (int)blockIdx.x, 0, 0};
    Unit u;
    for (int i = 0; i < 8 && S.next(i, u); ++i) {
        const int n = cntL[u.e];
        if (F.tid < 256) { const int pos = u.pm * 256 + F.tid; const int* le = glist + (size_t)u.e * LIST_CAP;
            idxl[i * 256 + F.tid] = (pos < n) ? le[pos] : (int)((unsigned)le[0] | 0x80000000u); }
    }
    __syncthreads();
}

__global__ void __launch_bounds__(NWAVES * 64, 2) fwd_megakernel(Args A_unused) {
    extern __shared__ __attribute__((aligned(16))) unsigned char lds_raw[];
    Frame F;
    F.lds = (LAS unsigned char*)lds_raw;
    F.tid = threadIdx.x; F.lane = F.tid & 63; F.wave = __builtin_amdgcn_readfirstlane(F.tid >> 6);
    F.G = gridDim.x; { const int bx = blockIdx.x; F.vcu = (F.G % 8 == 0) ? (bx % 8) * (F.G / 8) + bx / 8 : bx; }
    volatile LAS unsigned* MISC = (volatile LAS unsigned*)(F.lds + MISC_OFF);
    for (int u = F.tid; u < 64; u += NWAVES * 64) MISC[u] = 0u;
    __syncthreads();
    XcdBarrier bar;
    { KArgs Ap = get_args(); bar = xcd_barrier_post((unsigned*)(Ap->ws + WS_CTL) + CW_BAR, MISC + 16); }
    LAS int* cntL = (LAS int*)(F.lds + MISC_OFF);
    LAS int* idxl = (LAS int*)(F.lds + IDX_OFF);

    int n_ts = 0;
#define STAMP() do { if (TS_A >= 0) { if (blockIdx.x == 0 && threadIdx.x == 0) { KArgs Ap_ = get_args(); ((unsigned long long*)(Ap_->ws + WS_SMALL + SM_TS))[n_ts] = __builtin_amdgcn_s_memrealtime(); } ++n_ts; } } while (0)
    STAMP();
#define REPS(k, cond) (((DUP == (k)) && (cond)) ? 2 : 1)
#pragma unroll 1
    for (int rep = 0; rep < REPS(1, true); ++rep) { { KArgs Ap = get_args(); p0_prologue(Ap, F); } xcd_barrier(bar); STAMP(); }
#pragma unroll 1
    for (int l = 0; l < 2; ++l) {
#pragma unroll 1
        for (int rep = 0; rep < REPS(2, l == 0); ++rep) { { KArgs Ap = get_args(); phase_n1(Ap, F, l); } xcd_barrier(bar); STAMP(); }
#pragma unroll 1
        for (int rep = 0; rep < REPS(3, true); ++rep) {
        {
            KArgs Ap = get_args(); unsigned char* ws = Ap->ws; const Frame Fp = fresh(F); int bx = (int)blockIdx.x; asm volatile("" : "+s"(bx));
            SchedInN S1{(const char*)(ws + WS_XN), (const char*)(ws + WS_WINQ) + (size_t)l * IN_DIM * DM, Fp.G, bx, (const float*)(ws + WS_SMALL + SM_XS), (const float*)(ws + WS_WSIN) + l * IN_DIM};
            EpiInN E1{(bf16_t*)(ws + WS_PU), (bf16_t*)(ws + WS_QF), Ap->q_norm + l * 512, Ap->k_norm + l * 512};
            pg8::gemm_phase<EpiInN, SchedInN, 2, false, 0, true, true>(Fp.lds, idxl, DM, DM, DM, S1, E1);
        }
        {
            KArgs Ap = get_args(); unsigned char* ws = Ap->ws; const Frame Fp = fresh(F); int bx = (int)blockIdx.x; asm volatile("" : "+s"(bx));
            SchedInT S2{(const char*)(ws + WS_WINQ) + (size_t)l * IN_DIM * DM, (const char*)(ws + WS_XN), Fp.G, Fp.G - 1 - bx, (const float*)(ws + WS_SMALL + SM_XS), (const float*)(ws + WS_WSIN) + l * IN_DIM};
            EpiInT E2{(bf16_t*)(ws + WS_VF), (bf16_t*)(ws + WS_SGF), Ap->sg_norm + l * 256};
            pg8::gemm_phase<EpiInT, SchedInT, 1, false, 0, true, true>(Fp.lds, idxl, DM, DM, DM, S2, E2);
        }
        if (l == 0) { KArgs Ap = get_args(); int bx = (int)blockIdx.x; asm volatile("" : "+s"(bx));
            if (F.G == 256 && !(bx >= 61 && bx < 134)) convert_fill_rank(Ap, F, bx < 61 ? bx : bx - 73, 183, CVG_P0, CVG_IN0);
            else if (F.G != 256) convert_fill_rank(Ap, F, bx, F.G, CVG_P0, CVG_IN0); }
        xcd_barrier(bar); STAMP();
        }
#pragma unroll 1
        for (int rep = 0; rep < REPS(4, true); ++rep) { { KArgs Ap = get_args(); phase_mix(Ap, F, l); } xcd_barrier(bar); STAMP(); }
#pragma unroll 1
        for (int rep = 0; rep < REPS(5, l == 0); ++rep) {
        {
            KArgs Ap = get_args(); unsigned char* ws = Ap->ws; const Frame Fp = fresh(F); int bx = (int)blockIdx.x; asm volatile("" : "+s"(bx));
            SchedOut S{(const char*)(ws + WS_MIX), (const char*)(ws + WS_WOUT) + (size_t)l * DM * DM * 2, Fp.G, bx, (l == 0) ? 65 : 64};
            EpiOut E{Ap->x, Ap->ctx, (bf16_t*)(ws + WS_HRES), modp(Ap, l, 0) + 2048, modp(Ap, l, 1) + 2048, l};
            pg8::gemm_phase<EpiOut, SchedOut, 1, false, 0>(Fp.lds, idxl, DM * 2, DM * 2, DM * 2, S, E);
        }
        if (l == 0) { KArgs Ap = get_args(); int bx = (int)blockIdx.x; asm volatile("" : "+s"(bx)); convert_fill(Ap, F, bx, 65 * 4, CVG_IN0, CVG_OUT0); }
        xcd_barrier(bar); STAMP();
        }
        if (DUP == 8) { { KArgs Ap = get_args(); phase_n2(Ap, F, l, true); } xcd_barrier(bar); STAMP(); }
        if (l == 0) { KArgs Ap = get_args(); requant_gu(Ap, F); }
        { KArgs Ap = get_args(); phase_n2(Ap, F, l); }
        xcd_barrier(bar); STAMP();
        { KArgs Ap = get_args(); moe_setup(Ap, F, l, cntL, idxl); }
#pragma unroll 1
        for (int rep = 0; rep < REPS(6, true); ++rep) {
        {
            KArgs Ap = get_args(); unsigned char* ws = Ap->ws; const Frame Fp = fresh(F); int bx = (int)blockIdx.x; asm volatile("" : "+s"(bx));
            SchedMoe S{(const char*)(ws + WS_XN), (const char*)(ws + WS_WGUQ) + (size_t)l * NEXP * 1024 * 1024, cntL, Fp.G, bx, (size_t)1024 * 1024, (size_t)256 * DM};
            EpiG1 E{(bf16_t*)(ws + WS_H), idxl, (const float*)(ws + WS_SMALL + SM_XS), (const float*)(ws + WS_SMALL + SM_WSGU) + (size_t)l * NEXP * 1024};
            pg8::gemm_phase<EpiG1, SchedMoe, 1, true, 1, true>(Fp.lds, idxl, DM, DM, DM, S, E);
        }
        if (l == 0) { KArgs Ap = get_args(); int bx = (int)blockIdx.x; asm volatile("" : "+s"(bx)); int tu = 0;
            for (int e = 0; e < NEXP; ++e) tu += ((cntL[e] + 255) >> 8) * 4;
            convert_fill(Ap, F, bx, tu, CVG_OUT0, CVG_G10); }
        xcd_barrier(bar); STAMP();
        }
#pragma unroll 1
        for (int rep = 0; rep < REPS(7, true); ++rep) {
        {
            KArgs Ap = get_args(); unsigned char* ws = Ap->ws; const Frame Fp = fresh(F); int bx = (int)blockIdx.x; asm volatile("" : "+s"(bx));
            SchedMoe S{(const char*)(ws + WS_H), (const char*)(ws + WS_WDN) + (size_t)l * NEXP * 1024 * 512 * 2, cntL, Fp.G, bx, (size_t)1024 * 512 * 2, (size_t)256 * DEXP * 2};
            EpiG2 E{(bf16_t*)(ws + WS_Y), idxl, (const float*)(ws + WS_GW), modp(Ap, l, 0) + 5120, modp(Ap, l, 1) + 5120};
            pg8::gemm_phase<EpiG2, SchedMoe, 1, true, 0>(Fp.lds, idxl, DEXP * 2, DEXP * 2, DEXP * 2, S, E);
        }
        if (l == 0) { KArgs Ap = get_args(); int bx = (int)blockIdx.x; asm volatile("" : "+s"(bx)); int tu = 0;
            for (int e = 0; e < NEXP; ++e) tu += ((cntL[e] + 255) >> 8) * 4;
            convert_fill(Ap, F, bx, tu, CVG_G10, CVG_END); }
        xcd_barrier(bar); STAMP();
        }
    }
    if (DUP == 9) { for (int rep = 0; rep < 16; ++rep) xcd_barrier(bar); STAMP(); }
    { KArgs Ap = get_args(); phase_final(Ap, F); }
    STAMP();
    if (TS_A >= 0) { KArgs Ap = get_args(); if (blockIdx.x == 0 && threadIdx.x == 0) { const unsigned long long* ts = (const unsigned long long*)(Ap->ws + WS_SMALL + SM_TS);
        asm volatile("s_waitcnt vmcnt(0)" ::: "memory"); Ap->out[0] = (float)(ts[TS_B < 0 ? 0 : TS_B] - ts[TS_A < 0 ? 0 : TS_A]) * 0.01f * TS_SCALE; } }
    { KArgs Ap = get_args(); if (blockIdx.x == 0 && threadIdx.x == 0) { const unsigned t = xb_ld((unsigned*)(Ap->ws + WS_CTL) + CW_BAR + XB_TMO); if (t != 0u) { asm volatile("s_waitcnt vmcnt(0)" ::: "memory"); Ap->out[5] = __builtin_nanf(""); } } }
}

extern "C" void kernel_launch(void* const* d_in, const int* in_sizes, int n_in, void* d_out, int out_size, void* d_ws, size_t ws_size, hipStream_t stream) {
    static int grid = 0;
    if (grid == 0) {
        if (n_in != 23 || out_size != NTOK * DM || ws_size < WS_END) { fprintf(stderr, "kernel_launch: unexpected sizes (n_in %d out %d ws %zu)\n", n_in, out_size, ws_size); grid = -1; return; }
        int dev = 0, cus = 0, per_cu = 0;
        if (hipGetDevice(&dev) != hipSuccess || hipDeviceGetAttribute(&cus, hipDeviceAttributeMultiprocessorCount, dev) != hipSuccess) { grid = -1; return; }
        if (hipFuncSetAttribute((const void*)fwd_megakernel, hipFuncAttributeMaxDynamicSharedMemorySize, LDS_BYTES) != hipSuccess) { fprintf(stderr, "kernel_launch: hipFuncSetAttribute failed\n"); grid = -1; return; }
        if (hipOccupancyMaxActiveBlocksPerMultiprocessor(&per_cu, (const void*)fwd_megakernel, NWAVES * 64, LDS_BYTES) != hipSuccess || per_cu < 1) { fprintf(stderr, "kernel_launch: occupancy query says %d\n", per_cu); (void)hipGetLastError(); grid = -1; return; }
        grid = cus;
        if (grid != 256) fprintf(stderr, "kernel_launch: %d CUs (built for 256)\n", grid);
    }
    if (grid < 0) return;
    (void)hipMemsetAsync((char*)d_ws + WS_CTL, 0, CTL_ZERO_BYTES, stream);
    Args a{};
    const float** ap = (const float**)&a;
    for (int i = 0; i < 23; ++i) ap[i] = (const float*)d_in[i];
    a.out = (float*)d_out; a.ws = (unsigned char*)d_ws;
    void* args[] = {&a};
    hipError_t e = hipLaunchCooperativeKernel((const void*)fwd_megakernel, dim3(grid), dim3(NWAVES * 64), args, LDS_BYTES, stream);
    if (e != hipSuccess) fprintf(stderr, "kernel_launch: cooperative launch failed: %s\n", hipGetErrorString(e));
}
```
